# Optimizing an MI355X kernel written in HIP

```python
import math
import jax, jax.numpy as jnp
from jax import lax
import numpy as np

D_MODEL = 1024
BATCH = 2
SEQ = 8192
DEPTH = 2

HEAD_DIM = 64
N_HEADS = D_MODEL // HEAD_DIM
N_FOX = N_HEADS // 2
N_SB = N_HEADS - N_FOX
FOX_W = N_FOX * HEAD_DIM
SB_W = N_SB * HEAD_DIM
EVEN_IN = 3 * FOX_W + 3 * SB_W + N_FOX
N_Q = N_HEADS
N_KV = 4
GROUP = N_Q // N_KV
ODD_IN = N_Q * HEAD_DIM + 2 * N_KV * HEAD_DIM
WINDOW = 128
BLOCK_Q = 128
ROPE_THETA = 10000.0
D_FF = ((8 * D_MODEL // 3 + 255) // 256) * 256
PLE_DIM = 256
N_EVEN = (DEPTH + 1) // 2
N_ODD = DEPTH // 2
EPS = 1e-6
NEG_INF = -1e30

kernel_name = "hybrid_fox_stickbreak_swa_sink_block"


def _rmsnorm(x, g):
    xf = x.astype(jnp.float32)
    y = xf * lax.rsqrt(jnp.mean(xf * xf, axis=-1, keepdims=True) + EPS)
    return (y * g.astype(jnp.float32)).astype(x.dtype)


def _rope(x, pos):
    half = x.shape[-1] // 2
    inv = ROPE_THETA ** (-jnp.arange(half, dtype=jnp.float32) / half)
    ang = pos.astype(jnp.float32)[..., None] * inv
    cos = jnp.cos(ang)[:, :, None, :]
    sin = jnp.sin(ang)[:, :, None, :]
    xf = x.astype(jnp.float32)
    x1, x2 = xf[..., :half], xf[..., half:]
    out = jnp.concatenate([x1 * cos - x2 * sin, x2 * cos + x1 * sin], axis=-1)
    return out.astype(x.dtype)


def _forgetting_attention(q, k, v, log_f):
    S, d = q.shape[1], q.shape[-1]
    scale = d ** -0.5
    cum = jnp.cumsum(log_f, axis=1).transpose(0, 2, 1)
    outs = []
    for i in range(S // BLOCK_Q):
        q0, q1 = i * BLOCK_Q, (i + 1) * BLOCK_Q
        s = jnp.einsum('bqhd,bkhd->bhqk', q[:, q0:q1], k[:, :q1],
                       preferred_element_type=jnp.float32) * scale
        s = s + cum[:, :, q0:q1, None] - cum[:, :, None, :q1]
        causal = jnp.arange(q1)[None, :] <= jnp.arange(q0, q1)[:, None]
        s = jnp.where(causal, s, NEG_INF)
        w = jax.nn.softmax(s, axis=-1)
        outs.append(jnp.einsum('bhqk,bkhd->bqhd', w.astype(v.dtype), v[:, :q1]))
    return jnp.concatenate(outs, axis=1)


def _stick_breaking_attention(q, k, v):
    S, d = q.shape[1], q.shape[-1]
    scale = d ** -0.5
    outs = []
    for i in range(S // BLOCK_Q):
        q0, q1 = i * BLOCK_Q, (i + 1) * BLOCK_Q
        z = jnp.einsum('bqhd,bkhd->bhqk', q[:, q0:q1], k[:, :q1],
                       preferred_element_type=jnp.float32) * scale
        strict = jnp.arange(q1)[None, :] < jnp.arange(q0, q1)[:, None]
        log_1mb = jnp.where(strict, jax.nn.log_sigmoid(-z), 0.0)
        suffix = lax.cumsum(log_1mb, axis=3, reverse=True) - log_1mb
        a = jnp.where(strict, jnp.exp(jax.nn.log_sigmoid(z) + suffix), 0.0)
        outs.append(jnp.einsum('bhqk,bkhd->bqhd', a.astype(v.dtype), v[:, :q1]))
    return jnp.concatenate(outs, axis=1)


def _sliding_window_sink_attention(q, k, v, sinks):
    B, S, _, d = q.shape
    nb = S // WINDOW
    scale = d ** -0.5
    qb = q.reshape(B, nb, WINDOW, N_KV, GROUP, d)

    def band(x):
        xb = x.reshape(B, nb, WINDOW, N_KV, d)
        prev = jnp.concatenate([jnp.zeros_like(xb[:, :1]), xb[:, :-1]], axis=1)
        return jnp.concatenate([prev, xb], axis=2)

    kb, vb = band(k), band(v)
    s = jnp.einsum('bnqhgd,bnkhd->bnhgqk', qb, kb,
                   preferred_element_type=jnp.float32) * scale
    qi = jnp.arange(WINDOW)[:, None]
    kj = jnp.arange(2 * WINDOW)[None, :]
    rel = qi + WINDOW - kj
    valid = (rel >= 0) & (rel < WINDOW)
    first = (jnp.arange(nb)[:, None, None] == 0) & (kj[None] < WINDOW)
    mask = valid[None] & ~first
    s = jnp.where(mask[None, :, None, None], s, NEG_INF)
    sink = jnp.broadcast_to(
        sinks.astype(jnp.float32).reshape(N_KV, GROUP)[None, None, :, :, None, None],
        s.shape[:-1] + (1,))
    w = jax.nn.softmax(jnp.concatenate([s, sink], axis=-1), axis=-1)[..., :-1]
    o = jnp.einsum('bnhgqk,bnkhd->bnqhgd', w.astype(v.dtype), vb)
    return o.reshape(B, S, N_Q, d)


def _swiglu(x, w_gate, w_up, w_down):
    return (jax.nn.silu(x @ w_gate) * (x @ w_up)) @ w_down


def setup_inputs(seed: int = 0) -> dict:
    key = jax.random.key(seed)
    ks = jax.random.split(key, 20)
    f32 = jnp.float32

    def w(k, shape, fan_in):
        return jax.random.normal(k, shape, f32) * fan_in ** -0.5

    def gain(k, shape):
        return 1.0 + 0.02 * jax.random.normal(k, shape, f32)

    return {
        "x": jax.random.normal(ks[0], (BATCH, SEQ, D_MODEL), f32),
        "p": jax.random.normal(ks[1], (DEPTH, BATCH, SEQ, PLE_DIM), f32),
        "positions": jnp.broadcast_to(jnp.arange(SEQ, dtype=jnp.int32), (BATCH, SEQ)),
        "norm_mix": gain(ks[2], (DEPTH, D_MODEL)),
        "norm_ffn": gain(ks[3], (DEPTH, D_MODEL)),
        "norm_ple": gain(ks[4], (DEPTH, D_MODEL)),
        "norm_final": gain(ks[5], (D_MODEL,)),
        "ev_w_in": w(ks[6], (N_EVEN, D_MODEL, EVEN_IN), D_MODEL),
        "ev_b_f": 0.1 * jax.random.normal(ks[7], (N_EVEN, N_FOX), f32),
        "ev_w_out": w(ks[8], (N_EVEN, FOX_W + SB_W, D_MODEL), FOX_W + SB_W),
        "od_w_in": w(ks[9], (N_ODD, D_MODEL, ODD_IN), D_MODEL),
        "od_sinks": 0.5 * jax.random.normal(ks[10], (N_ODD, N_Q), f32),
        "od_w_out": w(ks[11], (N_ODD, N_Q * HEAD_DIM, D_MODEL), N_Q * HEAD_DIM),
        "ffn_w_gate": w(ks[12], (DEPTH, D_MODEL, D_FF), D_MODEL),
        "ffn_w_up": w(ks[13], (DEPTH, D_MODEL, D_FF), D_MODEL),
        "ffn_w_down": w(ks[14], (DEPTH, D_FF, D_MODEL), D_FF),
        "ple_w_proj": w(ks[15], (DEPTH, PLE_DIM, D_MODEL), PLE_DIM),
        "ple_w_gate": w(ks[16], (DEPTH, D_MODEL, D_MODEL), D_MODEL),
    }


def reference(x, p, positions, norm_mix, norm_ffn, norm_ple, norm_final,
              ev_w_in, ev_b_f, ev_w_out, od_w_in, od_sinks, od_w_out,
              ffn_w_gate, ffn_w_up, ffn_w_down, ple_w_proj, ple_w_gate):
    B, S, _ = x.shape
    h = x
    for i in range(DEPTH):
        hn = _rmsnorm(h, norm_mix[i])
        if i % 2 == 0:
            j = i // 2
            proj = hn @ ev_w_in[j]
            c = [0, FOX_W, 2 * FOX_W, 3 * FOX_W,
                 3 * FOX_W + SB_W, 3 * FOX_W + 2 * SB_W, 3 * FOX_W + 3 * SB_W]
            qa = proj[..., c[0]:c[1]].reshape(B, S, N_FOX, HEAD_DIM)
            ka = proj[..., c[1]:c[2]].reshape(B, S, N_FOX, HEAD_DIM)
            va = proj[..., c[2]:c[3]].reshape(B, S, N_FOX, HEAD_DIM)
            qs = proj[..., c[3]:c[4]].reshape(B, S, N_SB, HEAD_DIM)
            ks_ = proj[..., c[4]:c[5]].reshape(B, S, N_SB, HEAD_DIM)
            vs = proj[..., c[5]:c[6]].reshape(B, S, N_SB, HEAD_DIM)
            log_f = jax.nn.log_sigmoid(
                (proj[..., c[6]:] + ev_b_f[j]).astype(jnp.float32))
            o_fox = _forgetting_attention(qa, ka, va, log_f)
            o_sb = _stick_breaking_attention(qs, ks_, vs)
            mix = jnp.concatenate([o_fox.reshape(B, S, FOX_W),
                                   o_sb.reshape(B, S, SB_W)], axis=-1) @ ev_w_out[j]
        else:
            j = i // 2
            proj = hn @ od_w_in[j]
            qw, kw = N_Q * HEAD_DIM, N_KV * HEAD_DIM
            q = _rope(proj[..., :qw].reshape(B, S, N_Q, HEAD_DIM), positions)
            k = _rope(proj[..., qw:qw + kw].reshape(B, S, N_KV, HEAD_DIM), positions)
            v = proj[..., qw + kw:].reshape(B, S, N_KV, HEAD_DIM)
            o = _sliding_window_sink_attention(q, k, v, od_sinks[j])
            mix = o.reshape(B, S, qw) @ od_w_out[j]
        h = h + mix
        h = h + _swiglu(_rmsnorm(h, norm_ffn[i]), ffn_w_gate[i], ffn_w_up[i], ffn_w_down[i])
        gate = jax.nn.sigmoid(_rmsnorm(h, norm_ple[i]) @ ple_w_gate[i])
        h = h + gate * (p[i] @ ple_w_proj[i])
    return _rmsnorm(h, norm_final)
```

```cpp
#include <hip/hip_runtime.h>
#include <hip/hip_cooperative_groups.h>
#include <cstdio>
#include <cstdint>
#include <cmath>
namespace cg = cooperative_groups;
namespace pg8 {
#define PG8_LAS __attribute__((address_space(3)))
typedef unsigned short bf16_t;
typedef short bf16x8 __attribute__((ext_vector_type(8)));
typedef float f32x4 __attribute__((ext_vector_type(4)));
typedef unsigned u32x4 __attribute__((ext_vector_type(4)));
constexpr int BM = 256, BK = 64, HALF = 128, HTB = HALF * BK * 2  , STAGE_BYTES = 8 * HTB, NXCD = 8, WGM = 8;

__host__ __device__ __forceinline__ int lds_byte(int r, int c) { const int st = (r >> 4) * 2 + (c >> 5), rr = r & 15, cc = c & 31, ob = rr * 64 + cc * 2; return st * 1024 + (ob ^ (((ob >> 9) & 1) << 5)); }
__host__ __device__ __forceinline__ void stage_rc(int b, int& R, int& C) { const int st = b / 1024, sb = b % 1024, swz = sb ^ (((sb >> 9) & 1) << 5); R = (st >> 1) * 16 + swz / 64; C = (st & 1) * 32 + (swz % 64) / 2; }
__host__ __device__ __forceinline__ int perm32(int rho) { const int n = rho >> 4, i = rho & 15; return 8 * (i >> 2) + 4 * n + (i & 3); }

struct Unit { int pm, pn; };
struct Gemm { const bf16_t* A; const bf16_t* Bt; int M, N, K; };

struct StaticOrder {
    int nM, nN, nwg, G, c;
    __host__ __device__ void init(int M, int N, int G_, int c_) { nM = M / BM; nN = N / BM; nwg = nM * nN; G = G_; c = c_; }
    __host__ __device__ bool next(int i, Unit& u) const {
        const long L = (long)i * G + c; if (L >= nwg) return false;
        int wgid = (int)L; { const int q = nwg / NXCD, r = nwg % NXCD, xcd = wgid % NXCD, off = wgid / NXCD; wgid = (xcd < r ? xcd * (q + 1) : r * (q + 1) + (xcd - r) * q) + off; }
        const int nig = WGM * nN, gid = wgid / nig, fm = gid * WGM, gsz = (nM - fm) < WGM ? (nM - fm) : WGM;
        u.pm = fm + ((wgid % nig) % gsz); u.pn = (wgid % nig) / gsz; return true;
    }
    __device__ __forceinline__ void a_ready(const Unit&) const {}
    __device__ __forceinline__ void done(const Unit&) const {}
};

typedef float f32x2 __attribute__((ext_vector_type(2)));
typedef __bf16 bf16x2_t __attribute__((ext_vector_type(2)));
typedef unsigned u32x2 __attribute__((ext_vector_type(2)));
__device__ __forceinline__ unsigned cvtpk(float lo, float hi) { f32x2 v = {lo, hi}; bf16x2_t b = __builtin_convertvector(v, bf16x2_t); return __builtin_bit_cast(unsigned, b); }
__device__ __forceinline__ u32x4 pack8(f32x4 a, f32x4 b) { u32x4 w; w.x = cvtpk(a[0], a[1]); w.y = cvtpk(a[2], a[3]); w.z = cvtpk(b[0], b[1]); w.w = cvtpk(b[2], b[3]); return w; }
__device__ __forceinline__ float bflo(unsigned w) { return __builtin_bit_cast(float, w << 16); }
__device__ __forceinline__ float bfhi(unsigned w) { return __builtin_bit_cast(float, w & 0xffff0000u); }
__device__ __forceinline__ float fast_sigmoid(float x) { return __builtin_amdgcn_rcpf(1.0f + __builtin_amdgcn_exp2f(-x * 1.4426950408889634f)); }
__device__ __forceinline__ float row_rstd(const float* ssq, int row) { return __builtin_amdgcn_rsqf(ssq[row] * (1.0f / 1024.0f) + 1e-6f); }
__device__ __forceinline__ void st16_wt(void* p, u32x4 v) { asm volatile("global_store_dwordx4 %0, %1, off sc1\n\ts_nop 1" :: "v"(p), "v"(v) : "memory"); }
#ifndef WT_RESID
#define WT_RESID 0
#endif
#ifndef WT_WIDE
#define WT_WIDE 0
#endif
#ifndef WT_QK
#define WT_QK 0
#endif
#define EPI_ARGS const f32x4 (&acc)[2][2][4][2], const Unit& u, int wr, int wc, int fr, int fq
#define EPI_FLAGS static constexpr bool PERM = true, AFTER_DRAIN = false;
__device__ __forceinline__ void vt_store8(bf16_t* p, f32x4 a, f32x4 b) {
    const unsigned w0 = cvtpk(a[0], a[1]), w1 = cvtpk(a[2], a[3]), w2 = cvtpk(b[0], b[1]), w3 = cvtpk(b[2], b[3]);
    p[0 * 8192] = (bf16_t)(w0 & 0xffffu); p[1 * 8192] = (bf16_t)(w0 >> 16); p[2 * 8192] = (bf16_t)(w1 & 0xffffu); p[3 * 8192] = (bf16_t)(w1 >> 16);
    p[4 * 8192] = (bf16_t)(w2 & 0xffffu); p[5 * 8192] = (bf16_t)(w2 >> 16); p[6 * 8192] = (bf16_t)(w3 & 0xffffu); p[7 * 8192] = (bf16_t)(w3 >> 16);
}

struct EpiStore {
    EPI_FLAGS
    bf16_t* O; int ldc;
    __device__ __forceinline__ void operator()(EPI_ARGS) const {
        const int row0 = u.pm * BM + wr * 64 + fr, col0 = u.pn * BM + wc * 32 + 8 * fq;
#pragma unroll
        for (int ai = 0; ai < 2; ++ai)
#pragma unroll
            for (int m = 0; m < 4; ++m) { bf16_t* rowp = O + (size_t)(row0 + ai * HALF + m * 16) * ldc + col0;
#pragma unroll
                for (int bj = 0; bj < 2; ++bj) { if (WT_WIDE) st16_wt(rowp + bj * HALF, pack8(acc[ai][bj][m][0], acc[ai][bj][m][1])); else *(u32x4*)(rowp + bj * HALF) = pack8(acc[ai][bj][m][0], acc[ai][bj][m][1]); } }
    }
};

struct EpiL0In {
    EPI_FLAGS
    bf16_t* QK; bf16_t* VT; unsigned* kstat;
    __device__ __forceinline__ void operator()(EPI_ARGS) const {
        const int sec = u.pn >> 1, half = u.pn & 1, row0 = u.pm * BM + wr * 64 + fr, b = u.pm >> 5;
        if (sec == 2 || sec == 5) {
#pragma unroll
            for (int ai = 0; ai < 2; ++ai)
#pragma unroll
                for (int m = 0; m < 4; ++m) { const int s = (row0 + ai * HALF + m * 16) & 8191;
#pragma unroll
                    for (int bj = 0; bj < 2; ++bj) { const int colt = half * 256 + bj * 128 + wc * 32 + 8 * fq, head = (colt >> 6) + (sec == 5 ? 8 : 0), d0 = colt & 63;
                        vt_store8(VT + ((size_t)(b * 16 + head) * 64 + d0) * 8192 + s, acc[ai][bj][m][0], acc[ai][bj][m][1]); } }
        } else {
            const float sc = (sec == 0 || sec == 3) ? 0.125f * 1.4426950408889634f : 1.0f;
            const int cbase = (sec == 0 ? 0 : sec == 1 ? 512 : sec == 3 ? 1024 : 1536) + half * 256 + wc * 32 + 8 * fq;
#pragma unroll
            for (int ai = 0; ai < 2; ++ai)
#pragma unroll
                for (int m = 0; m < 4; ++m) { bf16_t* rowp = QK + (size_t)(row0 + ai * HALF + m * 16) * 2048 + cbase;
#pragma unroll
                    for (int bj = 0; bj < 2; ++bj) { if (WT_QK) st16_wt(rowp + bj * HALF, pack8(acc[ai][bj][m][0] * sc, acc[ai][bj][m][1] * sc)); else *(u32x4*)(rowp + bj * HALF) = pack8(acc[ai][bj][m][0] * sc, acc[ai][bj][m][1] * sc); } }
            if (sec == 1) {
#pragma unroll
                for (int bj = 0; bj < 2; ++bj) { float best = 0.f;
#pragma unroll
                    for (int ai = 0; ai < 2; ++ai)
#pragma unroll
                        for (int m = 0; m < 4; ++m) { const f32x4 a = acc[ai][bj][m][0], c = acc[ai][bj][m][1];
                            float ss = (a[0] * a[0] + a[1] * a[1]) + (a[2] * a[2] + a[3] * a[3]) + (c[0] * c[0] + c[1] * c[1]) + (c[2] * c[2] + c[3] * c[3]);
                            ss += __shfl_xor(ss, 16); ss += __shfl_xor(ss, 32); best = fmaxf(best, ss); }
                    best = fmaxf(best, __shfl_xor(best, 1)); best = fmaxf(best, __shfl_xor(best, 2)); best = fmaxf(best, __shfl_xor(best, 4)); best = fmaxf(best, __shfl_xor(best, 8));
                    if (fr == 0 && fq == 0) atomicMax(kstat + ((b * 8 + half * 4 + bj * 2 + (wc >> 1)) * 2 + (wc & 1)), __builtin_bit_cast(unsigned, best)); }
            }
        }
    }
};

struct EpiL1In {
    EPI_FLAGS
    bf16_t* QKV; bf16_t* VT; const float* ropeC; const float* ropeS; const float* ssq;
    __device__ __forceinline__ void operator()(EPI_ARGS) const {
        int fr_ = fr; asm volatile("" : "+v"(fr_));
        const int row0 = u.pm * BM + wr * 64 + fr_, b = u.pm >> 5;
        float sq[2][4];
#pragma unroll
        for (int ai = 0; ai < 2; ++ai)
#pragma unroll
            for (int m = 0; m < 4; ++m) sq[ai][m] = ssq[row0 + ai * HALF + m * 16];
        if (u.pn == 5) {
            asm volatile("" ::: "memory");
#pragma unroll
            for (int ai = 0; ai < 2; ++ai)
#pragma unroll
                for (int m = 0; m < 4; ++m) { const int s = (row0 + ai * HALF + m * 16) & 8191; const float rs = __builtin_amdgcn_rsqf(sq[ai][m] * (1.0f / 1024.0f) + 1e-6f);
#pragma unroll
                    for (int bj = 0; bj < 2; ++bj) { const int colt = bj * 128 + wc * 32 + 8 * fq, head = colt >> 6, d0 = colt & 63;
                        vt_store8(VT + ((size_t)(b * 4 + head) * 64 + d0) * 8192 + s, acc[ai][bj][m][0] * rs, acc[ai][bj][m][1] * rs); } }
        } else {
            const float sc = (u.pn < 4) ? 0.125f * 1.4426950408889634f : 1.0f;
            const int col0 = u.pn * BM + wc * 32 + 8 * fq, j0 = 4 * ((wc & 1) * 4 + fq);
            f32x4 csv[4], snv[4]; u32x4 outs[4][2];
#pragma unroll
            for (int m = 0; m < 4; ++m) { const int row = row0 + m * 16; csv[m] = *(const f32x4*)(ropeC + (size_t)row * 32 + j0); snv[m] = *(const f32x4*)(ropeS + (size_t)row * 32 + j0); }
#pragma unroll
            for (int ai = 0; ai < 2; ++ai) {
                asm volatile("" ::: "memory");
#pragma unroll
                for (int m = 0; m < 4; ++m) { const float rs = __builtin_amdgcn_rsqf(sq[ai][m] * (1.0f / 1024.0f) + 1e-6f) * sc; const f32x4 cs = csv[m] * rs, sn = snv[m] * rs;
#pragma unroll
                    for (int bj = 0; bj < 2; ++bj) { const f32x4 x1 = acc[ai][bj][m][0], x2 = acc[ai][bj][m][1]; outs[m][bj] = pack8(x1 * cs - x2 * sn, x2 * cs + x1 * sn); } }
                if (ai == 0) {
#pragma unroll
                    for (int m = 0; m < 4; ++m) { const int row = row0 + HALF + m * 16; csv[m] = *(const f32x4*)(ropeC + (size_t)row * 32 + j0); snv[m] = *(const f32x4*)(ropeS + (size_t)row * 32 + j0); } }
                asm volatile("" ::: "memory");
#pragma unroll
                for (int m = 0; m < 4; ++m) { bf16_t* rowp = QKV + (size_t)(row0 + ai * HALF + m * 16) * 1280 + col0;
#pragma unroll
                    for (int bj = 0; bj < 2; ++bj) *(u32x4*)(rowp + bj * HALF) = outs[m][bj]; }
            }
        }
    }
};

#define EPI_FENCE asm volatile("" ::: "memory")
__device__ __forceinline__ float rstd_of(float ssq_row) { return __builtin_amdgcn_rsqf(ssq_row * (1.0f / 1024.0f) + 1e-6f); }
__device__ __forceinline__ float sumsq8(f32x4 r0, f32x4 r1) { return (r0[0] * r0[0] + r0[1] * r0[1]) + (r0[2] * r0[2] + r0[3] * r0[3]) + (r1[0] * r1[0] + r1[1] * r1[1]) + (r1[2] * r1[2] + r1[3] * r1[3]); }

template <bool BASEF32> struct EpiResid {
    EPI_FLAGS
    const float* basef; const bf16_t* baseb; bf16_t* out; float* ssq; float mul;
    __device__ __forceinline__ void load_group(int g, int row0, int col0, f32x4 (&pf)[2][2][2], u32x4 (&pb)[2][2]) const {
#pragma unroll
        for (int r = 0; r < 2; ++r)
#pragma unroll
            for (int bj = 0; bj < 2; ++bj) { const size_t o = (size_t)(row0 + (g >> 1) * HALF + ((g & 1) * 2 + r) * 16) * 1024 + col0 + bj * HALF;
                if (BASEF32) { const f32x4* bp = (const f32x4*)(basef + o); pf[r][bj][0] = bp[0]; pf[r][bj][1] = bp[1]; } else pb[r][bj] = *(const u32x4*)(baseb + o); }
    }
    __device__ __forceinline__ void operator()(EPI_ARGS) const {
        const int row0 = u.pm * BM + wr * 64 + fr, col0 = u.pn * BM + wc * 32 + 8 * fq;
        f32x4 pf[2][2][2]; u32x4 pb[2][2], outs[2][2]; float sums[2];
        load_group(0, row0, col0, pf, pb);
#pragma unroll
        for (int g = 0; g < 4; ++g) { const int ai = g >> 1;
            EPI_FENCE;
#pragma unroll
            for (int r = 0; r < 2; ++r) { const int m = (g & 1) * 2 + r; float ss = 0.f;
#pragma unroll
                for (int bj = 0; bj < 2; ++bj) { f32x4 b0, b1;
                    if (BASEF32) { b0 = pf[r][bj][0]; b1 = pf[r][bj][1]; }
                    else { const u32x4 w = pb[r][bj]; b0 = (f32x4){bflo(w.x), bfhi(w.x), bflo(w.y), bfhi(w.y)}; b1 = (f32x4){bflo(w.z), bfhi(w.z), bflo(w.w), bfhi(w.w)}; }
                    const f32x4 r0 = b0 + acc[ai][bj][m][0] * mul, r1 = b1 + acc[ai][bj][m][1] * mul; outs[r][bj] = pack8(r0, r1); ss += sumsq8(r0, r1); }
                sums[r] = ss; }
            if (g < 3) load_group(g + 1, row0, col0, pf, pb);
            EPI_FENCE;
#pragma unroll
            for (int r = 0; r < 2; ++r) { const int row = row0 + ai * HALF + ((g & 1) * 2 + r) * 16; const size_t off = (size_t)row * 1024 + col0;
#pragma unroll
                for (int bj = 0; bj < 2; ++bj) *(u32x4*)(out + off + bj * HALF) = outs[r][bj];
                float ss = sums[r]; ss += __shfl_xor(ss, 16); ss += __shfl_xor(ss, 32); if (fq == 0) atomicAdd(ssq + row, ss); }
        }
    }
};

struct EpiSwiGLU {
    EPI_FLAGS
    bf16_t* ACT; const float* ssq;
    __device__ __forceinline__ void operator()(EPI_ARGS) const {
        const int row0 = u.pm * BM + wr * 64 + fr, col0 = u.pn * HALF + wc * 32 + 8 * fq;
        float sq[2][4];
#pragma unroll
        for (int ai = 0; ai < 2; ++ai)
#pragma unroll
            for (int m = 0; m < 4; ++m) sq[ai][m] = ssq[row0 + ai * HALF + m * 16];
        EPI_FENCE;
#pragma unroll
        for (int ai = 0; ai < 2; ++ai)
#pragma unroll
            for (int m = 0; m < 4; ++m) { f32x4 r[2]; const float rs = rstd_of(sq[ai][m]);
#pragma unroll
                for (int n = 0; n < 2; ++n) { const f32x4 g = acc[ai][0][m][n] * rs, up = acc[ai][1][m][n] * rs;
#pragma unroll
                    for (int e = 0; e < 4; ++e) r[n][e] = g[e] * fast_sigmoid(g[e]) * up[e]; }
                *(u32x4*)(ACT + (size_t)(row0 + ai * HALF + m * 16) * 2816 + col0) = pack8(r[0], r[1]); }
    }
};

struct EpiPle {
    EPI_FLAGS
    const bf16_t* base; const bf16_t* PP; const float* ssq_in; bf16_t* outb; float* ssq_out; float mul;
    __device__ __forceinline__ void load_group(int g, int row0, int col0, u32x4 (&hb)[2][2], u32x4 (&pb)[2][2]) const {
#pragma unroll
        for (int r = 0; r < 2; ++r)
#pragma unroll
            for (int bj = 0; bj < 2; ++bj) { const size_t o = (size_t)(row0 + (g >> 1) * HALF + ((g & 1) * 2 + r) * 16) * 1024 + col0 + bj * HALF; hb[r][bj] = *(const u32x4*)(base + o); pb[r][bj] = *(const u32x4*)(PP + o); }
    }
    __device__ __forceinline__ void operator()(EPI_ARGS) const {
        const int row0 = u.pm * BM + wr * 64 + fr, col0 = u.pn * BM + wc * 32 + 8 * fq;
        float sq[2][4]; u32x4 hb[2][2], pb[2][2], outs[2][2]; float sums[2];
#pragma unroll
        for (int ai = 0; ai < 2; ++ai)
#pragma unroll
            for (int m = 0; m < 4; ++m) sq[ai][m] = ssq_in[row0 + ai * HALF + m * 16];
        load_group(0, row0, col0, hb, pb);
#pragma unroll
        for (int g = 0; g < 4; ++g) { const int ai = g >> 1;
            EPI_FENCE;
#pragma unroll
            for (int r = 0; r < 2; ++r) { const int m = (g & 1) * 2 + r; const float rs = rstd_of(sq[ai][m]); float ss = 0.f;
#pragma unroll
                for (int bj = 0; bj < 2; ++bj) { const u32x4 hw = hb[r][bj], pp = pb[r][bj];
                    const f32x4 h0 = {bflo(hw.x), bfhi(hw.x), bflo(hw.y), bfhi(hw.y)}, h1 = {bflo(hw.z), bfhi(hw.z), bflo(hw.w), bfhi(hw.w)};
                    const f32x4 a0 = acc[ai][bj][m][0] * rs, a1 = acc[ai][bj][m][1] * rs;
                    f32x4 p0 = {bflo(pp.x), bfhi(pp.x), bflo(pp.y), bfhi(pp.y)}, p1 = {bflo(pp.z), bfhi(pp.z), bflo(pp.w), bfhi(pp.w)}, g0, g1;
#pragma unroll
                    for (int e = 0; e < 4; ++e) { g0[e] = fast_sigmoid(a0[e]); g1[e] = fast_sigmoid(a1[e]); }
                    const f32x4 r0 = h0 + g0 * p0 * mul, r1 = h1 + g1 * p1 * mul;
                    outs[r][bj] = pack8(r0, r1); ss += sumsq8(r0, r1); }
                sums[r] = ss; }
            if (g < 3) load_group(g + 1, row0, col0, hb, pb);
            EPI_FENCE;
#pragma unroll
            for (int r = 0; r < 2; ++r) { const int row = row0 + ai * HALF + ((g & 1) * 2 + r) * 16; const size_t off = (size_t)row * 1024 + col0;
#pragma unroll
                for (int bj = 0; bj < 2; ++bj) *(u32x4*)(outb + off + bj * HALF) = outs[r][bj];
                float ss = sums[r]; ss += __shfl_xor(ss, 16); ss += __shfl_xor(ss, 32); if (fq == 0) atomicAdd(ssq_out + row, ss); }
        }
    }
};

template <class Epi, class Sched, bool ALIGN_EPI = false, bool SP2 = false>
__device__ __forceinline__ void gemm_phase(PG8_LAS unsigned char* lds, const Gemm g, const Sched& S, const Epi& E) {
    int tid_ = threadIdx.x; asm volatile("" : "+v"(tid_));
    const int tid = tid_, wid = __builtin_amdgcn_readfirstlane(tid >> 6), lane = tid & 63, wr = wid >> 2, wc = wid & 3, fr = lane & 15, fq = lane >> 4;
    const int K = g.K, nt = K / BK;
    unsigned voffA[2], voffB[2];
#pragma unroll
    for (int i = 0; i < 2; ++i) { int R, C; stage_rc(tid * 16 + i * 8192, R, C); const int Rb = Epi::PERM ? ((R & ~31) + perm32(R & 31)) : R;
        voffA[i] = (unsigned)(R * K + C) * 2u; voffB[i] = (unsigned)(Rb * K + C) * 2u; }
    const size_t kstep = (size_t)(BK * 2);
    const size_t hstep = (size_t)HALF * K * 2;
    const size_t tstep = 2 * hstep;
    const unsigned ldsw = (unsigned)wid * 1024u;
    const int aoff = lds_byte(wr * 64 + fr, fq * 8), boff = lds_byte(wc * 32 + fr, fq * 8);
#define PG8_SA(b, h) (((b) * 2 + (h)) * HTB)
#define PG8_SB(b, h) ((4 + (b) * 2 + (h)) * HTB)
#define PG8_STAGE(bufoff, gbase, voff) do { _Pragma("unroll") for (int _i = 0; _i < 2; ++_i) \
        __builtin_amdgcn_global_load_lds((const unsigned*)((const char*)(gbase) + (voff)[_i]), (PG8_LAS unsigned*)(lds + (bufoff) + ldsw + _i * 8192), 16, 0, 0); } while (0)
#define PG8_LDA(dst, b, h) do { _Pragma("unroll") for (int m = 0; m < 4; ++m) _Pragma("unroll") for (int k = 0; k < 2; ++k) dst[m][k] = *(const PG8_LAS bf16x8*)(lds + PG8_SA(b, h) + aoff + m * 2048 + k * 1024); } while (0)
#define PG8_LDB(dst, b, h) do { _Pragma("unroll") for (int n = 0; n < 2; ++n) _Pragma("unroll") for (int k = 0; k < 2; ++k) dst[n][k] = *(const PG8_LAS bf16x8*)(lds + PG8_SB(b, h) + boff + n * 2048 + k * 1024); } while (0)
#define PG8_MMA(ai, bj, At, Bt) do { __builtin_amdgcn_s_setprio(1); _Pragma("unroll") for (int m = 0; m < 4; ++m) _Pragma("unroll") for (int n = 0; n < 2; ++n) _Pragma("unroll") for (int k = 0; k < 2; ++k) \
        acc[ai][bj][m][n] = __builtin_amdgcn_mfma_f32_16x16x32_bf16(Bt[n][k], At[m][k], acc[ai][bj][m][n], 0, 0, 0); __builtin_amdgcn_s_setprio(0); } while (0)
#define PG8_WAIT_V(n) asm volatile("s_waitcnt vmcnt(" #n ")" ::: "memory")
#define PG8_WAIT_L(n) asm volatile("s_waitcnt lgkmcnt(" #n ")" ::: "memory")
#define PG8_BAR __builtin_amdgcn_s_barrier()
#define PG8_SCHED __builtin_amdgcn_sched_barrier(0)
    Unit cur, nxt; int ui = 0;
    if (!S.next(0, cur)) return;
    f32x4 acc[2][2][4][2];
#pragma unroll
    for (int a = 0; a < 2; ++a)
#pragma unroll
        for (int b = 0; b < 2; ++b)
#pragma unroll
            for (int m = 0; m < 4; ++m)
#pragma unroll
                for (int n = 0; n < 2; ++n) acc[a][b][m][n] = (f32x4){0.f, 0.f, 0.f, 0.f};
    bf16x8 At[4][2], B0[2][2], B1[2][2];
    const char* cA = (const char*)g.A + (size_t)cur.pm * tstep; const char* cB = (const char*)g.Bt + (size_t)cur.pn * tstep;
    S.a_ready(cur);
    if constexpr (SP2) {
        PG8_STAGE(PG8_SB(0, 0), cB, voffB); PG8_STAGE(PG8_SB(0, 1), cB + hstep, voffB); PG8_STAGE(PG8_SA(0, 0), cA, voffA); PG8_STAGE(PG8_SA(0, 1), cA + hstep, voffA);
        if (wr == 1) PG8_BAR;
        PG8_WAIT_V(2); PG8_BAR;
        PG8_STAGE(PG8_SB(1, 0), cB + kstep, voffB); PG8_STAGE(PG8_SA(1, 0), cA + kstep, voffA); PG8_STAGE(PG8_SB(1, 1), cB + hstep + kstep, voffB);
        PG8_WAIT_V(6); PG8_BAR;
    } else {
        PG8_STAGE(PG8_SB(0, 0), cB, voffB); PG8_STAGE(PG8_SA(0, 0), cA, voffA); PG8_STAGE(PG8_SB(0, 1), cB + hstep, voffB); PG8_STAGE(PG8_SA(0, 1), cA + hstep, voffA);
        if (wr == 1) PG8_BAR;
        PG8_WAIT_V(4); PG8_BAR;
        PG8_STAGE(PG8_SB(1, 0), cB + kstep, voffB); PG8_STAGE(PG8_SA(1, 0), cA + kstep, voffA); PG8_STAGE(PG8_SB(1, 1), cB + hstep + kstep, voffB);
        PG8_WAIT_V(6); PG8_BAR;
    }
    for (;;) {
        const bool has_next = S.next(ui + 1, nxt);
        const char* nA = has_next ? (const char*)g.A + (size_t)nxt.pm * tstep : cA; const char* nB = has_next ? (const char*)g.Bt + (size_t)nxt.pn * tstep : cB;
        for (int t = 0; t < nt; t += 2) {
            const bool last = (t == nt - 2);
            const char* a1 = cA + (size_t)(t + 1) * kstep;
            const char* a2 = last ? nA : cA + (size_t)(t + 2) * kstep; const char* b2 = last ? nB : cB + (size_t)(t + 2) * kstep;
            const char* a3 = a2 + kstep; const char* b3 = b2 + kstep;
            if (last && has_next) S.a_ready(nxt);
            if constexpr (SP2) {
            PG8_LDB(B0, 0, 0); PG8_LDB(B1, 0, 1); PG8_SCHED; PG8_LDA(At, 0, 0); PG8_STAGE(PG8_SA(1, 1), a1 + hstep, voffA);
            PG8_WAIT_V(8); PG8_WAIT_L(0); PG8_BAR; PG8_MMA(0, 0, At, B0); PG8_MMA(0, 1, At, B1); PG8_BAR; PG8_SCHED;
            PG8_LDA(At, 0, 1); PG8_STAGE(PG8_SB(0, 0), b2, voffB); PG8_STAGE(PG8_SB(0, 1), b2 + hstep, voffB); PG8_STAGE(PG8_SA(0, 0), a2, voffA);
            PG8_WAIT_V(8); PG8_WAIT_L(0); PG8_BAR; PG8_MMA(1, 0, At, B0); PG8_MMA(1, 1, At, B1); PG8_BAR; PG8_SCHED;
            PG8_LDB(B0, 1, 0); PG8_LDB(B1, 1, 1); PG8_SCHED; PG8_LDA(At, 1, 0); PG8_STAGE(PG8_SA(0, 1), a2 + hstep, voffA);
            PG8_WAIT_V(8); PG8_WAIT_L(0); PG8_BAR; PG8_MMA(0, 0, At, B0); PG8_MMA(0, 1, At, B1); PG8_BAR; PG8_SCHED;
            PG8_LDA(At, 1, 1); PG8_STAGE(PG8_SB(1, 0), b3, voffB); PG8_STAGE(PG8_SB(1, 1), b3 + hstep, voffB); PG8_STAGE(PG8_SA(1, 0), a3, voffA);
            PG8_WAIT_V(8); PG8_WAIT_L(0); PG8_BAR; PG8_MMA(1, 0, At, B0); PG8_MMA(1, 1, At, B1); PG8_BAR; PG8_SCHED;
            } else {
            PG8_LDB(B0, 0, 0); PG8_SCHED; PG8_LDA(At, 0, 0); PG8_STAGE(PG8_SA(1, 1), a1 + hstep, voffA);
            PG8_WAIT_L(8); PG8_BAR; PG8_WAIT_L(0); PG8_MMA(0, 0, At, B0); PG8_BAR; PG8_SCHED;
            PG8_LDB(B1, 0, 1); PG8_STAGE(PG8_SB(0, 0), b2, voffB);
            PG8_BAR; PG8_WAIT_L(0); PG8_MMA(0, 1, At, B1); PG8_BAR;
            PG8_LDA(At, 0, 1); PG8_STAGE(PG8_SA(0, 0), a2, voffA);
            PG8_BAR; PG8_WAIT_L(0); PG8_MMA(1, 0, At, B0); PG8_BAR; PG8_SCHED;
            PG8_STAGE(PG8_SB(0, 1), b2 + hstep, voffB);
            PG8_WAIT_V(6); PG8_BAR; PG8_MMA(1, 1, At, B1); PG8_BAR;
            PG8_LDB(B0, 1, 0); PG8_SCHED; PG8_LDA(At, 1, 0); PG8_STAGE(PG8_SA(0, 1), a2 + hstep, voffA);
            PG8_WAIT_L(8); PG8_BAR; PG8_WAIT_L(0); PG8_MMA(0, 0, At, B0); PG8_BAR; PG8_SCHED;
            PG8_LDB(B1, 1, 1); PG8_STAGE(PG8_SB(1, 0), b3, voffB);
            PG8_BAR; PG8_WAIT_L(0); PG8_MMA(0, 1, At, B1); PG8_BAR;
            PG8_LDA(At, 1, 1); PG8_STAGE(PG8_SA(1, 0), a3, voffA);
            PG8_BAR; PG8_WAIT_L(0); PG8_MMA(1, 0, At, B0); PG8_BAR; PG8_SCHED;
            PG8_STAGE(PG8_SB(1, 1), b3 + hstep, voffB);
            PG8_WAIT_V(6); PG8_BAR; PG8_MMA(1, 1, At, B1); PG8_BAR;
            }
        }
        if constexpr (ALIGN_EPI) { if (wr == 0) PG8_BAR; }
        if constexpr (!Epi::AFTER_DRAIN) { E(acc, cur, wr, wc, fr, fq); S.done(cur); }
        if (!has_next) break;
#pragma unroll
        for (int a = 0; a < 2; ++a)
#pragma unroll
            for (int b = 0; b < 2; ++b)
#pragma unroll
                for (int m = 0; m < 4; ++m)
#pragma unroll
                    for (int n = 0; n < 2; ++n) acc[a][b][m][n] = (f32x4){0.f, 0.f, 0.f, 0.f};
        cur = nxt; cA = nA; cB = nB; ++ui;
        if constexpr (ALIGN_EPI) { if (wr == 1) PG8_BAR; }
    }
    PG8_WAIT_V(0);
    if constexpr (!ALIGN_EPI) { if (wr == 0) PG8_BAR; }
    PG8_BAR;
    if constexpr (Epi::AFTER_DRAIN) { E.fused(acc, cur, wr, wc, fr, fq, lds, wid, lane); S.done(cur); }
#undef PG8_SA
#undef PG8_SB
#undef PG8_STAGE
#undef PG8_LDA
#undef PG8_LDB
#undef PG8_MMA
#undef PG8_WAIT_V
#undef PG8_WAIT_L
#undef PG8_BAR
#undef PG8_SCHED
}
}

using pg8::bf16_t; using pg8::bf16x8; using pg8::f32x4; using pg8::u32x4; using pg8::u32x2; using pg8::cvtpk;
typedef float f32x16 __attribute__((ext_vector_type(16)));
#define LAS __attribute__((address_space(3)))
#define DI __device__ __forceinline__
#define MFMA32(a, b, c) __builtin_amdgcn_mfma_f32_32x32x16_bf16((a), (b), (c), 0, 0, 0)
constexpr float LOG2E = 1.4426950408889634f;
constexpr int M = 16384, S = 8192, D = 1024, DFF = 2816, NWAVES = 8, NTHREADS = 512;
constexpr float EPS = 1e-6f;
constexpr size_t MiB = 1u << 20;
constexpr size_t WS_KSTAT = 0, WS_TOT = 4096, WS_BAR = 16384, WS_SSQ = 65536, WS_ZERO_BYTES = 65536;
constexpr size_t WS_ROPEC = 1 * MiB, WS_ROPES = 3 * MiB;
constexpr size_t WS_F = 5 * MiB;
constexpr size_t WS_WIN0 = 6 * MiB, WS_WOUT0 = 12 * MiB, WS_WIN1 = 14 * MiB, WS_WOUT1 = 17 * MiB, WS_WGU = 19 * MiB, WS_WDN = 41 * MiB, WS_WPP = 52 * MiB, WS_WPG = 53 * MiB;
constexpr size_t WGU_STRIDE = (size_t)2 * DFF * D, WDN_STRIDE = (size_t)D * DFF, WPP_STRIDE = (size_t)D * 256, WPG_STRIDE = (size_t)D * D;
constexpr size_t WS_PBF = 58 * MiB, WS_HN = 74 * MiB, WS_O = 106 * MiB, WS_QK = 138 * MiB, WS_VT = 202 * MiB, WS_ACT = 138 * MiB, WS_VT1 = 178 * MiB, WS_HB2 = 186 * MiB, WS_ACT1 = 106 * MiB, WS_PP1 = 218 * MiB, WS_END = 250 * MiB;
constexpr int RING_BYTES = 131072, LDS_BYTES = 135168;

struct Params {
    const float *x, *p; const int* pos;
    const float *norm_mix, *norm_ffn, *norm_ple, *norm_final, *ev_w_in, *ev_b_f, *ev_w_out, *od_w_in, *od_sinks, *od_w_out, *ffn_w_gate, *ffn_w_up, *ffn_w_down, *ple_w_proj, *ple_w_gate;
    float* out; unsigned char* ws; int ph_lo, ph_hi;
};

DI float wave_sum(float v) {
#pragma unroll
    for (int o = 1; o < 64; o <<= 1) v += __shfl_xor(v, o);
    return v;
}

#define XB_TMO      128
#define XB_XCNT(j)  (256  + 64 * (j))
#define XB_XSUB(j)  (1280 + 64 * (j))
#define XB_XGEN(j)  (2304 + 64 * (j))
#define XB_TOP      3328
#define XB_TOPGEN   3392
#define XCD_BAR_WORDS 3456
#define XB_SPIN_CAP (1u << 24)

__device__ __forceinline__ unsigned xb_ld(unsigned* p)              { return __hip_atomic_load(p, __ATOMIC_RELAXED, __HIP_MEMORY_SCOPE_AGENT); }
__device__ __forceinline__ unsigned xb_add(unsigned* p, unsigned v) { return __hip_atomic_fetch_add(p, v, __ATOMIC_RELAXED, __HIP_MEMORY_SCOPE_AGENT); }
__device__ __forceinline__ unsigned xb_xcc_id() { return (unsigned)__builtin_amdgcn_s_getreg((3 << 11) | 20) & 0xFu; }
#define XB_SPIN(cond, bar) do { unsigned _sp = 0; while (cond) { __builtin_amdgcn_s_sleep(1); \
    if ((++_sp & 255u) == 0u) { if (xb_ld(&(bar)[XB_TMO])) break; if (_sp > XB_SPIN_CAP) { atomicAdd(&(bar)[XB_TMO], 1u); break; } } } } while (0)

struct XcdBarrier {
    unsigned* bar; unsigned x;
    volatile LAS unsigned* st;
};

__device__ __forceinline__ XcdBarrier xcd_barrier_post(unsigned* bar, volatile LAS unsigned* st) {
    XcdBarrier b; b.bar = bar; b.x = xb_xcc_id(); b.st = st;
    if (threadIdx.x == 0) (void)xb_add(&bar[XB_XCNT(b.x)], 1u);
    return b;
}
__device__ __forceinline__ void xcd_barrier_complete(unsigned* bar, unsigned x, unsigned& nloc, unsigned& nx) {
    const unsigned G = gridDim.x * gridDim.y * gridDim.z;
    unsigned sum, cnt, mine, sp = 0u;
    for (;;) {
        sum = 0u; cnt = 0u; mine = 0u;
#pragma unroll
        for (unsigned j = 0; j < 16; ++j) { const unsigned c = xb_ld(&bar[XB_XCNT(j)]); sum += c; cnt += (c > 0u) ? 1u : 0u; mine = (j == x) ? c : mine; }
        if (sum == G) break;
        __builtin_amdgcn_s_sleep(1);
        if ((++sp & 255u) == 0u) { if (xb_ld(&bar[XB_TMO])) break; if (sp > XB_SPIN_CAP) { atomicAdd(&bar[XB_TMO], 1u); break; } }
    }
    nloc = mine > 0u ? mine : 1u; nx = cnt > 0u ? cnt : 1u;
}

__device__ __forceinline__ void xcd_barrier(const XcdBarrier& b) {
    asm volatile("s_waitcnt vmcnt(0)" ::: "memory");
    __syncthreads();
    if (threadIdx.x == 0) {
        unsigned* bar = b.bar;
        __builtin_amdgcn_s_waitcnt(0);
        unsigned nloc = b.st[0], nx = b.st[1];
        if (nloc == 0u) { xcd_barrier_complete(bar, b.x, nloc, nx); b.st[0] = nloc; b.st[1] = nx; }
        const unsigned old = xb_add(&bar[XB_XSUB(b.x)], 1u);
        const unsigned gen = old / nloc;
        if (old + 1u == (gen + 1u) * nloc) {
            __builtin_amdgcn_fence(__ATOMIC_RELEASE, "agent");
            asm volatile("s_waitcnt vmcnt(0)" ::: "memory");
            const unsigned og = xb_add(&bar[XB_TOP], 1u);
            const unsigned tg = og / nx;
            if (og + 1u == (tg + 1u) * nx) xb_add(&bar[XB_TOPGEN], 1u);
            else XB_SPIN(xb_ld(&bar[XB_TOPGEN]) == tg, bar);
            __builtin_amdgcn_fence(__ATOMIC_ACQUIRE, "agent");
            xb_add(&bar[XB_XGEN(b.x)], 1u);
            asm volatile("s_waitcnt vmcnt(0)" ::: "memory");
        } else {
            XB_SPIN(xb_ld(&bar[XB_XGEN(b.x)]) == gen, bar);
            __builtin_amdgcn_fence(__ATOMIC_ACQUIRE, "agent");
            asm volatile("s_waitcnt vmcnt(0)" ::: "memory");
        }
    }
    __syncthreads();
}

DI int dest_row(int mode, int n, int row_off) {
    if (mode == 1) return (n >> 7) * 256 + (n & 127) + row_off;
    if (mode == 2 && n < 1280) { const int j = n & 63, jj = j & 31, pos = 8 * (jj >> 2) + (jj & 3) + ((j >> 5) << 2); return (n & ~63) + pos; }
    return n + row_off;
}
struct TJob { const float* W; bf16_t* WT; const float* gk; int ldn, K, ncols, mode, row_off, item; };
DI void transpose_issue(const TJob& j, float (&t)[32], int lane) {
    const int nblk = j.ncols / 32, kb = j.item / nblk, nb = j.item % nblk, k0 = 64 * kb, n0 = 32 * nb;
    const float* Wp = j.W + (size_t)(k0 + (lane >> 5)) * j.ldn + n0 + (lane & 31);
#pragma unroll
    for (int i = 0; i < 32; ++i) t[i] = Wp[(size_t)(2 * i) * j.ldn];
}
DI void transpose_finish(const TJob& j, const float (&t)[32], LAS float* scr, int lane) {
    const int nblk = j.ncols / 32, kb = j.item / nblk, nb = j.item % nblk, k0 = 64 * kb, n0 = 32 * nb;
    const int c = lane & 7;
    f32x4 g0 = {1.f, 1.f, 1.f, 1.f}, g1 = g0;
    if (j.gk) { g0 = *(const f32x4*)(j.gk + k0 + 8 * c); g1 = *(const f32x4*)(j.gk + k0 + 8 * c + 4); }
#pragma unroll
    for (int i = 0; i < 32; ++i) scr[(2 * i + (lane >> 5)) * 33 + (lane & 31)] = t[i];
    asm volatile("s_waitcnt lgkmcnt(0)" ::: "memory");
#pragma unroll
    for (int q = 0; q < 4; ++q) { const int n = (lane >> 3) + 8 * q; const LAS float* s = scr + (8 * c) * 33 + n;
        u32x4 o; o.x = cvtpk(s[0 * 33] * g0[0], s[1 * 33] * g0[1]); o.y = cvtpk(s[2 * 33] * g0[2], s[3 * 33] * g0[3]); o.z = cvtpk(s[4 * 33] * g1[0], s[5 * 33] * g1[1]); o.w = cvtpk(s[6 * 33] * g1[2], s[7 * 33] * g1[3]);
        *(u32x4*)(j.WT + (size_t)dest_row(j.mode, n0 + n, j.row_off) * j.K + k0 + 8 * c) = o; }
    asm volatile("s_waitcnt lgkmcnt(0)" ::: "memory");
}

DI void rope_entry(int pos, int j, float& c, float& s) {
    const float inv = powf(10000.0f, -(float)j / 32.0f);
    const float angf = (float)pos * inv;
    const double a = (double)angf, kq = rint(a * 0.63661977236758134308);
    double r = fma(-kq, 1.57079632679489655800e+00, a); r = fma(-kq, 6.12323399573676603587e-17, r);
    const int q = ((int)kq) & 3; const double r2 = r * r;
    const double sp = r * (1.0 + r2 * (-1.0 / 6 + r2 * (1.0 / 120 + r2 * (-1.0 / 5040 + r2 * (1.0 / 362880 + r2 * (-1.0 / 39916800 + r2 * (1.0 / 6227020800.0)))))));
    const double cp = 1.0 + r2 * (-0.5 + r2 * (1.0 / 24 + r2 * (-1.0 / 720 + r2 * (1.0 / 40320 + r2 * (-1.0 / 3628800 + r2 * (1.0 / 479001600 + r2 * (-1.0 / 87178291200.0)))))));
    const double cc = (q == 0) ? cp : (q == 1) ? -sp : (q == 2) ? -cp : sp, ss = (q == 0) ? sp : (q == 1) ? cp : (q == 2) ? -sp : -cp;
    c = (float)cc; s = (float)ss;
}

template <bool GATES, bool OUTF32>
DI void norm_phase(const float* src, const float* __restrict__ g, void* dst, LAS unsigned char* lds, const float* __restrict__ w_in0, const float* __restrict__ b_f, float* F, float* tot, int tid, int lane, int wave) {
    LAS float* Wg = (LAS float*)lds; LAS float* lfb = (LAS float*)(lds + 32768);
    if (GATES) { for (int idx = tid; idx < 8192; idx += NTHREADS) Wg[(idx & 7) * 1024 + (idx >> 3)] = w_in0[(size_t)(idx >> 3) * 3080 + 3072 + (idx & 7)]; __syncthreads(); }
    f32x4 gv[4];
#pragma unroll
    for (int j = 0; j < 4; ++j) gv[j] = *(const f32x4*)(g + 4 * lane + 256 * j);
    for (int chunk = blockIdx.x; chunk < M / 64; chunk += gridDim.x) {
        constexpr int RB = OUTF32 ? 2 : 4;
#pragma unroll 1
        for (int rb = 0; rb < 8; rb += RB) {
        f32x4 v[RB][4];
#pragma unroll
        for (int rr = 0; rr < RB; ++rr) { const f32x4* xr = (const f32x4*)(src + (size_t)(chunk * 64 + wave * 8 + rb + rr) * D) + lane;
#pragma unroll
            for (int j = 0; j < 4; ++j) v[rr][j] = xr[64 * j]; }
#pragma unroll
        for (int rr = 0; rr < RB; ++rr) {
            const int row = chunk * 64 + wave * 8 + rb + rr;
            float ss = 0.f;
#pragma unroll
            for (int j = 0; j < 4; ++j) ss += (v[rr][j][0] * v[rr][j][0] + v[rr][j][1] * v[rr][j][1]) + (v[rr][j][2] * v[rr][j][2] + v[rr][j][3] * v[rr][j][3]);
            const float rstd = 1.0f / sqrtf(wave_sum(ss) * (1.0f / D) + EPS);
#pragma unroll
            for (int j = 0; j < 4; ++j) v[rr][j] = v[rr][j] * rstd * gv[j];
            if (OUTF32) { f32x4* o = (f32x4*)((float*)dst + (size_t)row * D) + lane;
#pragma unroll
                for (int j = 0; j < 4; ++j) o[64 * j] = v[rr][j];
            } else { u32x2* o = (u32x2*)((bf16_t*)dst + (size_t)row * D) + lane;
#pragma unroll
                for (int j = 0; j < 4; ++j) { u32x2 w; w.x = cvtpk(v[rr][j][0], v[rr][j][1]); w.y = cvtpk(v[rr][j][2], v[rr][j][3]); o[64 * j] = w; } }
            if (GATES) {
                float ga[8];
#pragma unroll
                for (int g8 = 0; g8 < 8; ++g8) { float a = 0.f;
#pragma unroll
                    for (int j = 0; j < 4; ++j) { const f32x4 w = *(const LAS f32x4*)(Wg + g8 * 1024 + 256 * j + 4 * lane); a += (w[0] * v[rr][j][0] + w[1] * v[rr][j][1]) + (w[2] * v[rr][j][2] + w[3] * v[rr][j][3]); }
                    ga[g8] = a; }
                const bool b0 = lane & 1, b1 = lane & 2, b2 = lane & 4;
                float k4[4], k2[2], k1;
#pragma unroll
                for (int e = 0; e < 4; ++e) { const float keep = b0 ? ga[4 + e] : ga[e], send = b0 ? ga[e] : ga[4 + e]; k4[e] = keep + __shfl_xor(send, 1); }
#pragma unroll
                for (int e = 0; e < 2; ++e) { const float keep = b1 ? k4[2 + e] : k4[e], send = b1 ? k4[e] : k4[2 + e]; k2[e] = keep + __shfl_xor(send, 2); }
                { const float keep = b2 ? k2[1] : k2[0], send = b2 ? k2[0] : k2[1]; k1 = keep + __shfl_xor(send, 4); }
                k1 += __shfl_xor(k1, 8); k1 += __shfl_xor(k1, 16); k1 += __shfl_xor(k1, 32);
                if (lane < 8) { const int gate = 4 * (lane & 1) + (lane & 2) + ((lane >> 2) & 1); const float x0 = k1 + b_f[gate];
                    lfb[(wave * 8 + rb + rr) * 8 + gate] = fminf(x0, 0.f) - __builtin_amdgcn_logf(1.0f + __builtin_amdgcn_exp2f(-fabsf(x0) * LOG2E)) * 0.6931471805599453f; }
            }
        }
        }
        if (GATES) {
            __syncthreads();
            if (tid < 8) { const int b = chunk >> 7, blk = chunk & 127; float run = 0.f; float* Fp = F + (size_t)(b * 8 + tid) * S + blk * 64;
                for (int r = 0; r < 64; ++r) { run += lfb[r * 8 + tid]; Fp[r] = run; }
                tot[(b * 8 + tid) * 128 + blk] = run; }
            __syncthreads();
        }
    }
}

#ifndef ATT_MINBLK
#define ATT_MINBLK 0
#endif
constexpr int ATT_NS = 13, ATT_KPITCH = 144, ATT_VPITCH = 80, ATT_VOFF = 32 * ATT_KPITCH, ATT_SLOT = ATT_VOFF + 64 * ATT_VPITCH, ATT_FLAGS = ATT_NS * ATT_SLOT;
template <int MODE  >
DI int attn_wg(const bf16_t* __restrict__ QK, const bf16_t* __restrict__ VT, bf16_t* __restrict__ O, const float* __restrict__ F, const unsigned* __restrict__ kstat, const float* __restrict__ sinks,
               int b, int h, int qg, int res_lo, bool first, bool more, bf16x8 (&qfN)[4], float& FqN, LAS unsigned char* lds, int tid, int lane, int wave) {
    constexpr int PITCH = (MODE == 2) ? 1280 : 2048;
    const int n = lane & 31, hh = lane >> 5, qt = qg * 8 + wave, q0 = qt * 32;
    const int qcol = (MODE == 1) ? 1024 + h * 64 : h * 64;
    const int kcol = (MODE == 0) ? 512 + h * 64 : (MODE == 1) ? 1536 + h * 64 : 1024 + (h >> 2) * 64;
    const int vhead = (MODE == 0) ? b * 16 + h : (MODE == 1) ? b * 16 + 8 + h : b * 4 + (h >> 2);
    const int ocol = (MODE == 1) ? 512 + h * 64 : h * 64;
    const size_t rowb = (size_t)b * S;
    const int ksw = (n & 0x13) | ((n & 4) << 1) | ((n & 8) >> 1);
    const bool isK = tid < 256; const int tv = tid - 256;
    const bf16_t* gsrc = isK ? QK + (rowb + (tid >> 3)) * PITCH + kcol + 8 * (tid & 7) : VT + ((size_t)vhead * 64 + (tv >> 2)) * S + 8 * (tv & 3);
    const size_t gstep = isK ? (size_t)32 * PITCH : (size_t)32;
    const int loff = isK ? (tid >> 3) * ATT_KPITCH + (tid & 7) * 16 : ATT_VOFF + (tv >> 2) * ATT_VPITCH + (tv & 3) * 16;
    volatile LAS int* flags = (volatile LAS int*)(lds + ATT_FLAGS);
    __syncthreads();
    if (tid < 8) flags[tid] = 0x7fffffff;
    { bf16x8 t[8];
#pragma unroll
      for (int j = 0; j < 8; ++j) { const int blk = qg * 8 + j; if (blk < res_lo || blk > res_lo + 12) t[j] = *(const bf16x8*)(gsrc + (size_t)blk * gstep); }
#pragma unroll
      for (int j = 0; j < 8; ++j) { const int blk = qg * 8 + j; if (blk < res_lo || blk > res_lo + 12) *(LAS bf16x8*)(lds + (blk % ATT_NS) * ATT_SLOT + loff) = t[j]; } }
    bf16x8 qf[4];
    const float* Fp = (MODE == 0) ? F + (size_t)(b * 8 + h) * S : F;
    { const bf16_t* Qp = QK + (rowb + q0 + n) * PITCH + qcol + 8 * hh;
      if (first) {
#pragma unroll
          for (int c = 0; c < 4; ++c) qfN[c] = *(const bf16x8*)(Qp + 16 * c);
          if (MODE == 0) FqN = Fp[q0 + n]; }
#pragma unroll
      for (int c = 0; c < 4; ++c) qf[c] = qfN[c];
    }
    float m_run = -1e30f, l_run = 0.f, carry = 0.f, cfac = 1.0f, Fq = 0.f, qkb = 0.f, sink2 = 0.f;
    if (MODE == 0) Fq = FqN;
    if (more) { const bf16_t* Qp = QK + (rowb + q0 - 256 + n) * PITCH + qcol + 8 * hh;
#pragma unroll
        for (int c = 0; c < 4; ++c) qfN[c] = *(const bf16x8*)(Qp + 16 * c);
        if (MODE == 0) FqN = Fp[q0 - 256 + n]; }
    if (MODE == 0) {
        float qs = 0.f;
#pragma unroll
        for (int c = 0; c < 4; ++c)
#pragma unroll
            for (int j = 0; j < 8; ++j) { const float v = __builtin_bit_cast(float, ((unsigned)(unsigned short)qf[c][j]) << 16); qs += v * v; }
        qs += __shfl_xor(qs, 32);
        const float kmax2 = __builtin_bit_cast(float, kstat[(b * 8 + h) * 2]) + __builtin_bit_cast(float, kstat[(b * 8 + h) * 2 + 1]);
        qkb = sqrtf(qs * kmax2) * 1.02f + 0.01f;
    }
    if (MODE == 2) { sink2 = sinks[h] * LOG2E; m_run = sink2; }
    f32x16 o0, o1;
#pragma unroll
    for (int r = 0; r < 16; ++r) { o0[r] = 0.f; o1[r] = 0.f; }
    const int kb_lo = (MODE == 2) ? (qt >= 4 ? qt - 4 : 0) : 0;
    constexpr int RATE = (MODE == 2) ? 2 : 1;
    const int nb_lo = (MODE == 2) ? (qg * 8 >= 8 ? qg * 8 - 8 : 0) : 0;
    bool done = false, posted = false;
    int lo_w = qg * 8;
    bf16x8 tn_a[RATE], tn_b[RATE]; f32x4 fkN[4]; float FrN = 0.f;
#define ATT_FLOAD(kb_) do { if (MODE == 0) { const int k0_ = (kb_) * 32; fkN[0] = *(const f32x4*)(Fp + k0_ + 8 * hh); fkN[1] = *(const f32x4*)(Fp + k0_ + 8 * hh + 4); fkN[2] = *(const f32x4*)(Fp + k0_ + 16 + 8 * hh); \
        fkN[3] = *(const f32x4*)(Fp + k0_ + 16 + 8 * hh + 4); FrN = Fp[k0_ > 0 ? k0_ - 1 : 0]; } } while (0)
#pragma unroll
    for (int r = 0; r < RATE; ++r) { const int lb_ = qg * 8 - 1 - r; tn_a[r] = *(const bf16x8*)(gsrc + (size_t)(lb_ >= nb_lo ? lb_ : nb_lo) * gstep); }
    ATT_FLOAD(qt);
    __syncthreads();
#define ATT_STEP(I, TO, TN) { \
        const int nb = qg * 8 - 1 - RATE * (I); \
_Pragma("unroll") \
        for (int r = 0; r < RATE; ++r) { const int lb_ = nb - RATE - r; TN[r] = *(const bf16x8*)(gsrc + (size_t)(lb_ >= nb_lo ? lb_ : nb_lo) * gstep); } \
        const int kb = qt - (I); \
        if (!done && kb < kb_lo) done = true; \
        if (!done) { \
            const LAS unsigned char* sl = lds + (kb % ATT_NS) * ATT_SLOT; \
            bf16x8 kf[4]; f32x4 fk[4]; \
_Pragma("unroll") \
            for (int c = 0; c < 4; ++c) { kf[c] = *(const LAS bf16x8*)(sl + ksw * ATT_KPITCH + c * 32 + hh * 16); fk[c] = fkN[c]; } \
            const LAS unsigned char* vp = sl + ATT_VOFF + n * ATT_VPITCH + hh * 16; \
            const bf16x8 v00 = *(const LAS bf16x8*)(vp), v01 = *(const LAS bf16x8*)(vp + 32), v10 = *(const LAS bf16x8*)(vp + 32 * ATT_VPITCH), v11 = *(const LAS bf16x8*)(vp + 32 * ATT_VPITCH + 32); \
            const float Fr = FrN; \
            ATT_FLOAD(kb > kb_lo ? kb - 1 : kb_lo); \
            f32x16 s; \
_Pragma("unroll") \
            for (int r = 0; r < 16; ++r) s[r] = 0.f; \
_Pragma("unroll") \
            for (int c = 0; c < 4; ++c) s = MFMA32(kf[c], qf[c], s); \
            float p[16]; \
            if (MODE == 0 || MODE == 2) { \
                if (MODE == 0) { \
_Pragma("unroll") \
                    for (int r = 0; r < 16; ++r) p[r] = s[r] + (Fq - fk[r >> 2][r & 3]); \
                } else { \
_Pragma("unroll") \
                    for (int r = 0; r < 16; ++r) p[r] = s[r]; \
                } \
                if (kb == qt) { \
_Pragma("unroll") \
                    for (int r = 0; r < 16; ++r) { const int kl = 16 * (r >> 3) + 8 * hh + (r & 7); if (kl > n) p[r] = -1e30f; } \
                } \
                if (MODE == 2 && kb == qt - 4) { \
_Pragma("unroll") \
                    for (int r = 0; r < 16; ++r) { const int kl = 16 * (r >> 3) + 8 * hh + (r & 7); if (kl <= n) p[r] = -1e30f; } \
                } \
                float mx = p[0]; \
_Pragma("unroll") \
                for (int r = 1; r < 16; ++r) mx = fmaxf(mx, p[r]); \
                mx = fmaxf(mx, __shfl_xor(mx, 32)); \
                const float mnew = fmaxf(m_run, mx), alpha = __builtin_amdgcn_exp2f(m_run - mnew); \
                float ps = 0.f; \
_Pragma("unroll") \
                for (int r = 0; r < 16; ++r) { p[r] = __builtin_amdgcn_exp2f(p[r] - mnew); ps += p[r]; } \
                l_run = l_run * alpha + ps; m_run = mnew; \
                if (!__all(alpha == 1.0f)) { _Pragma("unroll") for (int r = 0; r < 16; ++r) { o0[r] *= alpha; o1[r] *= alpha; } } \
            } else { \
                float om[16], ex[16], T[2]; \
_Pragma("unroll") \
                for (int r = 0; r < 16; ++r) { om[r] = __builtin_amdgcn_rcpf(1.0f + __builtin_amdgcn_exp2f(s[r])); p[r] = 1.0f - om[r]; } \
                if (kb == qt) { \
_Pragma("unroll") \
                    for (int r = 0; r < 16; ++r) { const int kl = 16 * (r >> 3) + 8 * hh + (r & 7); if (kl >= n) { om[r] = 1.0f; p[r] = 0.f; } } \
                } \
_Pragma("unroll") \
                for (int c = 0; c < 2; ++c) { float run = 1.0f; \
_Pragma("unroll") \
                    for (int j = 7; j >= 0; --j) { ex[8 * c + j] = run; run *= om[8 * c + j]; } \
                    T[c] = run; } \
                const float P0 = __shfl_xor(T[0], 32), P1 = __shfl_xor(T[1], 32); \
                const float off0 = cfac * (hh == 0 ? (P0 * T[1] * P1) : (P1 * T[1])), off1 = cfac * (hh == 0 ? P1 : 1.0f); \
_Pragma("unroll") \
                for (int r = 0; r < 16; ++r) p[r] = p[r] * ex[r] * (r < 8 ? off0 : off1); \
                const float tot = (T[0] * T[1]) * (P0 * P1); \
                cfac *= tot; carry += __builtin_amdgcn_logf(tot); \
            } \
            bf16x8 pf0, pf1; \
            { u32x4 w0, w1; w0.x = cvtpk(p[0], p[1]); w0.y = cvtpk(p[2], p[3]); w0.z = cvtpk(p[4], p[5]); w0.w = cvtpk(p[6], p[7]); \
              w1.x = cvtpk(p[8], p[9]); w1.y = cvtpk(p[10], p[11]); w1.z = cvtpk(p[12], p[13]); w1.w = cvtpk(p[14], p[15]); \
              pf0 = __builtin_bit_cast(bf16x8, w0); pf1 = __builtin_bit_cast(bf16x8, w1); } \
            o0 = MFMA32(v00, pf0, o0); o0 = MFMA32(v01, pf1, o0); o1 = MFMA32(v10, pf0, o1); o1 = MFMA32(v11, pf1, o1); \
            if (MODE == 0 && (I) >= ATT_MINBLK) { if (__all((qkb + (Fq - Fr) - m_run) < -152.0f)) done = true; } \
            if (MODE == 1 && (I) >= ATT_MINBLK) { if (__all(carry < -152.0f)) done = true; } \
            if (kb == kb_lo) done = true; \
        } \
        if (done && !posted) { posted = true; if (lane == 0) flags[wave] = (I); } \
_Pragma("unroll") \
        for (int r = 0; r < RATE; ++r) { if (nb - r >= nb_lo) { *(LAS bf16x8*)(lds + ((nb - r) % ATT_NS) * ATT_SLOT + loff) = TO[r]; lo_w = nb - r; }  } \
        __syncthreads(); \
        const int fl = flags[lane & 7]; \
        if (__all(fl <= (I))) break; \
    }
    for (int i2 = 0; ; i2 += 2) {
        ATT_STEP(i2, tn_a, tn_b)
        ATT_STEP(i2 + 1, tn_b, tn_a)
    }
#undef ATT_STEP
    float inv = 1.0f;
    if (MODE == 0 || MODE == 2) { float l = l_run + __shfl_xor(l_run, 32); if (MODE == 2) l += __builtin_amdgcn_exp2f(sink2 - m_run); inv = 1.0f / l; }
    bf16_t* Op = O + (rowb + q0 + n) * D + ocol + 4 * hh;
#pragma unroll
    for (int i = 0; i < 4; ++i) {
        u32x2 w; w.x = cvtpk(o0[4 * i] * inv, o0[4 * i + 1] * inv); w.y = cvtpk(o0[4 * i + 2] * inv, o0[4 * i + 3] * inv); *(u32x2*)(Op + 8 * i) = w;
        u32x2 y; y.x = cvtpk(o1[4 * i] * inv, o1[4 * i + 1] * inv); y.y = cvtpk(o1[4 * i + 2] * inv, o1[4 * i + 3] * inv); *(u32x2*)(Op + 32 + 8 * i) = y;
    }
    return lo_w;
}

#undef ATT_FLOAD
#define REP_P0 0
#define REP_GIN0 0
#define REP_ATT0 0
#define REP_GU 0
#define REP_SWA 0
#define REP_SYNC 0
#define ALIGN1 true
#define ALIGNM true
#define REP_T 0
#define REP_NG 0
#define REP_PR 0
#define REP_GOUT0 0
#define REP_DOWN0 0
#define REP_PG0 0
__global__ void __launch_bounds__(NTHREADS, 2) mk_fwd(Params P) {
    extern __shared__ __attribute__((aligned(16))) unsigned char lds_raw[];
    LAS unsigned char* lds = (LAS unsigned char*)lds_raw;
    cg::grid_group grid = cg::this_grid();
    const int G = gridDim.x, NGW = G * NWAVES, NGT = G * NTHREADS;
    if (threadIdx.x < 32) ((LAS unsigned*)(lds + RING_BYTES))[threadIdx.x] = 0u;
    __syncthreads();
    const XcdBarrier xbar = xcd_barrier_post((unsigned*)(P.ws + WS_BAR), (volatile LAS unsigned*)(lds + RING_BYTES));
    if (P.ph_hi < 0) grid.sync();
#define IDS int tid = threadIdx.x; asm volatile("" : "+v"(tid)); const int lane = tid & 63, wave = __builtin_amdgcn_readfirstlane(tid >> 6), gw = blockIdx.x * NWAVES + wave, gt = blockIdx.x * NTHREADS + tid; (void)gw; (void)gt; (void)lane;
    unsigned char* ws = P.ws;
    unsigned* kstat = (unsigned*)(ws + WS_KSTAT); float* tot = (float*)(ws + WS_TOT); float* ropeC = (float*)(ws + WS_ROPEC); float* ropeS = (float*)(ws + WS_ROPES); float* Fc = (float*)(ws + WS_F);
    bf16_t* Win0 = (bf16_t*)(ws + WS_WIN0); bf16_t* Wout0 = (bf16_t*)(ws + WS_WOUT0); bf16_t* Win1 = (bf16_t*)(ws + WS_WIN1); bf16_t* Wout1 = (bf16_t*)(ws + WS_WOUT1);
    bf16_t* Wgu = (bf16_t*)(ws + WS_WGU); bf16_t* Wdn = (bf16_t*)(ws + WS_WDN); bf16_t* Wpp = (bf16_t*)(ws + WS_WPP); bf16_t* Wpg = (bf16_t*)(ws + WS_WPG);
    bf16_t* pbf = (bf16_t*)(ws + WS_PBF); bf16_t* hn = (bf16_t*)(ws + WS_HN); bf16_t* Ob = (bf16_t*)(ws + WS_O); bf16_t* PP = Ob; bf16_t* QK = (bf16_t*)(ws + WS_QK); bf16_t* VT = (bf16_t*)(ws + WS_VT); bf16_t* ACT = (bf16_t*)(ws + WS_ACT);
    bf16_t* hb2 = (bf16_t*)(ws + WS_HB2); bf16_t* VT1 = (bf16_t*)(ws + WS_VT1); float* ssq = (float*)(ws + WS_SSQ); bf16_t* ACT1 = (bf16_t*)(ws + WS_ACT1); bf16_t* PP1 = (bf16_t*)(ws + WS_PP1);
    float* h = P.out;
    const int lo = P.ph_lo, hi = P.ph_hi;
#define IN(k) (lo <= (k) && (k) < hi)
#define SEAM(k) do { if (IN(k) && IN((k) + 1)) xcd_barrier(xbar); } while (0)
#define GEMM(EpiT, E, A_, B_, N_, K_) do { int k_ = (K_); asm volatile("" : "+s"(k_)); pg8::Gemm g_{A_, B_, M, N_, k_}; pg8::StaticOrder S_; S_.init(M, N_, G, (int)blockIdx.x); pg8::gemm_phase<EpiT, pg8::StaticOrder, ALIGNM, true>(lds, g_, S_, E); } while (0)
#define GEMM1(EpiT, E, A_, B_, N_, K_) do { int k_ = (K_); asm volatile("" : "+s"(k_)); pg8::Gemm g_{A_, B_, M, N_, k_}; pg8::StaticOrder S_; S_.init(M, N_, G, (int)blockIdx.x); pg8::gemm_phase<EpiT, pg8::StaticOrder, ALIGN1, true>(lds, g_, S_, E); } while (0)

#define GEMM_SUB(EpiT, E, A_, B_, N_, K_, c0_) do { const int c0v_ = (c0_); if ((int)blockIdx.x >= c0v_) { int k_ = (K_); asm volatile("" : "+s"(k_)); pg8::Gemm g_{A_, B_, M, N_, k_}; pg8::StaticOrder S_; S_.init(M, N_, G - c0v_, (int)blockIdx.x - c0v_); \
        pg8::gemm_phase<EpiT, pg8::StaticOrder, true, true>(lds, g_, S_, E); } } while (0)
    if (IN(0)) for (int rep_ = 0; rep_ <= REP_P0; ++rep_) { IDS
        if (rep_ > 0) xcd_barrier(xbar);
        if (blockIdx.x == 0 && tid < 32) kstat[tid] = 0u;
        for (int i = gt; i < 6 * M; i += NGT) ssq[i] = 0.f;
        LAS float* scr = (LAS float*)(lds + wave * 16384);
        constexpr int I_IN0 = 16 * 96, I_SQ = 16 * 32, I_IN1 = 16 * 48, I_FF = 16 * 88, I_DN = 44 * 32, I_PP = 4 * 32;
        constexpr int NITEMS = I_IN0 + I_SQ + I_IN1 + I_SQ + 4 * I_FF + 2 * I_DN + 2 * I_PP + 2 * I_SQ;
#define T_DECODE(it_, J) do { int r = (it_); \
            if (r < I_IN0) { J = TJob{P.ev_w_in, Win0, nullptr, 3080, D, 3072, 0, 0, r}; break; } r -= I_IN0; \
            if (r < I_SQ) { J = TJob{P.ev_w_out, Wout0, nullptr, D, D, D, 0, 0, r}; break; } r -= I_SQ; \
            if (r < I_IN1) { J = TJob{P.od_w_in, Win1, P.norm_mix + D, 1536, D, 1536, 2, 0, r}; break; } r -= I_IN1; \
            if (r < I_SQ) { J = TJob{P.od_w_out, Wout1, nullptr, D, D, D, 0, 0, r}; break; } r -= I_SQ; \
            if (r < 4 * I_FF) { const int which = r / I_FF, l = which >> 1, up = which & 1; J = TJob{(up ? P.ffn_w_up : P.ffn_w_gate) + (size_t)l * D * DFF, Wgu + l * WGU_STRIDE, P.norm_ffn + l * D, DFF, D, DFF, 1, up * 128, r % I_FF}; break; } r -= 4 * I_FF; \
            if (r < 2 * I_DN) { const int l = r / I_DN; J = TJob{P.ffn_w_down + (size_t)l * DFF * D, Wdn + l * WDN_STRIDE, nullptr, D, DFF, D, 0, 0, r % I_DN}; break; } r -= 2 * I_DN; \
            if (r < 2 * I_PP) { const int l = r / I_PP; J = TJob{P.ple_w_proj + (size_t)l * 256 * D, Wpp + l * WPP_STRIDE, nullptr, D, 256, D, 0, 0, r % I_PP}; break; } r -= 2 * I_PP; \
            { const int l = r / I_SQ; J = TJob{P.ple_w_gate + (size_t)l * D * D, Wpg + l * WPG_STRIDE, P.norm_ple + l * D, D, D, D, 0, 0, r % I_SQ}; } } while (0)
        for (int rt_ = 0; rt_ <= REP_T; ++rt_)
        {
            float tA[32], tB[32]; TJob jc, jn; int it = gw; bool have = it < NITEMS;
            if (have) { T_DECODE(it, jc); transpose_issue(jc, tA, lane); }
            while (have) {
                const int itn = it + NGW; const bool haven = itn < NITEMS;
                if (haven) { T_DECODE(itn, jn); transpose_issue(jn, tB, lane); }
                transpose_finish(jc, tA, scr, lane);
#pragma unroll
                for (int i = 0; i < 32; ++i) tA[i] = tB[i];
                jc = jn; it = itn; have = haven;
            }
        }
#undef T_DECODE
        for (int rp_ = 0; rp_ <= REP_PR; ++rp_)
        for (int i0 = gt; i0 < 2 * M * 256 / 8; i0 += 4 * NGT) { f32x4 a[4], c[4];
#pragma unroll
            for (int k = 0; k < 4; ++k) { const int i = i0 + k * NGT; if (i < 2 * M * 256 / 8) { a[k] = ((const f32x4*)P.p)[2 * i]; c[k] = ((const f32x4*)P.p)[2 * i + 1]; } }
#pragma unroll
            for (int k = 0; k < 4; ++k) { const int i = i0 + k * NGT; if (i < 2 * M * 256 / 8) ((u32x4*)pbf)[i] = pg8::pack8(a[k], c[k]); } }
        for (int i = gt; i < M * 32; i += NGT) { float c, s; rope_entry(P.pos[i >> 5], i & 31, c, s); ropeC[i] = c; ropeS[i] = s; }
        __syncthreads();
        for (int rn_ = 0; rn_ <= REP_NG; ++rn_) norm_phase<true, false>(P.x, P.norm_mix, hn, lds, P.ev_w_in, P.ev_b_f, Fc, tot, tid, lane, wave);
    }
    SEAM(0);
    if (IN(1)) { IDS
        LAS float* offs = (LAS float*)lds;
        for (int bh = blockIdx.x; bh < 16; bh += G) {
            if (tid < 128) offs[tid] = tot[bh * 128 + tid];
            __syncthreads();
            if (tid == 0) { float run = 0.f; for (int i = 0; i < 128; ++i) { const float t = offs[i]; offs[i] = run; run += t; } }
            __syncthreads();
            for (int s = tid; s < S; s += NTHREADS) Fc[(size_t)bh * S + s] = (Fc[(size_t)bh * S + s] + offs[s >> 6]) * LOG2E;
            __syncthreads();
        }
        pg8::EpiL0In E{QK, VT, kstat};
        for (int rep_ = 0; rep_ <= REP_GIN0; ++rep_) GEMM(pg8::EpiL0In, E, hn, Win0, 3072, D);
    }
    SEAM(1);
    if (IN(2)) for (int rep_ = 0; rep_ <= REP_ATT0; ++rep_) { IDS
        if (rep_ > 0) xcd_barrier(xbar);
        for (int ch = blockIdx.x; ch < 2 * 8 * 16; ch += G) {
            const int cc = ch >> 4, b = (ch >> 3) & 1, hd = ch & 7; bf16x8 qfN[4]; float FqN = 0.f; int res = 1 << 28;
            for (int q = 1; q >= 0; --q) res = attn_wg<0>(QK, VT, Ob, Fc, kstat, nullptr, b, hd, 2 * cc + q, res, q == 1, q > 0, qfN, FqN, lds, tid, lane, wave);
            res = 1 << 28;
            for (int q = 1; q >= 0; --q) res = attn_wg<1>(QK, VT, Ob, nullptr, nullptr, nullptr, b, hd, 2 * cc + q, res, q == 1, q > 0, qfN, FqN, lds, tid, lane, wave);
        }
        __syncthreads();
    }
    SEAM(2);
    if (IN(3)) { { pg8::EpiResid<true> E{P.x, nullptr, hn, Fc, 1.0f}; for (int rep_ = 0; rep_ < REP_GOUT0; ++rep_) GEMM1(pg8::EpiResid<true>, E, Ob, Wout0, D, D); }
                 pg8::EpiResid<true> E{P.x, nullptr, hn, ssq, 1.0f}; GEMM1(pg8::EpiResid<true>, E, Ob, Wout0, D, D); }
    SEAM(3);
    if (IN(4)) { { pg8::EpiSwiGLU E{ACT, ssq}; for (int rep_ = 0; rep_ <= REP_GU; ++rep_) GEMM(pg8::EpiSwiGLU, E, hn, Wgu, 2 * DFF, D); }
                 { pg8::EpiStore E{PP, D}; GEMM_SUB(pg8::EpiStore, E, pbf, Wpp, D, 256, (64 * 22) % G); } }
    SEAM(4);
    if (IN(5)) { { pg8::EpiResid<false> E{nullptr, hn, hn, Fc, 0.0f}; for (int rep_ = 0; rep_ < REP_DOWN0; ++rep_) GEMM1(pg8::EpiResid<false>, E, ACT, Wdn, D, DFF); }
                 pg8::EpiResid<false> E{nullptr, hn, hn, ssq + M, 1.0f}; GEMM1(pg8::EpiResid<false>, E, ACT, Wdn, D, DFF); }
    SEAM(5);
    if (IN(6)) { { pg8::EpiPle E{hn, PP, ssq + M, hb2, Fc, 0.0f}; for (int rep_ = 0; rep_ < REP_PG0; ++rep_) GEMM1(pg8::EpiPle, E, hn, Wpg, D, D); }
                 pg8::EpiPle E{hn, PP, ssq + M, hb2, ssq + 2 * M, 1.0f}; GEMM1(pg8::EpiPle, E, hn, Wpg, D, D); }
    SEAM(6);
    if (IN(7)) { { pg8::EpiL1In E{QK, VT1, ropeC, ropeS, ssq + 2 * M}; GEMM(pg8::EpiL1In, E, hb2, Win1, 1536, D); }
                 { pg8::EpiStore E{PP1, D}; GEMM_SUB(pg8::EpiStore, E, pbf + (size_t)M * 256, Wpp + WPP_STRIDE, D, 256, (64 * 6) % G); } }
    SEAM(7);
    if (IN(8)) for (int rep_ = 0; rep_ <= REP_SWA; ++rep_) { IDS
        if (rep_ > 0) xcd_barrier(xbar);
        for (int ch = blockIdx.x; ch < 2 * 16 * 8; ch += G) { const int c = ch >> 5, b = (ch >> 4) & 1, hd = ch & 15; int res = 1 << 28; bf16x8 qfN[4]; float FqN = 0.f;
            for (int q = 3; q >= 0; --q) res = attn_wg<2>(QK, VT1, Ob, nullptr, nullptr, P.od_sinks, b, hd, 4 * c + q, res, q == 3, q > 0, qfN, FqN, lds, tid, lane, wave); }
        __syncthreads();
    }
    SEAM(8);
    if (IN(9)) { pg8::EpiResid<false> E{nullptr, hb2, hn, ssq + 3 * M, 1.0f}; GEMM1(pg8::EpiResid<false>, E, Ob, Wout1, D, D); }
    SEAM(9);
    if (IN(10)) { pg8::EpiSwiGLU E{ACT1, ssq + 3 * M}; GEMM(pg8::EpiSwiGLU, E, hn, Wgu + WGU_STRIDE, 2 * DFF, D); }
    SEAM(10);
    if (IN(11)) { pg8::EpiResid<false> E{nullptr, hn, hn, ssq + 4 * M, 1.0f}; GEMM1(pg8::EpiResid<false>, E, ACT1, Wdn + WDN_STRIDE, D, DFF); }
    SEAM(11);
    if (IN(12)) { pg8::EpiPle E{hn, PP1, ssq + 4 * M, hb2, ssq + 5 * M, 1.0f}; GEMM1(pg8::EpiPle, E, hn, Wpg + WPG_STRIDE, D, D); }
    SEAM(12);
    for (int rep_ = 0; rep_ < REP_SYNC; ++rep_) xcd_barrier(xbar);
    if (IN(13)) { IDS
        f32x4 g4[4];
#pragma unroll
        for (int q = 0; q < 4; ++q) g4[q] = *(const f32x4*)(P.norm_final + 8 * lane + 512 * (q >> 1) + 4 * (q & 1));
        for (int r0 = gw * 8; r0 < M; r0 += NGW * 8) {
            u32x4 w[8][2];
#pragma unroll
            for (int rr = 0; rr < 8; ++rr) { const u32x4* hp = (const u32x4*)(hb2 + (size_t)(r0 + rr) * D) + lane; w[rr][0] = hp[0]; w[rr][1] = hp[64]; }
#pragma unroll
            for (int rr = 0; rr < 8; ++rr) { const float rs = pg8::row_rstd(ssq + 5 * M, r0 + rr); f32x4* op = (f32x4*)(h + (size_t)(r0 + rr) * D) + 2 * lane;
#pragma unroll
                for (int q = 0; q < 2; ++q) { const u32x4 x = w[rr][q];
                    const f32x4 a = {pg8::bflo(x.x), pg8::bfhi(x.x), pg8::bflo(x.y), pg8::bfhi(x.y)}, c = {pg8::bflo(x.z), pg8::bfhi(x.z), pg8::bflo(x.w), pg8::bfhi(x.w)};
                    op[128 * q] = a * rs * g4[2 * q]; op[128 * q + 1] = c * rs * g4[2 * q + 1]; } }
        }
    }
#undef IN
#undef SEAM
#undef GEMM
}

#ifndef MK_PER_PHASE
#define MK_PER_PHASE 0
#endif
constexpr int N_PHASES = 14;
extern "C" void kernel_launch(void* const* d_in, const int* in_sizes, int n_in, void* d_out, int out_size, void* d_ws, size_t ws_size, hipStream_t stream) {
    static int grid_blocks = 0;
    if (grid_blocks == 0) {
        if (n_in != 18 || out_size != M * D || ws_size < WS_END) { fprintf(stderr, "kernel_launch: unexpected shapes (n_in %d, out %d, ws %zu)\n", n_in, out_size, ws_size); grid_blocks = -1; return; }
        int dev = 0, cus = 0, per_cu = 0;
        hipGetDevice(&dev); hipDeviceGetAttribute(&cus, hipDeviceAttributeMultiprocessorCount, dev);
        if (hipFuncSetAttribute((const void*)mk_fwd, hipFuncAttributeMaxDynamicSharedMemorySize, LDS_BYTES) != hipSuccess) { fprintf(stderr, "kernel_launch: hipFuncSetAttribute failed\n"); grid_blocks = -1; return; }
        if (hipOccupancyMaxActiveBlocksPerMultiprocessor(&per_cu, (const void*)mk_fwd, NTHREADS, LDS_BYTES) != hipSuccess || per_cu < 1) { fprintf(stderr, "kernel_launch: occupancy query gave %d\n", per_cu); per_cu = 1; (void)hipGetLastError(); }
        grid_blocks = cus * 1;
    }
    if (grid_blocks < 0) return;
#define REP_LAUNCH 0
    for (int pass_ = 0; pass_ <= REP_LAUNCH; ++pass_) {
    if (hipMemsetAsync((char*)d_ws, 0, WS_ZERO_BYTES, stream) != hipSuccess) { fprintf(stderr, "kernel_launch: hipMemsetAsync failed\n"); return; }
    Params p{};
    p.x = (const float*)d_in[0]; p.p = (const float*)d_in[1]; p.pos = (const int*)d_in[2];
    p.norm_mix = (const float*)d_in[3]; p.norm_ffn = (const float*)d_in[4]; p.norm_ple = (const float*)d_in[5]; p.norm_final = (const float*)d_in[6];
    p.ev_w_in = (const float*)d_in[7]; p.ev_b_f = (const float*)d_in[8]; p.ev_w_out = (const float*)d_in[9]; p.od_w_in = (const float*)d_in[10]; p.od_sinks = (const float*)d_in[11]; p.od_w_out = (const float*)d_in[12];
    p.ffn_w_gate = (const float*)d_in[13]; p.ffn_w_up = (const float*)d_in[14]; p.ffn_w_down = (const float*)d_in[15]; p.ple_w_proj = (const float*)d_in[16]; p.ple_w_gate = (const float*)d_in[17];
    p.out = (float*)d_out; p.ws = (unsigned char*)d_ws;
#if MK_PER_PHASE
    for (int ph = 0; ph < N_PHASES; ++ph) {
        p.ph_lo = ph; p.ph_hi = ph + 1;
        void* args[] = {&p};
        hipError_t e = hipLaunchCooperativeKernel((const void*)mk_fwd, dim3(grid_blocks), dim3(NTHREADS), args, LDS_BYTES, stream);
        if (e != hipSuccess) { fprintf(stderr, "cooperative launch (phase %d) failed: %s (grid %d)\n", ph, hipGetErrorString(e), grid_blocks); break; }
    }
#else
    p.ph_lo = 0; p.ph_hi = N_PHASES;
    void* args[] = {&p};
    hipError_t e = hipLaunchCooperativeKernel((const void*)mk_fwd, dim3(grid_blocks), dim3(NTHREADS), args, LDS_BYTES, stream);
    if (e != hipSuccess) fprintf(stderr, "cooperative launch failed: %s (grid %d)\n", hipGetErrorString(e), grid_blocks);
#endif
    }
}
```

```cpp
#include <hip/hip_runtime.h>
#include <hip/hip_cooperative_groups.h>
#include <cstdio>
#include <cstdint>
#include <cmath>
namespace cg = cooperative_groups;
namespace pg8 {
#define PG8_LAS __attribute__((address_space(3)))
typedef unsigned short bf16_t;
typedef short bf16x8 __attribute__((ext_vector_type(8)));
typedef float f32x4 __attribute__((ext_vector_type(4)));
typedef unsigned u32x4 __attribute__((ext_vector_type(4)));
constexpr int BM = 256, BK = 64, HALF = 128, HTB = HALF * BK * 2  , STAGE_BYTES = 8 * HTB, NXCD = 8, WGM = 8;

__host__ __device__ __forceinline__ int lds_byte(int r, int c) { const int st = (r >> 4) * 2 + (c >> 5), rr = r & 15, cc = c & 31, ob = rr * 64 + cc * 2; return st * 1024 + (ob ^ (((ob >> 9) & 1) << 5)); }
__host__ __device__ __forceinline__ void stage_rc(int b, int& R, int& C) { const int st = b / 1024, sb = b % 1024, swz = sb ^ (((sb >> 9) & 1) << 5); R = (st >> 1) * 16 + swz / 64; C = (st & 1) * 32 + (swz % 64) / 2; }
__host__ __device__ __forceinline__ int perm32(int rho) { const int n = rho >> 4, i = rho & 15; return 8 * (i >> 2) + 4 * n + (i & 3); }

struct Unit { int pm, pn; };
struct Gemm { const bf16_t* A; const bf16_t* Bt; int M, N, K; };

struct StaticOrder {
    int nM, nN, nwg, G, c;
    __host__ __device__ void init(int M, int N, int G_, int c_) { nM = M / BM; nN = N / BM; nwg = nM * nN; G = G_; c = c_; }
    __host__ __device__ bool next(int i, Unit& u) const {
        const long L = (long)i * G + c; if (L >= nwg) return false;
        int wgid = (int)L; { const int q = nwg / NXCD, r = nwg % NXCD, xcd = wgid % NXCD, off = wgid / NXCD; wgid = (xcd < r ? xcd * (q + 1) : r * (q + 1) + (xcd - r) * q) + off; }
        const int nig = WGM * nN, gid = wgid / nig, fm = gid * WGM, gsz = (nM - fm) < WGM ? (nM - fm) : WGM;
        u.pm = fm + ((wgid % nig) % gsz); u.pn = (wgid % nig) / gsz; return true;
    }
    __device__ __forceinline__ void a_ready(const Unit&) const {}
    __device__ __forceinline__ void done(const Unit&) const {}
};

typedef float f32x2 __attribute__((ext_vector_type(2)));
typedef __bf16 bf16x2_t __attribute__((ext_vector_type(2)));
typedef unsigned u32x2 __attribute__((ext_vector_type(2)));
__device__ __forceinline__ unsigned cvtpk(float lo, float hi) { f32x2 v = {lo, hi}; bf16x2_t b = __builtin_convertvector(v, bf16x2_t); return __builtin_bit_cast(unsigned, b); }
__device__ __forceinline__ u32x4 pack8(f32x4 a, f32x4 b) { u32x4 w; w.x = cvtpk(a[0], a[1]); w.y = cvtpk(a[2], a[3]); w.z = cvtpk(b[0], b[1]); w.w = cvtpk(b[2], b[3]); return w; }
__device__ __forceinline__ float bflo(unsigned w) { return __builtin_bit_cast(float, w << 16); }
__device__ __forceinline__ float bfhi(unsigned w) { return __builtin_bit_cast(float, w & 0xffff0000u); }
__device__ __forceinline__ float fast_sigmoid(float x) { return __builtin_amdgcn_rcpf(1.0f + __builtin_amdgcn_exp2f(-x * 1.4426950408889634f)); }
__device__ __forceinline__ float row_rstd(const float* ssq, int row) { return __builtin_amdgcn_rsqf(ssq[row] * (1.0f / 1024.0f) + 1e-6f); }
__device__ __forceinline__ void st16_wt(void* p, u32x4 v) { asm volatile("global_store_dwordx4 %0, %1, off sc1\n\ts_nop 1" :: "v"(p), "v"(v) : "memory"); }
#ifndef WT_RESID
#define WT_RESID 0
#endif
#ifndef WT_WIDE
#define WT_WIDE 0
#endif
#ifndef WT_QK
#define WT_QK 0
#endif
#define EPI_ARGS const f32x4 (&acc)[2][2][4][2], const Unit& u, int wr, int wc, int fr, int fq
#define EPI_FLAGS static constexpr bool PERM = true, AFTER_DRAIN = false;
__device__ __forceinline__ void vt_store8(bf16_t* p, f32x4 a, f32x4 b) {
    const unsigned w0 = cvtpk(a[0], a[1]), w1 = cvtpk(a[2], a[3]), w2 = cvtpk(b[0], b[1]), w3 = cvtpk(b[2], b[3]);
    p[0 * 8192] = (bf16_t)(w0 & 0xffffu); p[1 * 8192] = (bf16_t)(w0 >> 16); p[2 * 8192] = (bf16_t)(w1 & 0xffffu); p[3 * 8192] = (bf16_t)(w1 >> 16);
    p[4 * 8192] = (bf16_t)(w2 & 0xffffu); p[5 * 8192] = (bf16_t)(w2 >> 16); p[6 * 8192] = (bf16_t)(w3 & 0xffffu); p[7 * 8192] = (bf16_t)(w3 >> 16);
}

struct EpiStore {
    EPI_FLAGS
    bf16_t* O; int ldc;
    __device__ __forceinline__ void operator()(EPI_ARGS) const {
        const int row0 = u.pm * BM + wr * 64 + fr, col0 = u.pn * BM + wc * 32 + 8 * fq;
#pragma unroll
        for (int ai = 0; ai < 2; ++ai)
#pragma unroll
            for (int m = 0; m < 4; ++m) { bf16_t* rowp = O + (size_t)(row0 + ai * HALF + m * 16) * ldc + col0;
#pragma unroll
                for (int bj = 0; bj < 2; ++bj) { if (WT_WIDE) st16_wt(rowp + bj * HALF, pack8(acc[ai][bj][m][0], acc[ai][bj][m][1])); else *(u32x4*)(rowp + bj * HALF) = pack8(acc[ai][bj][m][0], acc[ai][bj][m][1]); } }
    }
};

struct EpiL0In {
    EPI_FLAGS
    bf16_t* QK; bf16_t* VT; unsigned* kstat;
    __device__ __forceinline__ void operator()(EPI_ARGS) const {
        const int sec = u.pn >> 1, half = u.pn & 1, row0 = u.pm * BM + wr * 64 + fr, b = u.pm >> 5;
        if (sec == 2 || sec == 5) {
#pragma unroll
            for (int ai = 0; ai < 2; ++ai)
#pragma unroll
                for (int m = 0; m < 4; ++m) { const int s = (row0 + ai * HALF + m * 16) & 8191;
#pragma unroll
                    for (int bj = 0; bj < 2; ++bj) { const int colt = half * 256 + bj * 128 + wc * 32 + 8 * fq, head = (colt >> 6) + (sec == 5 ? 8 : 0), d0 = colt & 63;
                        vt_store8(VT + ((size_t)(b * 16 + head) * 64 + d0) * 8192 + s, acc[ai][bj][m][0], acc[ai][bj][m][1]); } }
        } else {
            const float sc = (sec == 0 || sec == 3) ? 0.125f * 1.4426950408889634f : 1.0f;
            const int cbase = (sec == 0 ? 0 : sec == 1 ? 512 : sec == 3 ? 1024 : 1536) + half * 256 + wc * 32 + 8 * fq;
#pragma unroll
            for (int ai = 0; ai < 2; ++ai)
#pragma unroll
                for (int m = 0; m < 4; ++m) { bf16_t* rowp = QK + (size_t)(row0 + ai * HALF + m * 16) * 2048 + cbase;
#pragma unroll
                    for (int bj = 0; bj < 2; ++bj) { if (WT_QK) st16_wt(rowp + bj * HALF, pack8(acc[ai][bj][m][0] * sc, acc[ai][bj][m][1] * sc)); else *(u32x4*)(rowp + bj * HALF) = pack8(acc[ai][bj][m][0] * sc, acc[ai][bj][m][1] * sc); } }
            if (sec == 1) {
#pragma unroll
                for (int bj = 0; bj < 2; ++bj) { float best = 0.f;
#pragma unroll
                    for (int ai = 0; ai < 2; ++ai)
#pragma unroll
                        for (int m = 0; m < 4; ++m) { const f32x4 a = acc[ai][bj][m][0], c = acc[ai][bj][m][1];
                            float ss = (a[0] * a[0] + a[1] * a[1]) + (a[2] * a[2] + a[3] * a[3]) + (c[0] * c[0] + c[1] * c[1]) + (c[2] * c[2] + c[3] * c[3]);
                            ss += __shfl_xor(ss, 16); ss += __shfl_xor(ss, 32); best = fmaxf(best, ss); }
                    best = fmaxf(best, __shfl_xor(best, 1)); best = fmaxf(best, __shfl_xor(best, 2)); best = fmaxf(best, __shfl_xor(best, 4)); best = fmaxf(best, __shfl_xor(best, 8));
                    if (fr == 0 && fq == 0) atomicMax(kstat + ((b * 8 + half * 4 + bj * 2 + (wc >> 1)) * 2 + (wc & 1)), __builtin_bit_cast(unsigned, best)); }
            }
        }
    }
};

struct EpiL1In {
    EPI_FLAGS
    bf16_t* QKV; bf16_t* VT; const float* ropeC; const float* ropeS; const float* ssq;
    __device__ __forceinline__ void operator()(EPI_ARGS) const {
        int fr_ = fr; asm volatile("" : "+v"(fr_));
        const int row0 = u.pm * BM + wr * 64 + fr_, b = u.pm >> 5;
        float sq[2][4];
#pragma unroll
        for (int ai = 0; ai < 2; ++ai)
#pragma unroll
            for (int m = 0; m < 4; ++m) sq[ai][m] = ssq[row0 + ai * HALF + m * 16];
        if (u.pn == 5) {
            asm volatile("" ::: "memory");
#pragma unroll
            for (int ai = 0; ai < 2; ++ai)
#pragma unroll
                for (int m = 0; m < 4; ++m) { const int s = (row0 + ai * HALF + m * 16) & 8191; const float rs = __builtin_amdgcn_rsqf(sq[ai][m] * (1.0f / 1024.0f) + 1e-6f);
#pragma unroll
                    for (int bj = 0; bj < 2; ++bj) { const int colt = bj * 128 + wc * 32 + 8 * fq, head = colt >> 6, d0 = colt & 63;
                        vt_store8(VT + ((size_t)(b * 4 + head) * 64 + d0) * 8192 + s, acc[ai][bj][m][0] * rs, acc[ai][bj][m][1] * rs); } }
        } else {
            const float sc = (u.pn < 4) ? 0.125f * 1.4426950408889634f : 1.0f;
            const int col0 = u.pn * BM + wc * 32 + 8 * fq, j0 = 4 * ((wc & 1) * 4 + fq);
            f32x4 csv[4], snv[4]; u32x4 outs[4][2];
#pragma unroll
            for (int m = 0; m < 4; ++m) { const int row = row0 + m * 16; csv[m] = *(const f32x4*)(ropeC + (size_t)row * 32 + j0); snv[m] = *(const f32x4*)(ropeS + (size_t)row * 32 + j0); }
#pragma unroll
            for (int ai = 0; ai < 2; ++ai) {
                asm volatile("" ::: "memory");
#pragma unroll
                for (int m = 0; m < 4; ++m) { const float rs = __builtin_amdgcn_rsqf(sq[ai][m] * (1.0f / 1024.0f) + 1e-6f) * sc; const f32x4 cs = csv[m] * rs, sn = snv[m] * rs;
#pragma unroll
                    for (int bj = 0; bj < 2; ++bj) { const f32x4 x1 = acc[ai][bj][m][0], x2 = acc[ai][bj][m][1]; outs[m][bj] = pack8(x1 * cs - x2 * sn, x2 * cs + x1 * sn); } }
                if (ai == 0) {
#pragma unroll
                    for (int m = 0; m < 4; ++m) { const int row = row0 + HALF + m * 16; csv[m] = *(const f32x4*)(ropeC + (size_t)row * 32 + j0); snv[m] = *(const f32x4*)(ropeS + (size_t)row * 32 + j0); } }
                asm volatile("" ::: "memory");
#pragma unroll
                for (int m = 0; m < 4; ++m) { bf16_t* rowp = QKV + (size_t)(row0 + ai * HALF + m * 16) * 1280 + col0;
#pragma unroll
                    for (int bj = 0; bj < 2; ++bj) *(u32x4*)(rowp + bj * HALF) = outs[m][bj]; }
            }
        }
    }
};

#define EPI_FENCE asm volatile("" ::: "memory")
__device__ __forceinline__ float rstd_of(float ssq_row) { return __builtin_amdgcn_rsqf(ssq_row * (1.0f / 1024.0f) + 1e-6f); }
__device__ __forceinline__ float sumsq8(f32x4 r0, f32x4 r1) { return (r0[0] * r0[0] + r0[1] * r0[1]) + (r0[2] * r0[2] + r0[3] * r0[3]) + (r1[0] * r1[0] + r1[1] * r1[1]) + (r1[2] * r1[2] + r1[3] * r1[3]); }

template <bool BASEF32> struct EpiResid {
    EPI_FLAGS
    const float* basef; const bf16_t* baseb; bf16_t* out; float* ssq; float mul;
    __device__ __forceinline__ void load_group(int g, int row0, int col0, f32x4 (&pf)[2][2][2], u32x4 (&pb)[2][2]) const {
#pragma unroll
        for (int r = 0; r < 2; ++r)
#pragma unroll
            for (int bj = 0; bj < 2; ++bj) { const size_t o = (size_t)(row0 + (g >> 1) * HALF + ((g & 1) * 2 + r) * 16) * 1024 + col0 + bj * HALF;
                if (BASEF32) { const f32x4* bp = (const f32x4*)(basef + o); pf[r][bj][0] = bp[0]; pf[r][bj][1] = bp[1]; } else pb[r][bj] = *(const u32x4*)(baseb + o); }
    }
    __device__ __forceinline__ void operator()(EPI_ARGS) const {
        const int row0 = u.pm * BM + wr * 64 + fr, col0 = u.pn * BM + wc * 32 + 8 * fq;
        f32x4 pf[2][2][2]; u32x4 pb[2][2], outs[2][2]; float sums[2];
        load_group(0, row0, col0, pf, pb);
#pragma unroll
        for (int g = 0; g < 4; ++g) { const int ai = g >> 1;
            EPI_FENCE;
#pragma unroll
            for (int r = 0; r < 2; ++r) { const int m = (g & 1) * 2 + r; float ss = 0.f;
#pragma unroll
                for (int bj = 0; bj < 2; ++bj) { f32x4 b0, b1;
                    if (BASEF32) { b0 = pf[r][bj][0]; b1 = pf[r][bj][1]; }
                    else { const u32x4 w = pb[r][bj]; b0 = (f32x4){bflo(w.x), bfhi(w.x), bflo(w.y), bfhi(w.y)}; b1 = (f32x4){bflo(w.z), bfhi(w.z), bflo(w.w), bfhi(w.w)}; }
                    const f32x4 r0 = b0 + acc[ai][bj][m][0] * mul, r1 = b1 + acc[ai][bj][m][1] * mul; outs[r][bj] = pack8(r0, r1); ss += sumsq8(r0, r1); }
                sums[r] = ss; }
            if (g < 3) load_group(g + 1, row0, col0, pf, pb);
            EPI_FENCE;
#pragma unroll
            for (int r = 0; r < 2; ++r) { const int row = row0 + ai * HALF + ((g & 1) * 2 + r) * 16; const size_t off = (size_t)row * 1024 + col0;
#pragma unroll
                for (int bj = 0; bj < 2; ++bj) *(u32x4*)(out + off + bj * HALF) = outs[r][bj];
                float ss = sums[r]; ss += __shfl_xor(ss, 16); ss += __shfl_xor(ss, 32); if (fq == 0) atomicAdd(ssq + row, ss); }
        }
    }
};

struct EpiSwiGLU {
    EPI_FLAGS
    bf16_t* ACT; const float* ssq;
    __device__ __forceinline__ void operator()(EPI_ARGS) const {
        const int row0 = u.pm * BM + wr * 64 + fr, col0 = u.pn * HALF + wc * 32 + 8 * fq;
        float sq[2][4];
#pragma unroll
        for (int ai = 0; ai < 2; ++ai)
#pragma unroll
            for (int m = 0; m < 4; ++m) sq[ai][m] = ssq[row0 + ai * HALF + m * 16];
        EPI_FENCE;
#pragma unroll
        for (int ai = 0; ai < 2; ++ai)
#pragma unroll
            for (int m = 0; m < 4; ++m) { f32x4 r[2]; const float rs = rstd_of(sq[ai][m]);
#pragma unroll
                for (int n = 0; n < 2; ++n) { const f32x4 g = acc[ai][0][m][n] * rs, up = acc[ai][1][m][n] * rs;
#pragma unroll
                    for (int e = 0; e < 4; ++e) r[n][e] = g[e] * fast_sigmoid(g[e]) * up[e]; }
                *(u32x4*)(ACT + (size_t)(row0 + ai * HALF + m * 16) * 2816 + col0) = pack8(r[0], r[1]); }
    }
};

struct EpiPle {
    EPI_FLAGS
    const bf16_t* base; const bf16_t* PP; const float* ssq_in; bf16_t* outb; float* ssq_out; float mul;
    __device__ __forceinline__ void load_group(int g, int row0, int col0, u32x4 (&hb)[2][2], u32x4 (&pb)[2][2]) const {
#pragma unroll
        for (int r = 0; r < 2; ++r)
#pragma unroll
            for (int bj = 0; bj < 2; ++bj) { const size_t o = (size_t)(row0 + (g >> 1) * HALF + ((g & 1) * 2 + r) * 16) * 1024 + col0 + bj * HALF; hb[r][bj] = *(const u32x4*)(base + o); pb[r][bj] = *(const u32x4*)(PP + o); }
    }
    __device__ __forceinline__ void operator()(EPI_ARGS) const {
        const int row0 = u.pm * BM + wr * 64 + fr, col0 = u.pn * BM + wc * 32 + 8 * fq;
        float sq[2][4]; u32x4 hb[2][2], pb[2][2], outs[2][2]; float sums[2];
#pragma unroll
        for (int ai = 0; ai < 2; ++ai)
#pragma unroll
            for (int m = 0; m < 4; ++m) sq[ai][m] = ssq_in[row0 + ai * HALF + m * 16];
        load_group(0, row0, col0, hb, pb);
#pragma unroll
        for (int g = 0; g < 4; ++g) { const int ai = g >> 1;
            EPI_FENCE;
#pragma unroll
            for (int r = 0; r < 2; ++r) { const int m = (g & 1) * 2 + r; const float rs = rstd_of(sq[ai][m]); float ss = 0.f;
#pragma unroll
                for (int bj = 0; bj < 2; ++bj) { const u32x4 hw = hb[r][bj], pp = pb[r][bj];
                    const f32x4 h0 = {bflo(hw.x), bfhi(hw.x), bflo(hw.y), bfhi(hw.y)}, h1 = {bflo(hw.z), bfhi(hw.z), bflo(hw.w), bfhi(hw.w)};
                    const f32x4 a0 = acc[ai][bj][m][0] * rs, a1 = acc[ai][bj][m][1] * rs;
                    f32x4 p0 = {bflo(pp.x), bfhi(pp.x), bflo(pp.y), bfhi(pp.y)}, p1 = {bflo(pp.z), bfhi(pp.z), bflo(pp.w), bfhi(pp.w)}, g0, g1;
#pragma unroll
                    for (int e = 0; e < 4; ++e) { g0[e] = fast_sigmoid(a0[e]); g1[e] = fast_sigmoid(a1[e]); }
                    const f32x4 r0 = h0 + g0 * p0 * mul, r1 = h1 + g1 * p1 * mul;
                    outs[r][bj] = pack8(r0, r1); ss += sumsq8(r0, r1); }
                sums[r] = ss; }
            if (g < 3) load_group(g + 1, row0, col0, hb, pb);
            EPI_FENCE;
#pragma unroll
            for (int r = 0; r < 2; ++r) { const int row = row0 + ai * HALF + ((g & 1) * 2 + r) * 16; const size_t off = (size_t)row * 1024 + col0;
#pragma unroll
                for (int bj = 0; bj < 2; ++bj) *(u32x4*)(outb + off + bj * HALF) = outs[r][bj];
                float ss = sums[r]; ss += __shfl_xor(ss, 16); ss += __shfl_xor(ss, 32); if (fq == 0) atomicAdd(ssq_out + row, ss); }
        }
    }
};

template <class Epi, class Sched, bool ALIGN_EPI = false, bool SP2 = false>
__device__ __forceinline__ void gemm_phase(PG8_LAS unsigned char* lds, const Gemm g, const Sched& S, const Epi& E) {
    int tid_ = threadIdx.x; asm volatile("" : "+v"(tid_));
    const int tid = tid_, wid = __builtin_amdgcn_readfirstlane(tid >> 6), lane = tid & 63, wr = wid >> 2, wc = wid & 3, fr = lane & 15, fq = lane >> 4;
    const int K = g.K, nt = K / BK;
    unsigned voffA[2], voffB[2];
#pragma unroll
    for (int i = 0; i < 2; ++i) { int R, C; stage_rc(tid * 16 + i * 8192, R, C); const int Rb = Epi::PERM ? ((R & ~31) + perm32(R & 31)) : R;
        voffA[i] = (unsigned)(R * K + C) * 2u; voffB[i] = (unsigned)(Rb * K + C) * 2u; }
    const size_t kstep = (size_t)(BK * 2);
    const size_t hstep = (size_t)HALF * K * 2;
    const size_t tstep = 2 * hstep;
    const unsigned ldsw = (unsigned)wid * 1024u;
    const int aoff = lds_byte(wr * 64 + fr, fq * 8), boff = lds_byte(wc * 32 + fr, fq * 8);
#define PG8_SA(b, h) (((b) * 2 + (h)) * HTB)
#define PG8_SB(b, h) ((4 + (b) * 2 + (h)) * HTB)
#define PG8_STAGE(bufoff, gbase, voff) do { _Pragma("unroll") for (int _i = 0; _i < 2; ++_i) \
        __builtin_amdgcn_global_load_lds((const unsigned*)((const char*)(gbase) + (voff)[_i]), (PG8_LAS unsigned*)(lds + (bufoff) + ldsw + _i * 8192), 16, 0, 0); } while (0)
#define PG8_LDA(dst, b, h) do { _Pragma("unroll") for (int m = 0; m < 4; ++m) _Pragma("unroll") for (int k = 0; k < 2; ++k) dst[m][k] = *(const PG8_LAS bf16x8*)(lds + PG8_SA(b, h) + aoff + m * 2048 + k * 1024); } while (0)
#define PG8_LDB(dst, b, h) do { _Pragma("unroll") for (int n = 0; n < 2; ++n) _Pragma("unroll") for (int k = 0; k < 2; ++k) dst[n][k] = *(const PG8_LAS bf16x8*)(lds + PG8_SB(b, h) + boff + n * 2048 + k * 1024); } while (0)
#define PG8_MMA(ai, bj, At, Bt) do { __builtin_amdgcn_s_setprio(1); _Pragma("unroll") for (int m = 0; m < 4; ++m) _Pragma("unroll") for (int n = 0; n < 2; ++n) _Pragma("unroll") for (int k = 0; k < 2; ++k) \
        acc[ai][bj][m][n] = __builtin_amdgcn_mfma_f32_16x16x32_bf16(Bt[n][k], At[m][k], acc[ai][bj][m][n], 0, 0, 0); __builtin_amdgcn_s_setprio(0); } while (0)
#define PG8_WAIT_V(n) asm volatile("s_waitcnt vmcnt(" #n ")" ::: "memory")
#define PG8_WAIT_L(n) asm volatile("s_waitcnt lgkmcnt(" #n ")" ::: "memory")
#define PG8_BAR __builtin_amdgcn_s_barrier()
#define PG8_SCHED __builtin_amdgcn_sched_barrier(0)
    Unit cur, nxt; int ui = 0;
    if (!S.next(0, cur)) return;
    f32x4 acc[2][2][4][2];
#pragma unroll
    for (int a = 0; a < 2; ++a)
#pragma unroll
        for (int b = 0; b < 2; ++b)
#pragma unroll
            for (int m = 0; m < 4; ++m)
#pragma unroll
                for (int n = 0; n < 2; ++n) acc[a][b][m][n] = (f32x4){0.f, 0.f, 0.f, 0.f};
    bf16x8 At[4][2], B0[2][2], B1[2][2];
    const char* cA = (const char*)g.A + (size_t)cur.pm * tstep; const char* cB = (const char*)g.Bt + (size_t)cur.pn * tstep;
    S.a_ready(cur);
    if constexpr (SP2) {
        PG8_STAGE(PG8_SB(0, 0), cB, voffB); PG8_STAGE(PG8_SB(0, 1), cB + hstep, voffB); PG8_STAGE(PG8_SA(0, 0), cA, voffA); PG8_STAGE(PG8_SA(0, 1), cA + hstep, voffA);
        if (wr == 1) PG8_BAR;
        PG8_WAIT_V(2); PG8_BAR;
        PG8_STAGE(PG8_SB(1, 0), cB + kstep, voffB); PG8_STAGE(PG8_SA(1, 0), cA + kstep, voffA); PG8_STAGE(PG8_SB(1, 1), cB + hstep + kstep, voffB);
        PG8_WAIT_V(6); PG8_BAR;
    } else {
        PG8_STAGE(PG8_SB(0, 0), cB, voffB); PG8_STAGE(PG8_SA(0, 0), cA, voffA); PG8_STAGE(PG8_SB(0, 1), cB + hstep, voffB); PG8_STAGE(PG8_SA(0, 1), cA + hstep, voffA);
        if (wr == 1) PG8_BAR;
        PG8_WAIT_V(4); PG8_BAR;
        PG8_STAGE(PG8_SB(1, 0), cB + kstep, voffB); PG8_STAGE(PG8_SA(1, 0), cA + kstep, voffA); PG8_STAGE(PG8_SB(1, 1), cB + hstep + kstep, voffB);
        PG8_WAIT_V(6); PG8_BAR;
    }
    for (;;) {
        const bool has_next = S.next(ui + 1, nxt);
        const char* nA = has_next ? (const char*)g.A + (size_t)nxt.pm * tstep : cA; const char* nB = has_next ? (const char*)g.Bt + (size_t)nxt.pn * tstep : cB;
        for (int t = 0; t < nt; t += 2) {
            const bool last = (t == nt - 2);
            const char* a1 = cA + (size_t)(t + 1) * kstep;
            const char* a2 = last ? nA : cA + (size_t)(t + 2) * kstep; const char* b2 = last ? nB : cB + (size_t)(t + 2) * kstep;
            const char* a3 = a2 + kstep; const char* b3 = b2 + kstep;
            if (last && has_next) S.a_ready(nxt);
            if constexpr (SP2) {
            PG8_LDB(B0, 0, 0); PG8_LDB(B1, 0, 1); PG8_SCHED; PG8_LDA(At, 0, 0); PG8_STAGE(PG8_SA(1, 1), a1 + hstep, voffA);
            PG8_WAIT_V(8); PG8_WAIT_L(0); PG8_BAR; PG8_MMA(0, 0, At, B0); PG8_MMA(0, 1, At, B1); PG8_BAR; PG8_SCHED;
            PG8_LDA(At, 0, 1); PG8_STAGE(PG8_SB(0, 0), b2, voffB); PG8_STAGE(PG8_SB(0, 1), b2 + hstep, voffB); PG8_STAGE(PG8_SA(0, 0), a2, voffA);
            PG8_WAIT_V(8); PG8_WAIT_L(0); PG8_BAR; PG8_MMA(1, 0, At, B0); PG8_MMA(1, 1, At, B1); PG8_BAR; PG8_SCHED;
            PG8_LDB(B0, 1, 0); PG8_LDB(B1, 1, 1); PG8_SCHED; PG8_LDA(At, 1, 0); PG8_STAGE(PG8_SA(0, 1), a2 + hstep, voffA);
            PG8_WAIT_V(8); PG8_WAIT_L(0); PG8_BAR; PG8_MMA(0, 0, At, B0); PG8_MMA(0, 1, At, B1); PG8_BAR; PG8_SCHED;
            PG8_LDA(At, 1, 1); PG8_STAGE(PG8_SB(1, 0), b3, voffB); PG8_STAGE(PG8_SB(1, 1), b3 + hstep, voffB); PG8_STAGE(PG8_SA(1, 0), a3, voffA);
            PG8_WAIT_V(8); PG8_WAIT_L(0); PG8_BAR; PG8_MMA(1, 0, At, B0); PG8_MMA(1, 1, At, B1); PG8_BAR; PG8_SCHED;
            } else {
            PG8_LDB(B0, 0, 0); PG8_SCHED; PG8_LDA(At, 0, 0); PG8_STAGE(PG8_SA(1, 1), a1 + hstep, voffA);
            PG8_WAIT_L(8); PG8_BAR; PG8_WAIT_L(0); PG8_MMA(0, 0, At, B0); PG8_BAR; PG8_SCHED;
            PG8_LDB(B1, 0, 1); PG8_STAGE(PG8_SB(0, 0), b2, voffB);
            PG8_BAR; PG8_WAIT_L(0); PG8_MMA(0, 1, At, B1); PG8_BAR;
            PG8_LDA(At, 0, 1); PG8_STAGE(PG8_SA(0, 0), a2, voffA);
            PG8_BAR; PG8_WAIT_L(0); PG8_MMA(1, 0, At, B0); PG8_BAR; PG8_SCHED;
            PG8_STAGE(PG8_SB(0, 1), b2 + hstep, voffB);
            PG8_WAIT_V(6); PG8_BAR; PG8_MMA(1, 1, At, B1); PG8_BAR;
            PG8_LDB(B0, 1, 0); PG8_SCHED; PG8_LDA(At, 1, 0); PG8_STAGE(PG8_SA(0, 1), a2 + hstep, voffA);
            PG8_WAIT_L(8); PG8_BAR; PG8_WAIT_L(0); PG8_MMA(0, 0, At, B0); PG8_BAR; PG8_SCHED;
            PG8_LDB(B1, 1, 1); PG8_STAGE(PG8_SB(1, 0), b3, voffB);
            PG8_BAR; PG8_WAIT_L(0); PG8_MMA(0, 1, At, B1); PG8_BAR;
            PG8_LDA(At, 1, 1); PG8_STAGE(PG8_SA(1, 0), a3, voffA);
            PG8_BAR; PG8_WAIT_L(0); PG8_MMA(1, 0, At, B0); PG8_BAR; PG8_SCHED;
            PG8_STAGE(PG8_SB(1, 1), b3 + hstep, voffB);
            PG8_WAIT_V(6); PG8_BAR; PG8_MMA(1, 1, At, B1); PG8_BAR;
            }
        }
        if constexpr (ALIGN_EPI) { if (wr == 0) PG8_BAR; }
        if constexpr (!Epi::AFTER_DRAIN) { E(acc, cur, wr, wc, fr, fq); S.done(cur); }
        if (!has_next) break;
#pragma unroll
        for (int a = 0; a < 2; ++a)
#pragma unroll
            for (int b = 0; b < 2; ++b)
#pragma unroll
                for (int m = 0; m < 4; ++m)
#pragma unroll
                    for (int n = 0; n < 2; ++n) acc[a][b][m][n] = (f32x4){0.f, 0.f, 0.f, 0.f};
        cur = nxt; cA = nA; cB = nB; ++ui;
        if constexpr (ALIGN_EPI) { if (wr == 1) PG8_BAR; }
    }
    PG8_WAIT_V(0);
    if constexpr (!ALIGN_EPI) { if (wr == 0) PG8_BAR; }
    PG8_BAR;
    if constexpr (Epi::AFTER_DRAIN) { E.fused(acc, cur, wr, wc, fr, fq, lds, wid, lane); S.done(cur); }
#undef PG8_SA
#undef PG8_SB
#undef PG8_STAGE
#undef PG8_LDA
#undef PG8_LDB
#undef PG8_MMA
#undef PG8_WAIT_V
#undef PG8_WAIT_L
#undef PG8_BAR
#undef PG8_SCHED
}
}

using pg8::bf16_t; using pg8::bf16x8; using pg8::f32x4; using pg8::u32x4; using pg8::u32x2; using pg8::cvtpk;
typedef float f32x16 __attribute__((ext_vector_type(16)));
#define LAS __attribute__((address_space(3)))
#define DI __device__ __forceinline__
#define MFMA32(a, b, c) __builtin_amdgcn_mfma_f32_32x32x16_bf16((a), (b), (c), 0, 0, 0)
constexpr float LOG2E = 1.4426950408889634f;
constexpr int M = 16384, S = 8192, D = 1024, DFF = 2816, NWAVES = 8, NTHREADS = 512;
constexpr float EPS = 1e-6f;
constexpr size_t MiB = 1u << 20;
constexpr size_t WS_KSTAT = 0, WS_TOT = 4096, WS_BAR = 16384, WS_SSQ = 65536, WS_ZERO_BYTES = 65536;
constexpr size_t WS_ROPEC = 1 * MiB, WS_ROPES = 3 * MiB;
constexpr size_t WS_F = 5 * MiB;
constexpr size_t WS_WIN0 = 6 * MiB, WS_WOUT0 = 12 * MiB, WS_WIN1 = 14 * MiB, WS_WOUT1 = 17 * MiB, WS_WGU = 19 * MiB, WS_WDN = 41 * MiB, WS_WPP = 52 * MiB, WS_WPG = 53 * MiB;
constexpr size_t WGU_STRIDE = (size_t)2 * DFF * D, WDN_STRIDE = (size_t)D * DFF, WPP_STRIDE = (size_t)D * 256, WPG_STRIDE = (size_t)D * D;
constexpr size_t WS_PBF = 58 * MiB, WS_HN = 74 * MiB, WS_O = 106 * MiB, WS_QK = 138 * MiB, WS_VT = 202 * MiB, WS_ACT = 138 * MiB, WS_VT1 = 178 * MiB, WS_HB2 = 186 * MiB, WS_ACT1 = 106 * MiB, WS_PP1 = 218 * MiB, WS_END = 250 * MiB;
constexpr int RING_BYTES = 131072, LDS_BYTES = 135168;

struct Params {
    const float *x, *p; const int* pos;
    const float *norm_mix, *norm_ffn, *norm_ple, *norm_final, *ev_w_in, *ev_b_f, *ev_w_out, *od_w_in, *od_sinks, *od_w_out, *ffn_w_gate, *ffn_w_up, *ffn_w_down, *ple_w_proj, *ple_w_gate;
    float* out; unsigned char* ws; int ph_lo, ph_hi;
};

DI float wave_sum(float v) {
#pragma unroll
    for (int o = 1; o < 64; o <<= 1) v += __shfl_xor(v, o);
    return v;
}

#define XB_TMO      128
#define XB_XCNT(j)  (256  + 64 * (j))
#define XB_XSUB(j)  (1280 + 64 * (j))
#define XB_XGEN(j)  (2304 + 64 * (j))
#define XB_TOP      3328
#define XB_TOPGEN   3392
#define XCD_BAR_WORDS 3456
#define XB_SPIN_CAP (1u << 24)

__device__ __forceinline__ unsigned xb_ld(unsigned* p)              { return __hip_atomic_load(p, __ATOMIC_RELAXED, __HIP_MEMORY_SCOPE_AGENT); }
__device__ __forceinline__ unsigned xb_add(unsigned* p, unsigned v) { return __hip_atomic_fetch_add(p, v, __ATOMIC_RELAXED, __HIP_MEMORY_SCOPE_AGENT); }
__device__ __forceinline__ unsigned xb_xcc_id() { return (unsigned)__builtin_amdgcn_s_getreg((3 << 11) | 20) & 0xFu; }
#define XB_SPIN(cond, bar) do { unsigned _sp = 0; while (cond) { __builtin_amdgcn_s_sleep(1); \
    if ((++_sp & 255u) == 0u) { if (xb_ld(&(bar)[XB_TMO])) break; if (_sp > XB_SPIN_CAP) { atomicAdd(&(bar)[XB_TMO], 1u); break; } } } } while (0)

struct XcdBarrier {
    unsigned* bar; unsigned x;
    volatile LAS unsigned* st;
};

__device__ __forceinline__ XcdBarrier xcd_barrier_post(unsigned* bar, volatile LAS unsigned* st) {
    XcdBarrier b; b.bar = bar; b.x = xb_xcc_id(); b.st = st;
    if (threadIdx.x == 0) (void)xb_add(&bar[XB_XCNT(b.x)], 1u);
    return b;
}
__device__ __forceinline__ void xcd_barrier_complete(unsigned* bar, unsigned x, unsigned& nloc, unsigned& nx) {
    const unsigned G = gridDim.x * gridDim.y * gridDim.z;
    unsigned sum, cnt, mine, sp = 0u;
    for (;;) {
        sum = 0u; cnt = 0u; mine = 0u;
#pragma unroll
        for (unsigned j = 0; j < 16; ++j) { const unsigned c = xb_ld(&bar[XB_XCNT(j)]); sum += c; cnt += (c > 0u) ? 1u : 0u; mine = (j == x) ? c : mine; }
        if (sum == G) break;
        __builtin_amdgcn_s_sleep(1);
        if ((++sp & 255u) == 0u) { if (xb_ld(&bar[XB_TMO])) break; if (sp > XB_SPIN_CAP) { atomicAdd(&bar[XB_TMO], 1u); break; } }
    }
    nloc = mine > 0u ? mine : 1u; nx = cnt > 0u ? cnt : 1u;
}

__device__ __forceinline__ void xcd_barrier(const XcdBarrier& b) {
    asm volatile("s_waitcnt vmcnt(0)" ::: "memory");
    __syncthreads();
    if (threadIdx.x == 0) {
        unsigned* bar = b.bar;
        __builtin_amdgcn_s_waitcnt(0);
        unsigned nloc = b.st[0], nx = b.st[1];
        if (nloc == 0u) { xcd_barrier_complete(bar, b.x, nloc, nx); b.st[0] = nloc; b.st[1] = nx; }
        const unsigned old = xb_add(&bar[XB_XSUB(b.x)], 1u);
        const unsigned gen = old / nloc;
        if (old + 1u == (gen + 1u) * nloc) {
            __builtin_amdgcn_fence(__ATOMIC_RELEASE, "agent");
            asm volatile("s_waitcnt vmcnt(0)" ::: "memory");
            const unsigned og = xb_add(&bar[XB_TOP], 1u);
            const unsigned tg = og / nx;
            if (og + 1u == (tg + 1u) * nx) xb_add(&bar[XB_TOPGEN], 1u);
            else XB_SPIN(xb_ld(&bar[XB_TOPGEN]) == tg, bar);
            __builtin_amdgcn_fence(__ATOMIC_ACQUIRE, "agent");
            xb_add(&bar[XB_XGEN(b.x)], 1u);
            asm volatile("s_waitcnt vmcnt(0)" ::: "memory");
        } else {
            XB_SPIN(xb_ld(&bar[XB_XGEN(b.x)]) == gen, bar);
            __builtin_amdgcn_fence(__ATOMIC_ACQUIRE, "agent");
            asm volatile("s_waitcnt vmcnt(0)" ::: "memory");
        }
    }
    __syncthreads();
}

DI int dest_row(int mode, int n, int row_off) {
    if (mode == 1) return (n >> 7) * 256 + (n & 127) + row_off;
    if (mode == 2 && n < 1280) { const int j = n & 63, jj = j & 31, pos = 8 * (jj >> 2) + (jj & 3) + ((j >> 5) << 2); return (n & ~63) + pos; }
    return n + row_off;
}
struct TJob { const float* W; bf16_t* WT; const float* gk; int ldn, K, ncols, mode, row_off, item; };
DI void transpose_issue(const TJob& j, float (&t)[32], int lane) {
    const int nblk = j.ncols / 32, kb = j.item / nblk, nb = j.item % nblk, k0 = 64 * kb, n0 = 32 * nb;
    const float* Wp = j.W + (size_t)(k0 + (lane >> 5)) * j.ldn + n0 + (lane & 31);
#pragma unroll
    for (int i = 0; i < 32; ++i) t[i] = __builtin_nontemporal_load(Wp + (size_t)(2 * i) * j.ldn);
}
DI void transpose_finish(const TJob& j, const float (&t)[32], LAS float* scr, int lane) {
    const int nblk = j.ncols / 32, kb = j.item / nblk, nb = j.item % nblk, k0 = 64 * kb, n0 = 32 * nb;
    const int c = lane & 7;
    f32x4 g0 = {1.f, 1.f, 1.f, 1.f}, g1 = g0;
    if (j.gk) { g0 = *(const f32x4*)(j.gk + k0 + 8 * c); g1 = *(const f32x4*)(j.gk + k0 + 8 * c + 4); }
#pragma unroll
    for (int i = 0; i < 32; ++i) scr[(2 * i + (lane >> 5)) * 33 + (lane & 31)] = t[i];
    asm volatile("s_waitcnt lgkmcnt(0)" ::: "memory");
#pragma unroll
    for (int q = 0; q < 4; ++q) { const int n = (lane >> 3) + 8 * q; const LAS float* s = scr + (8 * c) * 33 + n;
        u32x4 o; o.x = cvtpk(s[0 * 33] * g0[0], s[1 * 33] * g0[1]); o.y = cvtpk(s[2 * 33] * g0[2], s[3 * 33] * g0[3]); o.z = cvtpk(s[4 * 33] * g1[0], s[5 * 33] * g1[1]); o.w = cvtpk(s[6 * 33] * g1[2], s[7 * 33] * g1[3]);
        *(u32x4*)(j.WT + (size_t)dest_row(j.mode, n0 + n, j.row_off) * j.K + k0 + 8 * c) = o; }
    asm volatile("s_waitcnt lgkmcnt(0)" ::: "memory");
}

DI void rope_entry(int pos, int j, float& c, float& s) {
    const float inv = powf(10000.0f, -(float)j / 32.0f);
    const float angf = (float)pos * inv;
    const double a = (double)angf, kq = rint(a * 0.63661977236758134308);
    double r = fma(-kq, 1.57079632679489655800e+00, a); r = fma(-kq, 6.12323399573676603587e-17, r);
    const int q = ((int)kq) & 3; const double r2 = r * r;
    const double sp = r * (1.0 + r2 * (-1.0 / 6 + r2 * (1.0 / 120 + r2 * (-1.0 / 5040 + r2 * (1.0 / 362880 + r2 * (-1.0 / 39916800 + r2 * (1.0 / 6227020800.0)))))));
    const double cp = 1.0 + r2 * (-0.5 + r2 * (1.0 / 24 + r2 * (-1.0 / 720 + r2 * (1.0 / 40320 + r2 * (-1.0 / 3628800 + r2 * (1.0 / 479001600 + r2 * (-1.0 / 87178291200.0)))))));
    const double cc = (q == 0) ? cp : (q == 1) ? -sp : (q == 2) ? -cp : sp, ss = (q == 0) ? sp : (q == 1) ? cp : (q == 2) ? -sp : -cp;
    c = (float)cc; s = (float)ss;
}

template <bool GATES, bool OUTF32>
DI void norm_phase(const float* src, const float* __restrict__ g, void* dst, LAS unsigned char* lds, const float* __restrict__ w_in0, const float* __restrict__ b_f, float* F, float* tot, int tid, int lane, int wave) {
    LAS float* Wg = (LAS float*)lds; LAS float* lfb = (LAS float*)(lds + 32768);
    if (GATES) { for (int idx = tid; idx < 8192; idx += NTHREADS) Wg[(idx & 7) * 1024 + (idx >> 3)] = w_in0[(size_t)(idx >> 3) * 3080 + 3072 + (idx & 7)]; __syncthreads(); }
    f32x4 gv[4];
#pragma unroll
    for (int j = 0; j < 4; ++j) gv[j] = *(const f32x4*)(g + 4 * lane + 256 * j);
    for (int chunk = blockIdx.x; chunk < M / 64; chunk += gridDim.x) {
        constexpr int RB = OUTF32 ? 2 : 4;
#pragma unroll 1
        for (int rb = 0; rb < 8; rb += RB) {
        f32x4 v[RB][4];
#pragma unroll
        for (int rr = 0; rr < RB; ++rr) { const f32x4* xr = (const f32x4*)(src + (size_t)(chunk * 64 + wave * 8 + rb + rr) * D) + lane;
#pragma unroll
            for (int j = 0; j < 4; ++j) v[rr][j] = xr[64 * j]; }
#pragma unroll
        for (int rr = 0; rr < RB; ++rr) {
            const int row = chunk * 64 + wave * 8 + rb + rr;
            float ss = 0.f;
#pragma unroll
            for (int j = 0; j < 4; ++j) ss += (v[rr][j][0] * v[rr][j][0] + v[rr][j][1] * v[rr][j][1]) + (v[rr][j][2] * v[rr][j][2] + v[rr][j][3] * v[rr][j][3]);
            const float rstd = 1.0f / sqrtf(wave_sum(ss) * (1.0f / D) + EPS);
#pragma unroll
            for (int j = 0; j < 4; ++j) v[rr][j] = v[rr][j] * rstd * gv[j];
            if (OUTF32) { f32x4* o = (f32x4*)((float*)dst + (size_t)row * D) + lane;
#pragma unroll
                for (int j = 0; j < 4; ++j) o[64 * j] = v[rr][j];
            } else { u32x2* o = (u32x2*)((bf16_t*)dst + (size_t)row * D) + lane;
#pragma unroll
                for (int j = 0; j < 4; ++j) { u32x2 w; w.x = cvtpk(v[rr][j][0], v[rr][j][1]); w.y = cvtpk(v[rr][j][2], v[rr][j][3]); o[64 * j] = w; } }
            if (GATES) {
                float ga[8];
#pragma unroll
                for (int g8 = 0; g8 < 8; ++g8) { float a = 0.f;
#pragma unroll
                    for (int j = 0; j < 4; ++j) { const f32x4 w = *(const LAS f32x4*)(Wg + g8 * 1024 + 256 * j + 4 * lane); a += (w[0] * v[rr][j][0] + w[1] * v[rr][j][1]) + (w[2] * v[rr][j][2] + w[3] * v[rr][j][3]); }
                    ga[g8] = a; }
                const bool b0 = lane & 1, b1 = lane & 2, b2 = lane & 4;
                float k4[4], k2[2], k1;
#pragma unroll
                for (int e = 0; e < 4; ++e) { const float keep = b0 ? ga[4 + e] : ga[e], send = b0 ? ga[e] : ga[4 + e]; k4[e] = keep + __shfl_xor(send, 1); }
#pragma unroll
                for (int e = 0; e < 2; ++e) { const float keep = b1 ? k4[2 + e] : k4[e], send = b1 ? k4[e] : k4[2 + e]; k2[e] = keep + __shfl_xor(send, 2); }
                { const float keep = b2 ? k2[1] : k2[0], send = b2 ? k2[0] : k2[1]; k1 = keep + __shfl_xor(send, 4); }
                k1 += __shfl_xor(k1, 8); k1 += __shfl_xor(k1, 16); k1 += __shfl_xor(k1, 32);
                if (lane < 8) { const int gate = 4 * (lane & 1) + (lane & 2) + ((lane >> 2) & 1); const float x0 = k1 + b_f[gate];
                    lfb[(wave * 8 + rb + rr) * 8 + gate] = fminf(x0, 0.f) - __builtin_amdgcn_logf(1.0f + __builtin_amdgcn_exp2f(-fabsf(x0) * LOG2E)) * 0.6931471805599453f; }
            }
        }
        }
        if (GATES) {
            __syncthreads();
            if (tid < 8) { const int b = chunk >> 7, blk = chunk & 127; float run = 0.f; float* Fp = F + (size_t)(b * 8 + tid) * S + blk * 64;
                for (int r = 0; r < 64; ++r) { run += lfb[r * 8 + tid]; Fp[r] = run; }
                tot[(b * 8 + tid) * 128 + blk] = run; }
            __syncthreads();
        }
    }
}

#ifndef ATT_MINBLK
#define ATT_MINBLK 0
#endif
constexpr int ATT_NS = 13, ATT_KPITCH = 144, ATT_VPITCH = 80, ATT_VOFF = 32 * ATT_KPITCH, ATT_SLOT = ATT_VOFF + 64 * ATT_VPITCH, ATT_FLAGS = ATT_NS * ATT_SLOT;
template <int MODE  >
DI int attn_wg(const bf16_t* __restrict__ QK, const bf16_t* __restrict__ VT, bf16_t* __restrict__ O, const float* __restrict__ F, const unsigned* __restrict__ kstat, const float* __restrict__ sinks,
               int b, int h, int qg, int res_lo, bool first, bool more, bf16x8 (&qfN)[4], float& FqN, LAS unsigned char* lds, int tid, int lane, int wave) {
    constexpr int PITCH = (MODE == 2) ? 1280 : 2048;
    const int n = lane & 31, hh = lane >> 5, qt = qg * 8 + wave, q0 = qt * 32;
    const int qcol = (MODE == 1) ? 1024 + h * 64 : h * 64;
    const int kcol = (MODE == 0) ? 512 + h * 64 : (MODE == 1) ? 1536 + h * 64 : 1024 + (h >> 2) * 64;
    const int vhead = (MODE == 0) ? b * 16 + h : (MODE == 1) ? b * 16 + 8 + h : b * 4 + (h >> 2);
    const int ocol = (MODE == 1) ? 512 + h * 64 : h * 64;
    const size_t rowb = (size_t)b * S;
    const int ksw = (n & 0x13) | ((n & 4) << 1) | ((n & 8) >> 1);
    const bool isK = tid < 256; const int tv = tid - 256;
    const bf16_t* gsrc = isK ? QK + (rowb + (tid >> 3)) * PITCH + kcol + 8 * (tid & 7) : VT + ((size_t)vhead * 64 + (tv >> 2)) * S + 8 * (tv & 3);
    const size_t gstep = isK ? (size_t)32 * PITCH : (size_t)32;
    const int loff = isK ? (tid >> 3) * ATT_KPITCH + (tid & 7) * 16 : ATT_VOFF + (tv >> 2) * ATT_VPITCH + (tv & 3) * 16;
    volatile LAS int* flags = (volatile LAS int*)(lds + ATT_FLAGS);
    __syncthreads();
    if (tid < 8) flags[tid] = 0x7fffffff;
    { bf16x8 t[8];
#pragma unroll
      for (int j = 0; j < 8; ++j) { const int blk = qg * 8 + j; if (blk < res_lo || blk > res_lo + 12) t[j] = *(const bf16x8*)(gsrc + (size_t)blk * gstep); }
#pragma unroll
      for (int j = 0; j < 8; ++j) { const int blk = qg * 8 + j; if (blk < res_lo || blk > res_lo + 12) *(LAS bf16x8*)(lds + (blk % ATT_NS) * ATT_SLOT + loff) = t[j]; } }
    bf16x8 qf[4];
    const float* Fp = (MODE == 0) ? F + (size_t)(b * 8 + h) * S : F;
    { const bf16_t* Qp = QK + (rowb + q0 + n) * PITCH + qcol + 8 * hh;
      if (first) {
#pragma unroll
          for (int c = 0; c < 4; ++c) qfN[c] = *(const bf16x8*)(Qp + 16 * c);
          if (MODE == 0) FqN = Fp[q0 + n]; }
#pragma unroll
      for (int c = 0; c < 4; ++c) qf[c] = qfN[c];
    }
    float m_run = -1e30f, l_run = 0.f, carry = 0.f, cfac = 1.0f, Fq = 0.f, qkb = 0.f, sink2 = 0.f;
    if (MODE == 0) Fq = FqN;
    if (more) { const bf16_t* Qp = QK + (rowb + q0 - 256 + n) * PITCH + qcol + 8 * hh;
#pragma unroll
        for (int c = 0; c < 4; ++c) qfN[c] = *(const bf16x8*)(Qp + 16 * c);
        if (MODE == 0) FqN = Fp[q0 - 256 + n]; }
    if (MODE == 0) {
        float qs = 0.f;
#pragma unroll
        for (int c = 0; c < 4; ++c)
#pragma unroll
            for (int j = 0; j < 8; ++j) { const float v = __builtin_bit_cast(float, ((unsigned)(unsigned short)qf[c][j]) << 16); qs += v * v; }
        qs += __shfl_xor(qs, 32);
        const float kmax2 = __builtin_bit_cast(float, kstat[(b * 8 + h) * 2]) + __builtin_bit_cast(float, kstat[(b * 8 + h) * 2 + 1]);
        qkb = sqrtf(qs * kmax2) * 1.02f + 0.01f;
    }
    if (MODE == 2) { sink2 = sinks[h] * LOG2E; m_run = sink2; }
    f32x16 o0, o1;
#pragma unroll
    for (int r = 0; r < 16; ++r) { o0[r] = 0.f; o1[r] = 0.f; }
    const int kb_lo = (MODE == 2) ? (qt >= 4 ? qt - 4 : 0) : 0;
    constexpr int RATE = (MODE == 2) ? 2 : 1;
    const int nb_lo = (MODE == 2) ? (qg * 8 >= 8 ? qg * 8 - 8 : 0) : 0;
    bool done = false, posted = false;
    int lo_w = qg * 8;
    bf16x8 tn_a[RATE], tn_b[RATE]; f32x4 fkN[4]; float FrN = 0.f;
#define ATT_FLOAD(kb_) do { if (MODE == 0) { const int k0_ = (kb_) * 32; fkN[0] = *(const f32x4*)(Fp + k0_ + 8 * hh); fkN[1] = *(const f32x4*)(Fp + k0_ + 8 * hh + 4); fkN[2] = *(const f32x4*)(Fp + k0_ + 16 + 8 * hh); \
        fkN[3] = *(const f32x4*)(Fp + k0_ + 16 + 8 * hh + 4); FrN = Fp[k0_ > 0 ? k0_ - 1 : 0]; } } while (0)
#pragma unroll
    for (int r = 0; r < RATE; ++r) { const int lb_ = qg * 8 - 1 - r; tn_a[r] = *(const bf16x8*)(gsrc + (size_t)(lb_ >= nb_lo ? lb_ : nb_lo) * gstep); }
    ATT_FLOAD(qt);
    __syncthreads();
#define ATT_STEP(I, TO, TN) { \
        const int nb = qg * 8 - 1 - RATE * (I); \
_Pragma("unroll") \
        for (int r = 0; r < RATE; ++r) { const int lb_ = nb - RATE - r; TN[r] = *(const bf16x8*)(gsrc + (size_t)(lb_ >= nb_lo ? lb_ : nb_lo) * gstep); } \
        const int kb = qt - (I); \
        if (!done && kb < kb_lo) done = true; \
        if (!done) { \
            const LAS unsigned char* sl = lds + (kb % ATT_NS) * ATT_SLOT; \
            bf16x8 kf[4]; f32x4 fk[4]; \
_Pragma("unroll") \
            for (int c = 0; c < 4; ++c) { kf[c] = *(const LAS bf16x8*)(sl + ksw * ATT_KPITCH + c * 32 + hh * 16); fk[c] = fkN[c]; } \
            const LAS unsigned char* vp = sl + ATT_VOFF + n * ATT_VPITCH + hh * 16; \
            const bf16x8 v00 = *(const LAS bf16x8*)(vp), v01 = *(const LAS bf16x8*)(vp + 32), v10 = *(const LAS bf16x8*)(vp + 32 * ATT_VPITCH), v11 = *(const LAS bf16x8*)(vp + 32 * ATT_VPITCH + 32); \
            const float Fr = FrN; \
            ATT_FLOAD(kb > kb_lo ? kb - 1 : kb_lo); \
            f32x16 s; \
_Pragma("unroll") \
            for (int r = 0; r < 16; ++r) s[r] = 0.f; \
_Pragma("unroll") \
            for (int c = 0; c < 4; ++c) s = MFMA32(kf[c], qf[c], s); \
            float p[16]; \
            if (MODE == 0 || MODE == 2) { \
                if (MODE == 0) { \
_Pragma("unroll") \
                    for (int r = 0; r < 16; ++r) p[r] = s[r] + (Fq - fk[r >> 2][r & 3]); \
                } else { \
_Pragma("unroll") \
                    for (int r = 0; r < 16; ++r) p[r] = s[r]; \
                } \
                if (kb == qt) { \
_Pragma("unroll") \
                    for (int r = 0; r < 16; ++r) { const int kl = 16 * (r >> 3) + 8 * hh + (r & 7); if (kl > n) p[r] = -1e30f; } \
                } \
                if (MODE == 2 && kb == qt - 4) { \
_Pragma("unroll") \
                    for (int r = 0; r < 16; ++r) { const int kl = 16 * (r >> 3) + 8 * hh + (r & 7); if (kl <= n) p[r] = -1e30f; } \
                } \
                float mx = p[0]; \
_Pragma("unroll") \
                for (int r = 1; r < 16; ++r) mx = fmaxf(mx, p[r]); \
                mx = fmaxf(mx, __shfl_xor(mx, 32)); \
                const float mnew = fmaxf(m_run, mx), alpha = __builtin_amdgcn_exp2f(m_run - mnew); \
                float ps = 0.f; \
_Pragma("unroll") \
                for (int r = 0; r < 16; ++r) { p[r] = __builtin_amdgcn_exp2f(p[r] - mnew); ps += p[r]; } \
                l_run = l_run * alpha + ps; m_run = mnew; \
                if (!__all(alpha == 1.0f)) { _Pragma("unroll") for (int r = 0; r < 16; ++r) { o0[r] *= alpha; o1[r] *= alpha; } } \
            } else { \
                float om[16], ex[16], T[2]; \
_Pragma("unroll") \
                for (int r = 0; r < 16; ++r) { om[r] = __builtin_amdgcn_rcpf(1.0f + __builtin_amdgcn_exp2f(s[r])); p[r] = 1.0f - om[r]; } \
                if (kb == qt) { \
_Pragma("unroll") \
                    for (int r = 0; r < 16; ++r) { const int kl = 16 * (r >> 3) + 8 * hh + (r & 7); if (kl >= n) { om[r] = 1.0f; p[r] = 0.f; } } \
                } \
_Pragma("unroll") \
                for (int c = 0; c < 2; ++c) { float run = 1.0f; \
_Pragma("unroll") \
                    for (int j = 7; j >= 0; --j) { ex[8 * c + j] = run; run *= om[8 * c + j]; } \
                    T[c] = run; } \
                const float P0 = __shfl_xor(T[0], 32), P1 = __shfl_xor(T[1], 32); \
                const float off0 = cfac * (hh == 0 ? (P0 * T[1] * P1) : (P1 * T[1])), off1 = cfac * (hh == 0 ? P1 : 1.0f); \
_Pragma("unroll") \
                for (int r = 0; r < 16; ++r) p[r] = p[r] * ex[r] * (r < 8 ? off0 : off1); \
                const float tot = (T[0] * T[1]) * (P0 * P1); \
                cfac *= tot; carry += __builtin_amdgcn_logf(tot); \
            } \
            bf16x8 pf0, pf1; \
            { u32x4 w0, w1; w0.x = cvtpk(p[0], p[1]); w0.y = cvtpk(p[2], p[3]); w0.z = cvtpk(p[4], p[5]); w0.w = cvtpk(p[6], p[7]); \
              w1.x = cvtpk(p[8], p[9]); w1.y = cvtpk(p[10], p[11]); w1.z = cvtpk(p[12], p[13]); w1.w = cvtpk(p[14], p[15]); \
              pf0 = __builtin_bit_cast(bf16x8, w0); pf1 = __builtin_bit_cast(bf16x8, w1); } \
            o0 = MFMA32(v00, pf0, o0); o0 = MFMA32(v01, pf1, o0); o1 = MFMA32(v10, pf0, o1); o1 = MFMA32(v11, pf1, o1); \
            if (MODE == 0 && (I) >= ATT_MINBLK) { if (__all((qkb + (Fq - Fr) - m_run) < -152.0f)) done = true; } \
            if (MODE == 1 && (I) >= ATT_MINBLK) { if (__all(carry < -152.0f)) done = true; } \
            if (kb == kb_lo) done = true; \
        } \
        if (done && !posted) { posted = true; if (lane == 0) flags[wave] = (I); } \
_Pragma("unroll") \
        for (int r = 0; r < RATE; ++r) { if (nb - r >= nb_lo) { *(LAS bf16x8*)(lds + ((nb - r) % ATT_NS) * ATT_SLOT + loff) = TO[r]; lo_w = nb - r; }  } \
        __syncthreads(); \
        const int fl = flags[lane & 7]; \
        if (__all(fl <= (I))) break; \
    }
    for (int i2 = 0; ; i2 += 2) {
        ATT_STEP(i2, tn_a, tn_b)
        ATT_STEP(i2 + 1, tn_b, tn_a)
    }
#undef ATT_STEP
    float inv = 1.0f;
    if (MODE == 0 || MODE == 2) { float l = l_run + __shfl_xor(l_run, 32); if (MODE == 2) l += __builtin_amdgcn_exp2f(sink2 - m_run); inv = 1.0f / l; }
    bf16_t* Op = O + (rowb + q0 + n) * D + ocol + 4 * hh;
#pragma unroll
    for (int i = 0; i < 4; ++i) {
        u32x2 w; w.x = cvtpk(o0[4 * i] * inv, o0[4 * i + 1] * inv); w.y = cvtpk(o0[4 * i + 2] * inv, o0[4 * i + 3] * inv); *(u32x2*)(Op + 8 * i) = w;
        u32x2 y; y.x = cvtpk(o1[4 * i] * inv, o1[4 * i + 1] * inv); y.y = cvtpk(o1[4 * i + 2] * inv, o1[4 * i + 3] * inv); *(u32x2*)(Op + 32 + 8 * i) = y;
    }
    return lo_w;
}

#undef ATT_FLOAD
#define REP_P0 0
#define REP_GIN0 0
#define REP_ATT0 0
#define REP_GU 0
#define REP_SWA 0
#define REP_SYNC 0
#define ALIGN1 true
#define ALIGNM true
#define REP_T 0
#define REP_NG 0
#define REP_PR 0
#define REP_GOUT0 0
#define REP_DOWN0 0
#define REP_PG0 0
__global__ void __launch_bounds__(NTHREADS, 2) mk_fwd(Params P) {
    extern __shared__ __attribute__((aligned(16))) unsigned char lds_raw[];
    LAS unsigned char* lds = (LAS unsigned char*)lds_raw;
    cg::grid_group grid = cg::this_grid();
    const int G = gridDim.x, NGW = G * NWAVES, NGT = G * NTHREADS;
    if (threadIdx.x < 32) ((LAS unsigned*)(lds + RING_BYTES))[threadIdx.x] = 0u;
    __syncthreads();
    const XcdBarrier xbar = xcd_barrier_post((unsigned*)(P.ws + WS_BAR), (volatile LAS unsigned*)(lds + RING_BYTES));
    if (P.ph_hi < 0) grid.sync();
#define IDS int tid = threadIdx.x; asm volatile("" : "+v"(tid)); const int lane = tid & 63, wave = __builtin_amdgcn_readfirstlane(tid >> 6), gw = blockIdx.x * NWAVES + wave, gt = blockIdx.x * NTHREADS + tid; (void)gw; (void)gt; (void)lane;
    unsigned char* ws = P.ws;
    unsigned* kstat = (unsigned*)(ws + WS_KSTAT); float* tot = (float*)(ws + WS_TOT); float* ropeC = (float*)(ws + WS_ROPEC); float* ropeS = (float*)(ws + WS_ROPES); float* Fc = (float*)(ws + WS_F);
    bf16_t* Win0 = (bf16_t*)(ws + WS_WIN0); bf16_t* Wout0 = (bf16_t*)(ws + WS_WOUT0); bf16_t* Win1 = (bf16_t*)(ws + WS_WIN1); bf16_t* Wout1 = (bf16_t*)(ws + WS_WOUT1);
    bf16_t* Wgu = (bf16_t*)(ws + WS_WGU); bf16_t* Wdn = (bf16_t*)(ws + WS_WDN); bf16_t* Wpp = (bf16_t*)(ws + WS_WPP); bf16_t* Wpg = (bf16_t*)(ws + WS_WPG);
    bf16_t* pbf = (bf16_t*)(ws + WS_PBF); bf16_t* hn = (bf16_t*)(ws + WS_HN); bf16_t* Ob = (bf16_t*)(ws + WS_O); bf16_t* PP = Ob; bf16_t* QK = (bf16_t*)(ws + WS_QK); bf16_t* VT = (bf16_t*)(ws + WS_VT); bf16_t* ACT = (bf16_t*)(ws + WS_ACT);
    bf16_t* hb2 = (bf16_t*)(ws + WS_HB2); bf16_t* VT1 = (bf16_t*)(ws + WS_VT1); float* ssq = (float*)(ws + WS_SSQ); bf16_t* ACT1 = (bf16_t*)(ws + WS_ACT1); bf16_t* PP1 = (bf16_t*)(ws + WS_PP1);
    float* h = P.out;
    const int lo = P.ph_lo, hi = P.ph_hi;
#define IN(k) (lo <= (k) && (k) < hi)
#define SEAM(k) do { if (IN(k) && IN((k) + 1)) xcd_barrier(xbar); } while (0)
#define GEMM(EpiT, E, A_, B_, N_, K_) do { int k_ = (K_); asm volatile("" : "+s"(k_)); pg8::Gemm g_{A_, B_, M, N_, k_}; pg8::StaticOrder S_; S_.init(M, N_, G, (int)blockIdx.x); pg8::gemm_phase<EpiT, pg8::StaticOrder, ALIGNM, true>(lds, g_, S_, E); } while (0)
#define GEMM1(EpiT, E, A_, B_, N_, K_) do { int k_ = (K_); asm volatile("" : "+s"(k_)); pg8::Gemm g_{A_, B_, M, N_, k_}; pg8::StaticOrder S_; S_.init(M, N_, G, (int)blockIdx.x); pg8::gemm_phase<EpiT, pg8::StaticOrder, ALIGN1, true>(lds, g_, S_, E); } while (0)

#define GEMM_SUB(EpiT, E, A_, B_, N_, K_, c0_) do { const int c0v_ = (c0_); if ((int)blockIdx.x >= c0v_) { int k_ = (K_); asm volatile("" : "+s"(k_)); pg8::Gemm g_{A_, B_, M, N_, k_}; pg8::StaticOrder S_; S_.init(M, N_, G - c0v_, (int)blockIdx.x - c0v_); \
        pg8::gemm_phase<EpiT, pg8::StaticOrder, true, true>(lds, g_, S_, E); } } while (0)
    if (IN(0)) for (int rep_ = 0; rep_ <= REP_P0; ++rep_) { IDS
        if (rep_ > 0) xcd_barrier(xbar);
        if (blockIdx.x == 0 && tid < 32) kstat[tid] = 0u;
        for (int i = gt; i < 6 * M; i += NGT) ssq[i] = 0.f;
        LAS float* scr = (LAS float*)(lds + wave * 16384);
        constexpr int I_IN0 = 16 * 96, I_SQ = 16 * 32, I_IN1 = 16 * 48, I_FF = 16 * 88, I_DN = 44 * 32, I_PP = 4 * 32;
        constexpr int NITEMS = I_IN0 + I_SQ + I_IN1 + I_SQ + 4 * I_FF + 2 * I_DN + 2 * I_PP + 2 * I_SQ;
#define T_DECODE(it_, J) do { int r = (it_); \
            if (r < I_IN0) { J = TJob{P.ev_w_in, Win0, nullptr, 3080, D, 3072, 0, 0, r}; break; } r -= I_IN0; \
            if (r < I_SQ) { J = TJob{P.ev_w_out, Wout0, nullptr, D, D, D, 0, 0, r}; break; } r -= I_SQ; \
            if (r < I_IN1) { J = TJob{P.od_w_in, Win1, P.norm_mix + D, 1536, D, 1536, 2, 0, r}; break; } r -= I_IN1; \
            if (r < I_SQ) { J = TJob{P.od_w_out, Wout1, nullptr, D, D, D, 0, 0, r}; break; } r -= I_SQ; \
            if (r < 4 * I_FF) { const int which = r / I_FF, l = which >> 1, up = which & 1; J = TJob{(up ? P.ffn_w_up : P.ffn_w_gate) + (size_t)l * D * DFF, Wgu + l * WGU_STRIDE, P.norm_ffn + l * D, DFF, D, DFF, 1, up * 128, r % I_FF}; break; } r -= 4 * I_FF; \
            if (r < 2 * I_DN) { const int l = r / I_DN; J = TJob{P.ffn_w_down + (size_t)l * DFF * D, Wdn + l * WDN_STRIDE, nullptr, D, DFF, D, 0, 0, r % I_DN}; break; } r -= 2 * I_DN; \
            if (r < 2 * I_PP) { const int l = r / I_PP; J = TJob{P.ple_w_proj + (size_t)l * 256 * D, Wpp + l * WPP_STRIDE, nullptr, D, 256, D, 0, 0, r % I_PP}; break; } r -= 2 * I_PP; \
            { const int l = r / I_SQ; J = TJob{P.ple_w_gate + (size_t)l * D * D, Wpg + l * WPG_STRIDE, P.norm_ple + l * D, D, D, D, 0, 0, r % I_SQ}; } } while (0)
        for (int rt_ = 0; rt_ <= REP_T; ++rt_)
        {
            float tA[32], tB[32]; TJob jc, jn; int it = gw; bool have = it < NITEMS;
            if (have) { T_DECODE(it, jc); transpose_issue(jc, tA, lane); }
            while (have) {
                const int itn = it + NGW; const bool haven = itn < NITEMS;
                if (haven) { T_DECODE(itn, jn); transpose_issue(jn, tB, lane); }
                transpose_finish(jc, tA, scr, lane);
#pragma unroll
                for (int i = 0; i < 32; ++i) tA[i] = tB[i];
                jc = jn; it = itn; have = haven;
            }
        }
#undef T_DECODE
        for (int rp_ = 0; rp_ <= REP_PR; ++rp_)
        for (int i0 = gt; i0 < 2 * M * 256 / 8; i0 += 4 * NGT) { f32x4 a[4], c[4];
#pragma unroll
            for (int k = 0; k < 4; ++k) { const int i = i0 + k * NGT; if (i < 2 * M * 256 / 8) { a[k] = __builtin_nontemporal_load((const f32x4*)P.p + 2 * i); c[k] = __builtin_nontemporal_load((const f32x4*)P.p + 2 * i + 1); } }
#pragma unroll
            for (int k = 0; k < 4; ++k) { const int i = i0 + k * NGT; if (i < 2 * M * 256 / 8) ((u32x4*)pbf)[i] = pg8::pack8(a[k], c[k]); } }
        for (int i = gt; i < M * 32; i += NGT) { float c, s; rope_entry(P.pos[i >> 5], i & 31, c, s); ropeC[i] = c; ropeS[i] = s; }
        __syncthreads();
        for (int rn_ = 0; rn_ <= REP_NG; ++rn_) norm_phase<true, false>(P.x, P.norm_mix, hn, lds, P.ev_w_in, P.ev_b_f, Fc, tot, tid, lane, wave);
    }
    SEAM(0);
    if (IN(1)) { IDS
        LAS float* offs = (LAS float*)lds;
        for (int bh = blockIdx.x; bh < 16; bh += G) {
            if (tid < 128) offs[tid] = tot[bh * 128 + tid];
            __syncthreads();
            if (tid == 0) { float run = 0.f; for (int i = 0; i < 128; ++i) { const float t = offs[i]; offs[i] = run; run += t; } }
            __syncthreads();
            for (int s = tid; s < S; s += NTHREADS) Fc[(size_t)bh * S + s] = (Fc[(size_t)bh * S + s] + offs[s >> 6]) * LOG2E;
            __syncthreads();
        }
        pg8::EpiL0In E{QK, VT, kstat};
        for (int rep_ = 0; rep_ <= REP_GIN0; ++rep_) GEMM(pg8::EpiL0In, E, hn, Win0, 3072, D);
    }
    SEAM(1);
    if (IN(2)) for (int rep_ = 0; rep_ <= REP_ATT0; ++rep_) { IDS
        if (rep_ > 0) xcd_barrier(xbar);
        for (int ch = blockIdx.x; ch < 2 * 8 * 16; ch += G) {
            const int cc = ch >> 4, b = (ch >> 3) & 1, hd = ch & 7; bf16x8 qfN[4]; float FqN = 0.f; int res = 1 << 28;
            for (int q = 1; q >= 0; --q) res = attn_wg<0>(QK, VT, Ob, Fc, kstat, nullptr, b, hd, 2 * cc + q, res, q == 1, q > 0, qfN, FqN, lds, tid, lane, wave);
            res = 1 << 28;
            for (int q = 1; q >= 0; --q) res = attn_wg<1>(QK, VT, Ob, nullptr, nullptr, nullptr, b, hd, 2 * cc + q, res, q == 1, q > 0, qfN, FqN, lds, tid, lane, wave);
        }
        __syncthreads();
    }
    SEAM(2);
    if (IN(3)) { { pg8::EpiResid<true> E{P.x, nullptr, hn, Fc, 1.0f}; for (int rep_ = 0; rep_ < REP_GOUT0; ++rep_) GEMM1(pg8::EpiResid<true>, E, Ob, Wout0, D, D); }
                 pg8::EpiResid<true> E{P.x, nullptr, hn, ssq, 1.0f}; GEMM1(pg8::EpiResid<true>, E, Ob, Wout0, D, D); }
    SEAM(3);
    if (IN(4)) { { pg8::EpiSwiGLU E{ACT, ssq}; for (int rep_ = 0; rep_ <= REP_GU; ++rep_) GEMM(pg8::EpiSwiGLU, E, hn, Wgu, 2 * DFF, D); }
                 { pg8::EpiStore E{PP, D}; GEMM_SUB(pg8::EpiStore, E, pbf, Wpp, D, 256, (64 * 22) % G); } }
    SEAM(4);
    if (IN(5)) { { pg8::EpiResid<false> E{nullptr, hn, hn, Fc, 0.0f}; for (int rep_ = 0; rep_ < REP_DOWN0; ++rep_) GEMM1(pg8::EpiResid<false>, E, ACT, Wdn, D, DFF); }
                 pg8::EpiResid<false> E{nullptr, hn, hn, ssq + M, 1.0f}; GEMM1(pg8::EpiResid<false>, E, ACT, Wdn, D, DFF); }
    SEAM(5);
    if (IN(6)) { { pg8::EpiPle E{hn, PP, ssq + M, hb2, Fc, 0.0f}; for (int rep_ = 0; rep_ < REP_PG0; ++rep_) GEMM1(pg8::EpiPle, E, hn, Wpg, D, D); }
                 pg8::EpiPle E{hn, PP, ssq + M, hb2, ssq + 2 * M, 1.0f}; GEMM1(pg8::EpiPle, E, hn, Wpg, D, D); }
    SEAM(6);
    if (IN(7)) { { pg8::EpiL1In E{QK, VT1, ropeC, ropeS, ssq + 2 * M}; GEMM(pg8::EpiL1In, E, hb2, Win1, 1536, D); }
                 { pg8::EpiStore E{PP1, D}; GEMM_SUB(pg8::EpiStore, E, pbf + (size_t)M * 256, Wpp + WPP_STRIDE, D, 256, (64 * 6) % G); } }
    SEAM(7);
    if (IN(8)) for (int rep_ = 0; rep_ <= REP_SWA; ++rep_) { IDS
        if (rep_ > 0) xcd_barrier(xbar);
        for (int ch = blockIdx.x; ch < 2 * 16 * 8; ch += G) { const int c = ch >> 5, b = (ch >> 4) & 1, hd = ch & 15; int res = 1 << 28; bf16x8 qfN[4]; float FqN = 0.f;
            for (int q = 3; q >= 0; --q) res = attn_wg<2>(QK, VT1, Ob, nullptr, nullptr, P.od_sinks, b, hd, 4 * c + q, res, q == 3, q > 0, qfN, FqN, lds, tid, lane, wave); }
        __syncthreads();
    }
    SEAM(8);
    if (IN(9)) { pg8::EpiResid<false> E{nullptr, hb2, hn, ssq + 3 * M, 1.0f}; GEMM1(pg8::EpiResid<false>, E, Ob, Wout1, D, D); }
    SEAM(9);
    if (IN(10)) { pg8::EpiSwiGLU E{ACT1, ssq + 3 * M}; GEMM(pg8::EpiSwiGLU, E, hn, Wgu + WGU_STRIDE, 2 * DFF, D); }
    SEAM(10);
    if (IN(11)) { pg8::EpiResid<false> E{nullptr, hn, hn, ssq + 4 * M, 1.0f}; GEMM1(pg8::EpiResid<false>, E, ACT1, Wdn + WDN_STRIDE, D, DFF); }
    SEAM(11);
    if (IN(12)) { pg8::EpiPle E{hn, PP1, ssq + 4 * M, hb2, ssq + 5 * M, 1.0f}; GEMM1(pg8::EpiPle, E, hn, Wpg + WPG_STRIDE, D, D); }
    SEAM(12);
    for (int rep_ = 0; rep_ < REP_SYNC; ++rep_) xcd_barrier(xbar);
    if (IN(13)) { IDS
        f32x4 g4[4];
#pragma unroll
        for (int q = 0; q < 4; ++q) g4[q] = *(const f32x4*)(P.norm_final + 8 * lane + 512 * (q >> 1) + 4 * (q & 1));
        for (int r0 = gw * 8; r0 < M; r0 += NGW * 8) {
            u32x4 w[8][2];
#pragma unroll
            for (int rr = 0; rr < 8; ++rr) { const u32x4* hp = (const u32x4*)(hb2 + (size_t)(r0 + rr) * D) + lane; w[rr][0] = hp[0]; w[rr][1] = hp[64]; }
#pragma unroll
            for (int rr = 0; rr < 8; ++rr) { const float rs = pg8::row_rstd(ssq + 5 * M, r0 + rr); f32x4* op = (f32x4*)(h + (size_t)(r0 + rr) * D) + 2 * lane;
#pragma unroll
                for (int q = 0; q < 2; ++q) { const u32x4 x = w[rr][q];
                    const f32x4 a = {pg8::bflo(x.x), pg8::bfhi(x.x), pg8::bflo(x.y), pg8::bfhi(x.y)}, c = {pg8::bflo(x.z), pg8::bfhi(x.z), pg8::bflo(x.w), pg8::bfhi(x.w)};
                    op[128 * q] = a * rs * g4[2 * q]; op[128 * q + 1] = c * rs * g4[2 * q + 1]; } }
        }
    }
#undef IN
#undef SEAM
#undef GEMM
}

#ifndef MK_PER_PHASE
#define MK_PER_PHASE 0
#endif
constexpr int N_PHASES = 14;
extern "C" void kernel_launch(void* const* d_in, const int* in_sizes, int n_in, void* d_out, int out_size, void* d_ws, size_t ws_size, hipStream_t stream) {
    static int grid_blocks = 0;
    if (grid_blocks == 0) {
        if (n_in != 18 || out_size != M * D || ws_size < WS_END) { fprintf(stderr, "kernel_launch: unexpected shapes (n_in %d, out %d, ws %zu)\n", n_in, out_size, ws_size); grid_blocks = -1; return; }
        int dev = 0, cus = 0, per_cu = 0;
        hipGetDevice(&dev); hipDeviceGetAttribute(&cus, hipDeviceAttributeMultiprocessorCount, dev);
        if (hipFuncSetAttribute((const void*)mk_fwd, hipFuncAttributeMaxDynamicSharedMemorySize, LDS_BYTES) != hipSuccess) { fprintf(stderr, "kernel_launch: hipFuncSetAttribute failed\n"); grid_blocks = -1; return; }
        if (hipOccupancyMaxActiveBlocksPerMultiprocessor(&per_cu, (const void*)mk_fwd, NTHREADS, LDS_BYTES) != hipSuccess || per_cu < 1) { fprintf(stderr, "kernel_launch: occupancy query gave %d\n", per_cu); per_cu = 1; (void)hipGetLastError(); }
        grid_blocks = cus * 1;
    }
    if (grid_blocks < 0) return;
#define REP_LAUNCH 0
    for (int pass_ = 0; pass_ <= REP_LAUNCH; ++pass_) {
    if (hipMemsetAsync((char*)d_ws, 0, WS_ZERO_BYTES, stream) != hipSuccess) { fprintf(stderr, "kernel_launch: hipMemsetAsync failed\n"); return; }
    Params p{};
    p.x = (const float*)d_in[0]; p.p = (const float*)d_in[1]; p.pos = (const int*)d_in[2];
    p.norm_mix = (const float*)d_in[3]; p.norm_ffn = (const float*)d_in[4]; p.norm_ple = (const float*)d_in[5]; p.norm_final = (const float*)d_in[6];
    p.ev_w_in = (const float*)d_in[7]; p.ev_b_f = (const float*)d_in[8]; p.ev_w_out = (const float*)d_in[9]; p.od_w_in = (const float*)d_in[10]; p.od_sinks = (const float*)d_in[11]; p.od_w_out = (const float*)d_in[12];
    p.ffn_w_gate = (const float*)d_in[13]; p.ffn_w_up = (const float*)d_in[14]; p.ffn_w_down = (const float*)d_in[15]; p.ple_w_proj = (const float*)d_in[16]; p.ple_w_gate = (const float*)d_in[17];
    p.out = (float*)d_out; p.ws = (unsigned char*)d_ws;
#if MK_PER_PHASE
    for (int ph = 0; ph < N_PHASES; ++ph) {
        p.ph_lo = ph; p.ph_hi = ph + 1;
        void* args[] = {&p};
        hipError_t e = hipLaunchCooperativeKernel((const void*)mk_fwd, dim3(grid_blocks), dim3(NTHREADS), args, LDS_BYTES, stream);
        if (e != hipSuccess) { fprintf(stderr, "cooperative launch (phase %d) failed: %s (grid %d)\n", ph, hipGetErrorString(e), grid_blocks); break; }
    }
#else
    p.ph_lo = 0; p.ph_hi = N_PHASES;
    void* args[] = {&p};
    hipError_t e = hipLaunchCooperativeKernel((const void*)mk_fwd, dim3(grid_blocks), dim3(NTHREADS), args, LDS_BYTES, stream);
    if (e != hipSuccess) fprintf(stderr, "cooperative launch failed: %s (grid %d)\n", hipGetErrorString(e), grid_blocks);
#endif
    }
}
```

```cpp
#include <hip/hip_runtime.h>
#include <hip/hip_cooperative_groups.h>
#include <cstdio>
#include <cstdint>
#include <cmath>
namespace cg = cooperative_groups;
namespace pg8 {
#define PG8_LAS __attribute__((address_space(3)))
typedef unsigned short bf16_t;
typedef short bf16x8 __attribute__((ext_vector_type(8)));
typedef float f32x4 __attribute__((ext_vector_type(4)));
typedef unsigned u32x4 __attribute__((ext_vector_type(4)));
constexpr int BM = 256, BK = 64, HALF = 128, HTB = HALF * BK * 2  , STAGE_BYTES = 8 * HTB, NXCD = 8, WGM = 8;

__host__ __device__ __forceinline__ int lds_byte(int r, int c) { const int st = (r >> 4) * 2 + (c >> 5), rr = r & 15, cc = c & 31, ob = rr * 64 + cc * 2; return st * 1024 + (ob ^ (((ob >> 9) & 1) << 5)); }
__host__ __device__ __forceinline__ void stage_rc(int b, int& R, int& C) { const int st = b / 1024, sb = b % 1024, swz = sb ^ (((sb >> 9) & 1) << 5); R = (st >> 1) * 16 + swz / 64; C = (st & 1) * 32 + (swz % 64) / 2; }
__host__ __device__ __forceinline__ int perm32(int rho) { const int n = rho >> 4, i = rho & 15; return 8 * (i >> 2) + 4 * n + (i & 3); }

struct Unit { int pm, pn; };
struct Gemm { const bf16_t* A; const bf16_t* Bt; int M, N, K; };

struct StaticOrder {
    int nM, nN, nwg, G, c;
    __host__ __device__ void init(int M, int N, int G_, int c_) { nM = M / BM; nN = N / BM; nwg = nM * nN; G = G_; c = c_; }
    __host__ __device__ bool next(int i, Unit& u) const {
        const long L = (long)i * G + c; if (L >= nwg) return false;
        int wgid = (int)L; { const int q = nwg / NXCD, r = nwg % NXCD, xcd = wgid % NXCD, off = wgid / NXCD; wgid = (xcd < r ? xcd * (q + 1) : r * (q + 1) + (xcd - r) * q) + off; }
        const int nig = WGM * nN, gid = wgid / nig, fm = gid * WGM, gsz = (nM - fm) < WGM ? (nM - fm) : WGM;
        u.pm = fm + ((wgid % nig) % gsz); u.pn = (wgid % nig) / gsz; return true;
    }
    __device__ __forceinline__ void a_ready(const Unit&) const {}
    __device__ __forceinline__ void done(const Unit&) const {}
};

typedef float f32x2 __attribute__((ext_vector_type(2)));
typedef __bf16 bf16x2_t __attribute__((ext_vector_type(2)));
typedef unsigned u32x2 __attribute__((ext_vector_type(2)));
__device__ __forceinline__ unsigned cvtpk(float lo, float hi) { f32x2 v = {lo, hi}; bf16x2_t b = __builtin_convertvector(v, bf16x2_t); return __builtin_bit_cast(unsigned, b); }
__device__ __forceinline__ u32x4 pack8(f32x4 a, f32x4 b) { u32x4 w; w.x = cvtpk(a[0], a[1]); w.y = cvtpk(a[2], a[3]); w.z = cvtpk(b[0], b[1]); w.w = cvtpk(b[2], b[3]); return w; }
__device__ __forceinline__ float bflo(unsigned w) { return __builtin_bit_cast(float, w << 16); }
__device__ __forceinline__ float bfhi(unsigned w) { return __builtin_bit_cast(float, w & 0xffff0000u); }
__device__ __forceinline__ float fast_sigmoid(float x) { return __builtin_amdgcn_rcpf(1.0f + __builtin_amdgcn_exp2f(-x * 1.4426950408889634f)); }
__device__ __forceinline__ float row_rstd(const float* ssq, int row) { return __builtin_amdgcn_rsqf(ssq[row] * (1.0f / 1024.0f) + 1e-6f); }
__device__ __forceinline__ void st16_wt(void* p, u32x4 v) { asm volatile("global_store_dwordx4 %0, %1, off sc1\n\ts_nop 1" :: "v"(p), "v"(v) : "memory"); }
#ifndef WT_RESID
#define WT_RESID 0
#endif
#ifndef WT_WIDE
#define WT_WIDE 0
#endif
#ifndef WT_QK
#define WT_QK 0
#endif
#define EPI_ARGS const f32x4 (&acc)[2][2][4][2], const Unit& u, int wr, int wc, int fr, int fq
#define EPI_FLAGS static constexpr bool PERM = true, AFTER_DRAIN = false;
__device__ __forceinline__ void vt_store8(bf16_t* p, f32x4 a, f32x4 b) {
    const unsigned w0 = cvtpk(a[0], a[1]), w1 = cvtpk(a[2], a[3]), w2 = cvtpk(b[0], b[1]), w3 = cvtpk(b[2], b[3]);
    p[0 * 8192] = (bf16_t)(w0 & 0xffffu); p[1 * 8192] = (bf16_t)(w0 >> 16); p[2 * 8192] = (bf16_t)(w1 & 0xffffu); p[3 * 8192] = (bf16_t)(w1 >> 16);
    p[4 * 8192] = (bf16_t)(w2 & 0xffffu); p[5 * 8192] = (bf16_t)(w2 >> 16); p[6 * 8192] = (bf16_t)(w3 & 0xffffu); p[7 * 8192] = (bf16_t)(w3 >> 16);
}

struct EpiStore {
    EPI_FLAGS
    bf16_t* O; int ldc;
    __device__ __forceinline__ void operator()(EPI_ARGS) const {
        const int row0 = u.pm * BM + wr * 64 + fr, col0 = u.pn * BM + wc * 32 + 8 * fq;
#pragma unroll
        for (int ai = 0; ai < 2; ++ai)
#pragma unroll
            for (int m = 0; m < 4; ++m) { bf16_t* rowp = O + (size_t)(row0 + ai * HALF + m * 16) * ldc + col0;
#pragma unroll
                for (int bj = 0; bj < 2; ++bj) { if (WT_WIDE) st16_wt(rowp + bj * HALF, pack8(acc[ai][bj][m][0], acc[ai][bj][m][1])); else *(u32x4*)(rowp + bj * HALF) = pack8(acc[ai][bj][m][0], acc[ai][bj][m][1]); } }
    }
};

struct EpiL0In {
    EPI_FLAGS
    bf16_t* QK; bf16_t* VT; unsigned* kstat;
    __device__ __forceinline__ void operator()(EPI_ARGS) const {
        const int sec = u.pn >> 1, half = u.pn & 1, row0 = u.pm * BM + wr * 64 + fr, b = u.pm >> 5;
        if (sec == 2 || sec == 5) {
#pragma unroll
            for (int ai = 0; ai < 2; ++ai)
#pragma unroll
                for (int m = 0; m < 4; ++m) { const int s = (row0 + ai * HALF + m * 16) & 8191;
#pragma unroll
                    for (int bj = 0; bj < 2; ++bj) { const int colt = half * 256 + bj * 128 + wc * 32 + 8 * fq, head = (colt >> 6) + (sec == 5 ? 8 : 0), d0 = colt & 63;
                        vt_store8(VT + ((size_t)(b * 16 + head) * 64 + d0) * 8192 + s, acc[ai][bj][m][0], acc[ai][bj][m][1]); } }
        } else {
            const float sc = (sec == 0 || sec == 3) ? 0.125f * 1.4426950408889634f : 1.0f;
            const int cbase = (sec == 0 ? 0 : sec == 1 ? 512 : sec == 3 ? 1024 : 1536) + half * 256 + wc * 32 + 8 * fq;
#pragma unroll
            for (int ai = 0; ai < 2; ++ai)
#pragma unroll
                for (int m = 0; m < 4; ++m) { bf16_t* rowp = QK + (size_t)(row0 + ai * HALF + m * 16) * 2048 + cbase;
#pragma unroll
                    for (int bj = 0; bj < 2; ++bj) { if (WT_QK) st16_wt(rowp + bj * HALF, pack8(acc[ai][bj][m][0] * sc, acc[ai][bj][m][1] * sc)); else *(u32x4*)(rowp + bj * HALF) = pack8(acc[ai][bj][m][0] * sc, acc[ai][bj][m][1] * sc); } }
            if (sec == 1) {
#pragma unroll
                for (int bj = 0; bj < 2; ++bj) { float best = 0.f;
#pragma unroll
                    for (int ai = 0; ai < 2; ++ai)
#pragma unroll
                        for (int m = 0; m < 4; ++m) { const f32x4 a = acc[ai][bj][m][0], c = acc[ai][bj][m][1];
                            float ss = (a[0] * a[0] + a[1] * a[1]) + (a[2] * a[2] + a[3] * a[3]) + (c[0] * c[0] + c[1] * c[1]) + (c[2] * c[2] + c[3] * c[3]);
                            ss += __shfl_xor(ss, 16); ss += __shfl_xor(ss, 32); best = fmaxf(best, ss); }
                    best = fmaxf(best, __shfl_xor(best, 1)); best = fmaxf(best, __shfl_xor(best, 2)); best = fmaxf(best, __shfl_xor(best, 4)); best = fmaxf(best, __shfl_xor(best, 8));
                    if (fr == 0 && fq == 0) atomicMax(kstat + ((b * 8 + half * 4 + bj * 2 + (wc >> 1)) * 2 + (wc & 1)), __builtin_bit_cast(unsigned, best)); }
            }
        }
    }
};

struct EpiL1In {
    EPI_FLAGS
    bf16_t* QKV; bf16_t* VT; const float* ropeC; const float* ropeS; const float* ssq;
    __device__ __forceinline__ void operator()(EPI_ARGS) const {
        int fr_ = fr; asm volatile("" : "+v"(fr_));
        const int row0 = u.pm * BM + wr * 64 + fr_, b = u.pm >> 5;
        float sq[2][4];
#pragma unroll
        for (int ai = 0; ai < 2; ++ai)
#pragma unroll
            for (int m = 0; m < 4; ++m) sq[ai][m] = ssq[row0 + ai * HALF + m * 16];
        if (u.pn == 5) {
            asm volatile("" ::: "memory");
#pragma unroll
            for (int ai = 0; ai < 2; ++ai)
#pragma unroll
                for (int m = 0; m < 4; ++m) { const int s = (row0 + ai * HALF + m * 16) & 8191; const float rs = __builtin_amdgcn_rsqf(sq[ai][m] * (1.0f / 1024.0f) + 1e-6f);
#pragma unroll
                    for (int bj = 0; bj < 2; ++bj) { const int colt = bj * 128 + wc * 32 + 8 * fq, head = colt >> 6, d0 = colt & 63;
                        vt_store8(VT + ((size_t)(b * 4 + head) * 64 + d0) * 8192 + s, acc[ai][bj][m][0] * rs, acc[ai][bj][m][1] * rs); } }
        } else {
            const float sc = (u.pn < 4) ? 0.125f * 1.4426950408889634f : 1.0f;
            const int col0 = u.pn * BM + wc * 32 + 8 * fq, j0 = 4 * ((wc & 1) * 4 + fq);
            f32x4 csv[4], snv[4]; u32x4 outs[4][2];
#pragma unroll
            for (int m = 0; m < 4; ++m) { const int row = row0 + m * 16; csv[m] = *(const f32x4*)(ropeC + (size_t)row * 32 + j0); snv[m] = *(const f32x4*)(ropeS + (size_t)row * 32 + j0); }
#pragma unroll
            for (int ai = 0; ai < 2; ++ai) {
                asm volatile("" ::: "memory");
#pragma unroll
                for (int m = 0; m < 4; ++m) { const float rs = __builtin_amdgcn_rsqf(sq[ai][m] * (1.0f / 1024.0f) + 1e-6f) * sc; const f32x4 cs = csv[m] * rs, sn = snv[m] * rs;
#pragma unroll
                    for (int bj = 0; bj < 2; ++bj) { const f32x4 x1 = acc[ai][bj][m][0], x2 = acc[ai][bj][m][1]; outs[m][bj] = pack8(x1 * cs - x2 * sn, x2 * cs + x1 * sn); } }
                if (ai == 0) {
#pragma unroll
                    for (int m = 0; m < 4; ++m) { const int row = row0 + HALF + m * 16; csv[m] = *(const f32x4*)(ropeC + (size_t)row * 32 + j0); snv[m] = *(const f32x4*)(ropeS + (size_t)row * 32 + j0); } }
                asm volatile("" ::: "memory");
#pragma unroll
                for (int m = 0; m < 4; ++m) { bf16_t* rowp = QKV + (size_t)(row0 + ai * HALF + m * 16) * 1280 + col0;
#pragma unroll
                    for (int bj = 0; bj < 2; ++bj) *(u32x4*)(rowp + bj * HALF) = outs[m][bj]; }
            }
        }
    }
};

#define EPI_FENCE asm volatile("" ::: "memory")
__device__ __forceinline__ float rstd_of(float ssq_row) { return __builtin_amdgcn_rsqf(ssq_row * (1.0f / 1024.0f) + 1e-6f); }
__device__ __forceinline__ float sumsq8(f32x4 r0, f32x4 r1) { return (r0[0] * r0[0] + r0[1] * r0[1]) + (r0[2] * r0[2] + r0[3] * r0[3]) + (r1[0] * r1[0] + r1[1] * r1[1]) + (r1[2] * r1[2] + r1[3] * r1[3]); }

template <bool BASEF32> struct EpiResid {
    EPI_FLAGS
    const float* basef; const bf16_t* baseb; bf16_t* out; float* ssq; float mul;
    __device__ __forceinline__ void load_group(int g, int row0, int col0, f32x4 (&pf)[2][2][2], u32x4 (&pb)[2][2]) const {
#pragma unroll
        for (int r = 0; r < 2; ++r)
#pragma unroll
            for (int bj = 0; bj < 2; ++bj) { const size_t o = (size_t)(row0 + (g >> 1) * HALF + ((g & 1) * 2 + r) * 16) * 1024 + col0 + bj * HALF;
                if (BASEF32) { const f32x4* bp = (const f32x4*)(basef + o); pf[r][bj][0] = __builtin_nontemporal_load(bp); pf[r][bj][1] = __builtin_nontemporal_load(bp + 1); } else pb[r][bj] = *(const u32x4*)(baseb + o); }
    }
    __device__ __forceinline__ void operator()(EPI_ARGS) const {
        const int row0 = u.pm * BM + wr * 64 + fr, col0 = u.pn * BM + wc * 32 + 8 * fq;
        f32x4 pf[2][2][2]; u32x4 pb[2][2], outs[2][2]; float sums[2];
        load_group(0, row0, col0, pf, pb);
#pragma unroll
        for (int g = 0; g < 4; ++g) { const int ai = g >> 1;
            EPI_FENCE;
#pragma unroll
            for (int r = 0; r < 2; ++r) { const int m = (g & 1) * 2 + r; float ss = 0.f;
#pragma unroll
                for (int bj = 0; bj < 2; ++bj) { f32x4 b0, b1;
                    if (BASEF32) { b0 = pf[r][bj][0]; b1 = pf[r][bj][1]; }
                    else { const u32x4 w = pb[r][bj]; b0 = (f32x4){bflo(w.x), bfhi(w.x), bflo(w.y), bfhi(w.y)}; b1 = (f32x4){bflo(w.z), bfhi(w.z), bflo(w.w), bfhi(w.w)}; }
                    const f32x4 r0 = b0 + acc[ai][bj][m][0] * mul, r1 = b1 + acc[ai][bj][m][1] * mul; outs[r][bj] = pack8(r0, r1); ss += sumsq8(r0, r1); }
                sums[r] = ss; }
            if (g < 3) load_group(g + 1, row0, col0, pf, pb);
            EPI_FENCE;
#pragma unroll
            for (int r = 0; r < 2; ++r) { const int row = row0 + ai * HALF + ((g & 1) * 2 + r) * 16; const size_t off = (size_t)row * 1024 + col0;
#pragma unroll
                for (int bj = 0; bj < 2; ++bj) *(u32x4*)(out + off + bj * HALF) = outs[r][bj];
                float ss = sums[r]; ss += __shfl_xor(ss, 16); ss += __shfl_xor(ss, 32); if (fq == 0) atomicAdd(ssq + row, ss); }
        }
    }
};

struct EpiSwiGLU {
    EPI_FLAGS
    bf16_t* ACT; const float* ssq;
    __device__ __forceinline__ void operator()(EPI_ARGS) const {
        const int row0 = u.pm * BM + wr * 64 + fr, col0 = u.pn * HALF + wc * 32 + 8 * fq;
        float sq[2][4];
#pragma unroll
        for (int ai = 0; ai < 2; ++ai)
#pragma unroll
            for (int m = 0; m < 4; ++m) sq[ai][m] = ssq[row0 + ai * HALF + m * 16];
        EPI_FENCE;
#pragma unroll
        for (int ai = 0; ai < 2; ++ai)
#pragma unroll
            for (int m = 0; m < 4; ++m) { f32x4 r[2]; const float rs = rstd_of(sq[ai][m]);
#pragma unroll
                for (int n = 0; n < 2; ++n) { const f32x4 g = acc[ai][0][m][n] * rs, up = acc[ai][1][m][n] * rs;
#pragma unroll
                    for (int e = 0; e < 4; ++e) r[n][e] = g[e] * fast_sigmoid(g[e]) * up[e]; }
                *(u32x4*)(ACT + (size_t)(row0 + ai * HALF + m * 16) * 2816 + col0) = pack8(r[0], r[1]); }
    }
};

struct EpiPle {
    EPI_FLAGS
    const bf16_t* base; const bf16_t* PP; const float* ssq_in; bf16_t* outb; float* ssq_out; float mul;
    __device__ __forceinline__ void load_group(int g, int row0, int col0, u32x4 (&hb)[2][2], u32x4 (&pb)[2][2]) const {
#pragma unroll
        for (int r = 0; r < 2; ++r)
#pragma unroll
            for (int bj = 0; bj < 2; ++bj) { const size_t o = (size_t)(row0 + (g >> 1) * HALF + ((g & 1) * 2 + r) * 16) * 1024 + col0 + bj * HALF; hb[r][bj] = *(const u32x4*)(base + o); pb[r][bj] = __builtin_nontemporal_load((const u32x4*)(PP + o)); }
    }
    __device__ __forceinline__ void operator()(EPI_ARGS) const {
        const int row0 = u.pm * BM + wr * 64 + fr, col0 = u.pn * BM + wc * 32 + 8 * fq;
        float sq[2][4]; u32x4 hb[2][2], pb[2][2], outs[2][2]; float sums[2];
#pragma unroll
        for (int ai = 0; ai < 2; ++ai)
#pragma unroll
            for (int m = 0; m < 4; ++m) sq[ai][m] = ssq_in[row0 + ai * HALF + m * 16];
        load_group(0, row0, col0, hb, pb);
#pragma unroll
        for (int g = 0; g < 4; ++g) { const int ai = g >> 1;
            EPI_FENCE;
#pragma unroll
            for (int r = 0; r < 2; ++r) { const int m = (g & 1) * 2 + r; const float rs = rstd_of(sq[ai][m]); float ss = 0.f;
#pragma unroll
                for (int bj = 0; bj < 2; ++bj) { const u32x4 hw = hb[r][bj], pp = pb[r][bj];
                    const f32x4 h0 = {bflo(hw.x), bfhi(hw.x), bflo(hw.y), bfhi(hw.y)}, h1 = {bflo(hw.z), bfhi(hw.z), bflo(hw.w), bfhi(hw.w)};
                    const f32x4 a0 = acc[ai][bj][m][0] * rs, a1 = acc[ai][bj][m][1] * rs;
                    f32x4 p0 = {bflo(pp.x), bfhi(pp.x), bflo(pp.y), bfhi(pp.y)}, p1 = {bflo(pp.z), bfhi(pp.z), bflo(pp.w), bfhi(pp.w)}, g0, g1;
#pragma unroll
                    for (int e = 0; e < 4; ++e) { g0[e] = fast_sigmoid(a0[e]); g1[e] = fast_sigmoid(a1[e]); }
                    const f32x4 r0 = h0 + g0 * p0 * mul, r1 = h1 + g1 * p1 * mul;
                    outs[r][bj] = pack8(r0, r1); ss += sumsq8(r0, r1); }
                sums[r] = ss; }
            if (g < 3) load_group(g + 1, row0, col0, hb, pb);
            EPI_FENCE;
#pragma unroll
            for (int r = 0; r < 2; ++r) { const int row = row0 + ai * HALF + ((g & 1) * 2 + r) * 16; const size_t off = (size_t)row * 1024 + col0;
#pragma unroll
                for (int bj = 0; bj < 2; ++bj) *(u32x4*)(outb + off + bj * HALF) = outs[r][bj];
                float ss = sums[r]; ss += __shfl_xor(ss, 16); ss += __shfl_xor(ss, 32); if (fq == 0) atomicAdd(ssq_out + row, ss); }
        }
    }
};

template <class Epi, class Sched, bool ALIGN_EPI = false, bool SP2 = false>
__device__ __forceinline__ void gemm_phase(PG8_LAS unsigned char* lds, const Gemm g, const Sched& S, const Epi& E) {
    int tid_ = threadIdx.x; asm volatile("" : "+v"(tid_));
    const int tid = tid_, wid = __builtin_amdgcn_readfirstlane(tid >> 6), lane = tid & 63, wr = wid >> 2, wc = wid & 3, fr = lane & 15, fq = lane >> 4;
    const int K = g.K, nt = K / BK;
    unsigned voffA[2], voffB[2];
#pragma unroll
    for (int i = 0; i < 2; ++i) { int R, C; stage_rc(tid * 16 + i * 8192, R, C); const int Rb = Epi::PERM ? ((R & ~31) + perm32(R & 31)) : R;
        voffA[i] = (unsigned)(R * K + C) * 2u; voffB[i] = (unsigned)(Rb * K + C) * 2u; }
    const size_t kstep = (size_t)(BK * 2);
    const size_t hstep = (size_t)HALF * K * 2;
    const size_t tstep = 2 * hstep;
    const unsigned ldsw = (unsigned)wid * 1024u;
    const int aoff = lds_byte(wr * 64 + fr, fq * 8), boff = lds_byte(wc * 32 + fr, fq * 8);
#define PG8_SA(b, h) (((b) * 2 + (h)) * HTB)
#define PG8_SB(b, h) ((4 + (b) * 2 + (h)) * HTB)
#define PG8_STAGE(bufoff, gbase, voff) do { _Pragma("unroll") for (int _i = 0; _i < 2; ++_i) \
        __builtin_amdgcn_global_load_lds((const unsigned*)((const char*)(gbase) + (voff)[_i]), (PG8_LAS unsigned*)(lds + (bufoff) + ldsw + _i * 8192), 16, 0, 0); } while (0)
#define PG8_LDA(dst, b, h) do { _Pragma("unroll") for (int m = 0; m < 4; ++m) _Pragma("unroll") for (int k = 0; k < 2; ++k) dst[m][k] = *(const PG8_LAS bf16x8*)(lds + PG8_SA(b, h) + aoff + m * 2048 + k * 1024); } while (0)
#define PG8_LDB(dst, b, h) do { _Pragma("unroll") for (int n = 0; n < 2; ++n) _Pragma("unroll") for (int k = 0; k < 2; ++k) dst[n][k] = *(const PG8_LAS bf16x8*)(lds + PG8_SB(b, h) + boff + n * 2048 + k * 1024); } while (0)
#define PG8_MMA(ai, bj, At, Bt) do { __builtin_amdgcn_s_setprio(1); _Pragma("unroll") for (int m = 0; m < 4; ++m) _Pragma("unroll") for (int n = 0; n < 2; ++n) _Pragma("unroll") for (int k = 0; k < 2; ++k) \
        acc[ai][bj][m][n] = __builtin_amdgcn_mfma_f32_16x16x32_bf16(Bt[n][k], At[m][k], acc[ai][bj][m][n], 0, 0, 0); __builtin_amdgcn_s_setprio(0); } while (0)
#define PG8_WAIT_V(n) asm volatile("s_waitcnt vmcnt(" #n ")" ::: "memory")
#define PG8_WAIT_L(n) asm volatile("s_waitcnt lgkmcnt(" #n ")" ::: "memory")
#define PG8_BAR __builtin_amdgcn_s_barrier()
#define PG8_SCHED __builtin_amdgcn_sched_barrier(0)
    Unit cur, nxt; int ui = 0;
    if (!S.next(0, cur)) return;
    f32x4 acc[2][2][4][2];
#pragma unroll
    for (int a = 0; a < 2; ++a)
#pragma unroll
        for (int b = 0; b < 2; ++b)
#pragma unroll
            for (int m = 0; m < 4; ++m)
#pragma unroll
                for (int n = 0; n < 2; ++n) acc[a][b][m][n] = (f32x4){0.f, 0.f, 0.f, 0.f};
    bf16x8 At[4][2], B0[2][2], B1[2][2];
    const char* cA = (const char*)g.A + (size_t)cur.pm * tstep; const char* cB = (const char*)g.Bt + (size_t)cur.pn * tstep;
    S.a_ready(cur);
    if constexpr (SP2) {
        PG8_STAGE(PG8_SB(0, 0), cB, voffB); PG8_STAGE(PG8_SB(0, 1), cB + hstep, voffB); PG8_STAGE(PG8_SA(0, 0), cA, voffA); PG8_STAGE(PG8_SA(0, 1), cA + hstep, voffA);
        if (wr == 1) PG8_BAR;
        PG8_WAIT_V(2); PG8_BAR;
        PG8_STAGE(PG8_SB(1, 0), cB + kstep, voffB); PG8_STAGE(PG8_SA(1, 0), cA + kstep, voffA); PG8_STAGE(PG8_SB(1, 1), cB + hstep + kstep, voffB);
        PG8_WAIT_V(6); PG8_BAR;
    } else {
        PG8_STAGE(PG8_SB(0, 0), cB, voffB); PG8_STAGE(PG8_SA(0, 0), cA, voffA); PG8_STAGE(PG8_SB(0, 1), cB + hstep, voffB); PG8_STAGE(PG8_SA(0, 1), cA + hstep, voffA);
        if (wr == 1) PG8_BAR;
        PG8_WAIT_V(4); PG8_BAR;
        PG8_STAGE(PG8_SB(1, 0), cB + kstep, voffB); PG8_STAGE(PG8_SA(1, 0), cA + kstep, voffA); PG8_STAGE(PG8_SB(1, 1), cB + hstep + kstep, voffB);
        PG8_WAIT_V(6); PG8_BAR;
    }
    for (;;) {
        const bool has_next = S.next(ui + 1, nxt);
        const char* nA = has_next ? (const char*)g.A + (size_t)nxt.pm * tstep : cA; const char* nB = has_next ? (const char*)g.Bt + (size_t)nxt.pn * tstep : cB;
        for (int t = 0; t < nt; t += 2) {
            const bool last = (t == nt - 2);
            const char* a1 = cA + (size_t)(t + 1) * kstep;
            const char* a2 = last ? nA : cA + (size_t)(t + 2) * kstep; const char* b2 = last ? nB : cB + (size_t)(t + 2) * kstep;
            const char* a3 = a2 + kstep; const char* b3 = b2 + kstep;
            if (last && has_next) S.a_ready(nxt);
            if constexpr (SP2) {
            PG8_LDB(B0, 0, 0); PG8_LDB(B1, 0, 1); PG8_SCHED; PG8_LDA(At, 0, 0); PG8_STAGE(PG8_SA(1, 1), a1 + hstep, voffA);
            PG8_WAIT_V(8); PG8_WAIT_L(0); PG8_BAR; PG8_MMA(0, 0, At, B0); PG8_MMA(0, 1, At, B1); PG8_BAR; PG8_SCHED;
            PG8_LDA(At, 0, 1); PG8_STAGE(PG8_SB(0, 0), b2, voffB); PG8_STAGE(PG8_SB(0, 1), b2 + hstep, voffB); PG8_STAGE(PG8_SA(0, 0), a2, voffA);
            PG8_WAIT_V(8); PG8_WAIT_L(0); PG8_BAR; PG8_MMA(1, 0, At, B0); PG8_MMA(1, 1, At, B1); PG8_BAR; PG8_SCHED;
            PG8_LDB(B0, 1, 0); PG8_LDB(B1, 1, 1); PG8_SCHED; PG8_LDA(At, 1, 0); PG8_STAGE(PG8_SA(0, 1), a2 + hstep, voffA);
            PG8_WAIT_V(8); PG8_WAIT_L(0); PG8_BAR; PG8_MMA(0, 0, At, B0); PG8_MMA(0, 1, At, B1); PG8_BAR; PG8_SCHED;
            PG8_LDA(At, 1, 1); PG8_STAGE(PG8_SB(1, 0), b3, voffB); PG8_STAGE(PG8_SB(1, 1), b3 + hstep, voffB); PG8_STAGE(PG8_SA(1, 0), a3, voffA);
            PG8_WAIT_V(8); PG8_WAIT_L(0); PG8_BAR; PG8_MMA(1, 0, At, B0); PG8_MMA(1, 1, At, B1); PG8_BAR; PG8_SCHED;
            } else {
            PG8_LDB(B0, 0, 0); PG8_SCHED; PG8_LDA(At, 0, 0); PG8_STAGE(PG8_SA(1, 1), a1 + hstep, voffA);
            PG8_WAIT_L(8); PG8_BAR; PG8_WAIT_L(0); PG8_MMA(0, 0, At, B0); PG8_BAR; PG8_SCHED;
            PG8_LDB(B1, 0, 1); PG8_STAGE(PG8_SB(0, 0), b2, voffB);
            PG8_BAR; PG8_WAIT_L(0); PG8_MMA(0, 1, At, B1); PG8_BAR;
            PG8_LDA(At, 0, 1); PG8_STAGE(PG8_SA(0, 0), a2, voffA);
            PG8_BAR; PG8_WAIT_L(0); PG8_MMA(1, 0, At, B0); PG8_BAR; PG8_SCHED;
            PG8_STAGE(PG8_SB(0, 1), b2 + hstep, voffB);
            PG8_WAIT_V(6); PG8_BAR; PG8_MMA(1, 1, At, B1); PG8_BAR;
            PG8_LDB(B0, 1, 0); PG8_SCHED; PG8_LDA(At, 1, 0); PG8_STAGE(PG8_SA(0, 1), a2 + hstep, voffA);
            PG8_WAIT_L(8); PG8_BAR; PG8_WAIT_L(0); PG8_MMA(0, 0, At, B0); PG8_BAR; PG8_SCHED;
            PG8_LDB(B1, 1, 1); PG8_STAGE(PG8_SB(1, 0), b3, voffB);
            PG8_BAR; PG8_WAIT_L(0); PG8_MMA(0, 1, At, B1); PG8_BAR;
            PG8_LDA(At, 1, 1); PG8_STAGE(PG8_SA(1, 0), a3, voffA);
            PG8_BAR; PG8_WAIT_L(0); PG8_MMA(1, 0, At, B0); PG8_BAR; PG8_SCHED;
            PG8_STAGE(PG8_SB(1, 1), b3 + hstep, voffB);
            PG8_WAIT_V(6); PG8_BAR; PG8_MMA(1, 1, At, B1); PG8_BAR;
            }
        }
        if constexpr (ALIGN_EPI) { if (wr == 0) PG8_BAR; }
        if constexpr (!Epi::AFTER_DRAIN) { E(acc, cur, wr, wc, fr, fq); S.done(cur); }
        if (!has_next) break;
#pragma unroll
        for (int a = 0; a < 2; ++a)
#pragma unroll
            for (int b = 0; b < 2; ++b)
#pragma unroll
                for (int m = 0; m < 4; ++m)
#pragma unroll
                    for (int n = 0; n < 2; ++n) acc[a][b][m][n] = (f32x4){0.f, 0.f, 0.f, 0.f};
        cur = nxt; cA = nA; cB = nB; ++ui;
        if constexpr (ALIGN_EPI) { if (wr == 1) PG8_BAR; }
    }
    PG8_WAIT_V(0);
    if constexpr (!ALIGN_EPI) { if (wr == 0) PG8_BAR; }
    PG8_BAR;
    if constexpr (Epi::AFTER_DRAIN) { E.fused(acc, cur, wr, wc, fr, fq, lds, wid, lane); S.done(cur); }
#undef PG8_SA
#undef PG8_SB
#undef PG8_STAGE
#undef PG8_LDA
#undef PG8_LDB
#undef PG8_MMA
#undef PG8_WAIT_V
#undef PG8_WAIT_L
#undef PG8_BAR
#undef PG8_SCHED
}
}

using pg8::bf16_t; using pg8::bf16x8; using pg8::f32x4; using pg8::u32x4; using pg8::u32x2; using pg8::cvtpk;
typedef float f32x16 __attribute__((ext_vector_type(16)));
#define LAS __attribute__((address_space(3)))
#define DI __device__ __forceinline__
#define MFMA32(a, b, c) __builtin_amdgcn_mfma_f32_32x32x16_bf16((a), (b), (c), 0, 0, 0)
constexpr float LOG2E = 1.4426950408889634f;
constexpr int M = 16384, S = 8192, D = 1024, DFF = 2816, NWAVES = 8, NTHREADS = 512;
constexpr float EPS = 1e-6f;
constexpr size_t MiB = 1u << 20;
constexpr size_t WS_KSTAT = 0, WS_TOT = 4096, WS_BAR = 16384, WS_SSQ = 65536, WS_ZERO_BYTES = 65536;
constexpr size_t WS_ROPEC = 1 * MiB, WS_ROPES = 3 * MiB;
constexpr size_t WS_F = 5 * MiB;
constexpr size_t WS_WIN0 = 6 * MiB, WS_WOUT0 = 12 * MiB, WS_WIN1 = 14 * MiB, WS_WOUT1 = 17 * MiB, WS_WGU = 19 * MiB, WS_WDN = 41 * MiB, WS_WPP = 52 * MiB, WS_WPG = 53 * MiB;
constexpr size_t WGU_STRIDE = (size_t)2 * DFF * D, WDN_STRIDE = (size_t)D * DFF, WPP_STRIDE = (size_t)D * 256, WPG_STRIDE = (size_t)D * D;
constexpr size_t WS_PBF = 58 * MiB, WS_HN = 74 * MiB, WS_O = 106 * MiB, WS_QK = 138 * MiB, WS_VT = 202 * MiB, WS_ACT = 138 * MiB, WS_VT1 = 178 * MiB, WS_HB2 = 186 * MiB, WS_ACT1 = 106 * MiB, WS_PP1 = 218 * MiB, WS_END = 250 * MiB;
constexpr int RING_BYTES = 131072, LDS_BYTES = 135168;

struct Params {
    const float *x, *p; const int* pos;
    const float *norm_mix, *norm_ffn, *norm_ple, *norm_final, *ev_w_in, *ev_b_f, *ev_w_out, *od_w_in, *od_sinks, *od_w_out, *ffn_w_gate, *ffn_w_up, *ffn_w_down, *ple_w_proj, *ple_w_gate;
    float* out; unsigned char* ws; int ph_lo, ph_hi;
};

DI float wave_sum(float v) {
#pragma unroll
    for (int o = 1; o < 64; o <<= 1) v += __shfl_xor(v, o);
    return v;
}

#define XB_TMO      128
#define XB_XCNT(j)  (256  + 64 * (j))
#define XB_XSUB(j)  (1280 + 64 * (j))
#define XB_XGEN(j)  (2304 + 64 * (j))
#define XB_TOP      3328
#define XB_TOPGEN   3392
#define XCD_BAR_WORDS 3456
#define XB_SPIN_CAP (1u << 24)

__device__ __forceinline__ unsigned xb_ld(unsigned* p)              { return __hip_atomic_load(p, __ATOMIC_RELAXED, __HIP_MEMORY_SCOPE_AGENT); }
__device__ __forceinline__ unsigned xb_add(unsigned* p, unsigned v) { return __hip_atomic_fetch_add(p, v, __ATOMIC_RELAXED, __HIP_MEMORY_SCOPE_AGENT); }
__device__ __forceinline__ unsigned xb_xcc_id() { return (unsigned)__builtin_amdgcn_s_getreg((3 << 11) | 20) & 0xFu; }
#define XB_SPIN(cond, bar) do { unsigned _sp = 0; while (cond) { __builtin_amdgcn_s_sleep(1); \
    if ((++_sp & 255u) == 0u) { if (xb_ld(&(bar)[XB_TMO])) break; if (_sp > XB_SPIN_CAP) { atomicAdd(&(bar)[XB_TMO], 1u); break; } } } } while (0)

struct XcdBarrier {
    unsigned* bar; unsigned x;
    volatile LAS unsigned* st;
};

__device__ __forceinline__ XcdBarrier xcd_barrier_post(unsigned* bar, volatile LAS unsigned* st) {
    XcdBarrier b; b.bar = bar; b.x = xb_xcc_id(); b.st = st;
    if (threadIdx.x == 0) (void)xb_add(&bar[XB_XCNT(b.x)], 1u);
    return b;
}
__device__ __forceinline__ void xcd_barrier_complete(unsigned* bar, unsigned x, unsigned& nloc, unsigned& nx) {
    const unsigned G = gridDim.x * gridDim.y * gridDim.z;
    unsigned sum, cnt, mine, sp = 0u;
    for (;;) {
        sum = 0u; cnt = 0u; mine = 0u;
#pragma unroll
        for (unsigned j = 0; j < 16; ++j) { const unsigned c = xb_ld(&bar[XB_XCNT(j)]); sum += c; cnt += (c > 0u) ? 1u : 0u; mine = (j == x) ? c : mine; }
        if (sum == G) break;
        __builtin_amdgcn_s_sleep(1);
        if ((++sp & 255u) == 0u) { if (xb_ld(&bar[XB_TMO])) break; if (sp > XB_SPIN_CAP) { atomicAdd(&bar[XB_TMO], 1u); break; } }
    }
    nloc = mine > 0u ? mine : 1u; nx = cnt > 0u ? cnt : 1u;
}

__device__ __forceinline__ void xcd_barrier(const XcdBarrier& b) {
    asm volatile("s_waitcnt vmcnt(0)" ::: "memory");
    __syncthreads();
    if (threadIdx.x == 0) {
        unsigned* bar = b.bar;
        __builtin_amdgcn_s_waitcnt(0);
        unsigned nloc = b.st[0], nx = b.st[1];
        if (nloc == 0u) { xcd_barrier_complete(bar, b.x, nloc, nx); b.st[0] = nloc; b.st[1] = nx; }
        const unsigned old = xb_add(&bar[XB_XSUB(b.x)], 1u);
        const unsigned gen = old / nloc;
        if (old + 1u == (gen + 1u) * nloc) {
            __builtin_amdgcn_fence(__ATOMIC_RELEASE, "agent");
            asm volatile("s_waitcnt vmcnt(0)" ::: "memory");
            const unsigned og = xb_add(&bar[XB_TOP], 1u);
            const unsigned tg = og / nx;
            if (og + 1u == (tg + 1u) * nx) xb_add(&bar[XB_TOPGEN], 1u);
            else XB_SPIN(xb_ld(&bar[XB_TOPGEN]) == tg, bar);
            __builtin_amdgcn_fence(__ATOMIC_ACQUIRE, "agent");
            xb_add(&bar[XB_XGEN(b.x)], 1u);
            asm volatile("s_waitcnt vmcnt(0)" ::: "memory");
        } else {
            XB_SPIN(xb_ld(&bar[XB_XGEN(b.x)]) == gen, bar);
            __builtin_amdgcn_fence(__ATOMIC_ACQUIRE, "agent");
            asm volatile("s_waitcnt vmcnt(0)" ::: "memory");
        }
    }
    __syncthreads();
}

DI int dest_row(int mode, int n, int row_off) {
    if (mode == 1) return (n >> 7) * 256 + (n & 127) + row_off;
    if (mode == 2 && n < 1280) { const int j = n & 63, jj = j & 31, pos = 8 * (jj >> 2) + (jj & 3) + ((j >> 5) << 2); return (n & ~63) + pos; }
    return n + row_off;
}
struct TJob { const float* W; bf16_t* WT; const float* gk; int ldn, K, ncols, mode, row_off, item; };
DI void transpose_issue(const TJob& j, float (&t)[32], int lane) {
    const int nblk = j.ncols / 32, kb = j.item / nblk, nb = j.item % nblk, k0 = 64 * kb, n0 = 32 * nb;
    const float* Wp = j.W + (size_t)(k0 + (lane >> 5)) * j.ldn + n0 + (lane & 31);
#pragma unroll
    for (int i = 0; i < 32; ++i) t[i] = __builtin_nontemporal_load(Wp + (size_t)(2 * i) * j.ldn);
}
DI void transpose_finish(const TJob& j, const float (&t)[32], LAS float* scr, int lane) {
    const int nblk = j.ncols / 32, kb = j.item / nblk, nb = j.item % nblk, k0 = 64 * kb, n0 = 32 * nb;
    const int c = lane & 7;
    f32x4 g0 = {1.f, 1.f, 1.f, 1.f}, g1 = g0;
    if (j.gk) { g0 = *(const f32x4*)(j.gk + k0 + 8 * c); g1 = *(const f32x4*)(j.gk + k0 + 8 * c + 4); }
#pragma unroll
    for (int i = 0; i < 32; ++i) scr[(2 * i + (lane >> 5)) * 33 + (lane & 31)] = t[i];
    asm volatile("s_waitcnt lgkmcnt(0)" ::: "memory");
#pragma unroll
    for (int q = 0; q < 4; ++q) { const int n = (lane >> 3) + 8 * q; const LAS float* s = scr + (8 * c) * 33 + n;
        u32x4 o; o.x = cvtpk(s[0 * 33] * g0[0], s[1 * 33] * g0[1]); o.y = cvtpk(s[2 * 33] * g0[2], s[3 * 33] * g0[3]); o.z = cvtpk(s[4 * 33] * g1[0], s[5 * 33] * g1[1]); o.w = cvtpk(s[6 * 33] * g1[2], s[7 * 33] * g1[3]);
        *(u32x4*)(j.WT + (size_t)dest_row(j.mode, n0 + n, j.row_off) * j.K + k0 + 8 * c) = o; }
    asm volatile("s_waitcnt lgkmcnt(0)" ::: "memory");
}

DI void rope_entry(int pos, int j, float& c, float& s) {
    const float inv = powf(10000.0f, -(float)j / 32.0f);
    const float angf = (float)pos * inv;
    const double a = (double)angf, kq = rint(a * 0.63661977236758134308);
    double r = fma(-kq, 1.57079632679489655800e+00, a); r = fma(-kq, 6.12323399573676603587e-17, r);
    const int q = ((int)kq) & 3; const double r2 = r * r;
    const double sp = r * (1.0 + r2 * (-1.0 / 6 + r2 * (1.0 / 120 + r2 * (-1.0 / 5040 + r2 * (1.0 / 362880 + r2 * (-1.0 / 39916800 + r2 * (1.0 / 6227020800.0)))))));
    const double cp = 1.0 + r2 * (-0.5 + r2 * (1.0 / 24 + r2 * (-1.0 / 720 + r2 * (1.0 / 40320 + r2 * (-1.0 / 3628800 + r2 * (1.0 / 479001600 + r2 * (-1.0 / 87178291200.0)))))));
    const double cc = (q == 0) ? cp : (q == 1) ? -sp : (q == 2) ? -cp : sp, ss = (q == 0) ? sp : (q == 1) ? cp : (q == 2) ? -sp : -cp;
    c = (float)cc; s = (float)ss;
}

template <bool GATES, bool OUTF32>
DI void norm_phase(const float* src, const float* __restrict__ g, void* dst, LAS unsigned char* lds, const float* __restrict__ w_in0, const float* __restrict__ b_f, float* F, float* tot, int tid, int lane, int wave) {
    LAS float* Wg = (LAS float*)lds; LAS float* lfb = (LAS float*)(lds + 32768);
    if (GATES) { for (int idx = tid; idx < 8192; idx += NTHREADS) Wg[(idx & 7) * 1024 + (idx >> 3)] = w_in0[(size_t)(idx >> 3) * 3080 + 3072 + (idx & 7)]; __syncthreads(); }
    f32x4 gv[4];
#pragma unroll
    for (int j = 0; j < 4; ++j) gv[j] = *(const f32x4*)(g + 4 * lane + 256 * j);
    for (int chunk = blockIdx.x; chunk < M / 64; chunk += gridDim.x) {
        constexpr int RB = OUTF32 ? 2 : 4;
#pragma unroll 1
        for (int rb = 0; rb < 8; rb += RB) {
        f32x4 v[RB][4];
#pragma unroll
        for (int rr = 0; rr < RB; ++rr) { const f32x4* xr = (const f32x4*)(src + (size_t)(chunk * 64 + wave * 8 + rb + rr) * D) + lane;
#pragma unroll
            for (int j = 0; j < 4; ++j) v[rr][j] = GATES ? __builtin_nontemporal_load(xr + 64 * j) : xr[64 * j]; }
#pragma unroll
        for (int rr = 0; rr < RB; ++rr) {
            const int row = chunk * 64 + wave * 8 + rb + rr;
            float ss = 0.f;
#pragma unroll
            for (int j = 0; j < 4; ++j) ss += (v[rr][j][0] * v[rr][j][0] + v[rr][j][1] * v[rr][j][1]) + (v[rr][j][2] * v[rr][j][2] + v[rr][j][3] * v[rr][j][3]);
            const float rstd = 1.0f / sqrtf(wave_sum(ss) * (1.0f / D) + EPS);
#pragma unroll
            for (int j = 0; j < 4; ++j) v[rr][j] = v[rr][j] * rstd * gv[j];
            if (OUTF32) { f32x4* o = (f32x4*)((float*)dst + (size_t)row * D) + lane;
#pragma unroll
                for (int j = 0; j < 4; ++j) o[64 * j] = v[rr][j];
            } else { u32x2* o = (u32x2*)((bf16_t*)dst + (size_t)row * D) + lane;
#pragma unroll
                for (int j = 0; j < 4; ++j) { u32x2 w; w.x = cvtpk(v[rr][j][0], v[rr][j][1]); w.y = cvtpk(v[rr][j][2], v[rr][j][3]); o[64 * j] = w; } }
            if (GATES) {
                float ga[8];
#pragma unroll
                for (int g8 = 0; g8 < 8; ++g8) { float a = 0.f;
#pragma unroll
                    for (int j = 0; j < 4; ++j) { const f32x4 w = *(const LAS f32x4*)(Wg + g8 * 1024 + 256 * j + 4 * lane); a += (w[0] * v[rr][j][0] + w[1] * v[rr][j][1]) + (w[2] * v[rr][j][2] + w[3] * v[rr][j][3]); }
                    ga[g8] = a; }
                const bool b0 = lane & 1, b1 = lane & 2, b2 = lane & 4;
                float k4[4], k2[2], k1;
#pragma unroll
                for (int e = 0; e < 4; ++e) { const float keep = b0 ? ga[4 + e] : ga[e], send = b0 ? ga[e] : ga[4 + e]; k4[e] = keep + __shfl_xor(send, 1); }
#pragma unroll
                for (int e = 0; e < 2; ++e) { const float keep = b1 ? k4[2 + e] : k4[e], send = b1 ? k4[e] : k4[2 + e]; k2[e] = keep + __shfl_xor(send, 2); }
                { const float keep = b2 ? k2[1] : k2[0], send = b2 ? k2[0] : k2[1]; k1 = keep + __shfl_xor(send, 4); }
                k1 += __shfl_xor(k1, 8); k1 += __shfl_xor(k1, 16); k1 += __shfl_xor(k1, 32);
                if (lane < 8) { const int gate = 4 * (lane & 1) + (lane & 2) + ((lane >> 2) & 1); const float x0 = k1 + b_f[gate];
                    lfb[(wave * 8 + rb + rr) * 8 + gate] = fminf(x0, 0.f) - __builtin_amdgcn_logf(1.0f + __builtin_amdgcn_exp2f(-fabsf(x0) * LOG2E)) * 0.6931471805599453f; }
            }
        }
        }
        if (GATES) {
            __syncthreads();
            if (tid < 8) { const int b = chunk >> 7, blk = chunk & 127; float run = 0.f; float* Fp = F + (size_t)(b * 8 + tid) * S + blk * 64;
                for (int r = 0; r < 64; ++r) { run += lfb[r * 8 + tid]; Fp[r] = run; }
                tot[(b * 8 + tid) * 128 + blk] = run; }
            __syncthreads();
        }
    }
}

#ifndef ATT_MINBLK
#define ATT_MINBLK 0
#endif
constexpr int ATT_NS = 13, ATT_KPITCH = 144, ATT_VPITCH = 80, ATT_VOFF = 32 * ATT_KPITCH, ATT_SLOT = ATT_VOFF + 64 * ATT_VPITCH, ATT_FLAGS = ATT_NS * ATT_SLOT;
template <int MODE  >
DI int attn_wg(const bf16_t* __restrict__ QK, const bf16_t* __restrict__ VT, bf16_t* __restrict__ O, const float* __restrict__ F, const unsigned* __restrict__ kstat, const float* __restrict__ sinks,
               int b, int h, int qg, int res_lo, bool first, bool more, bf16x8 (&qfN)[4], float& FqN, LAS unsigned char* lds, int tid, int lane, int wave) {
    constexpr int PITCH = (MODE == 2) ? 1280 : 2048;
    const int n = lane & 31, hh = lane >> 5, qt = qg * 8 + wave, q0 = qt * 32;
    const int qcol = (MODE == 1) ? 1024 + h * 64 : h * 64;
    const int kcol = (MODE == 0) ? 512 + h * 64 : (MODE == 1) ? 1536 + h * 64 : 1024 + (h >> 2) * 64;
    const int vhead = (MODE == 0) ? b * 16 + h : (MODE == 1) ? b * 16 + 8 + h : b * 4 + (h >> 2);
    const int ocol = (MODE == 1) ? 512 + h * 64 : h * 64;
    const size_t rowb = (size_t)b * S;
    const int ksw = (n & 0x13) | ((n & 4) << 1) | ((n & 8) >> 1);
    const bool isK = tid < 256; const int tv = tid - 256;
    const bf16_t* gsrc = isK ? QK + (rowb + (tid >> 3)) * PITCH + kcol + 8 * (tid & 7) : VT + ((size_t)vhead * 64 + (tv >> 2)) * S + 8 * (tv & 3);
    const size_t gstep = isK ? (size_t)32 * PITCH : (size_t)32;
    const int loff = isK ? (tid >> 3) * ATT_KPITCH + (tid & 7) * 16 : ATT_VOFF + (tv >> 2) * ATT_VPITCH + (tv & 3) * 16;
    volatile LAS int* flags = (volatile LAS int*)(lds + ATT_FLAGS);
    __syncthreads();
    if (tid < 8) flags[tid] = 0x7fffffff;
    { bf16x8 t[8];
#pragma unroll
      for (int j = 0; j < 8; ++j) { const int blk = qg * 8 + j; if (blk < res_lo || blk > res_lo + 12) t[j] = *(const bf16x8*)(gsrc + (size_t)blk * gstep); }
#pragma unroll
      for (int j = 0; j < 8; ++j) { const int blk = qg * 8 + j; if (blk < res_lo || blk > res_lo + 12) *(LAS bf16x8*)(lds + (blk % ATT_NS) * ATT_SLOT + loff) = t[j]; } }
    bf16x8 qf[4];
    const float* Fp = (MODE == 0) ? F + (size_t)(b * 8 + h) * S : F;
    { const bf16_t* Qp = QK + (rowb + q0 + n) * PITCH + qcol + 8 * hh;
      if (first) {
#pragma unroll
          for (int c = 0; c < 4; ++c) qfN[c] = *(const bf16x8*)(Qp + 16 * c);
          if (MODE == 0) FqN = Fp[q0 + n]; }
#pragma unroll
      for (int c = 0; c < 4; ++c) qf[c] = qfN[c];
    }
    float m_run = -1e30f, l_run = 0.f, carry = 0.f, cfac = 1.0f, Fq = 0.f, qkb = 0.f, sink2 = 0.f;
    if (MODE == 0) Fq = FqN;
    if (more) { const bf16_t* Qp = QK + (rowb + q0 - 256 + n) * PITCH + qcol + 8 * hh;
#pragma unroll
        for (int c = 0; c < 4; ++c) qfN[c] = *(const bf16x8*)(Qp + 16 * c);
        if (MODE == 0) FqN = Fp[q0 - 256 + n]; }
    if (MODE == 0) {
        float qs = 0.f;
#pragma unroll
        for (int c = 0; c < 4; ++c)
#pragma unroll
            for (int j = 0; j < 8; ++j) { const float v = __builtin_bit_cast(float, ((unsigned)(unsigned short)qf[c][j]) << 16); qs += v * v; }
        qs += __shfl_xor(qs, 32);
        const float kmax2 = __builtin_bit_cast(float, kstat[(b * 8 + h) * 2]) + __builtin_bit_cast(float, kstat[(b * 8 + h) * 2 + 1]);
        qkb = sqrtf(qs * kmax2) * 1.02f + 0.01f;
    }
    if (MODE == 2) { sink2 = sinks[h] * LOG2E; m_run = sink2; }
    f32x16 o0, o1;
#pragma unroll
    for (int r = 0; r < 16; ++r) { o0[r] = 0.f; o1[r] = 0.f; }
    const int kb_lo = (MODE == 2) ? (qt >= 4 ? qt - 4 : 0) : 0;
    constexpr int RATE = (MODE == 2) ? 2 : 1;
    const int nb_lo = (MODE == 2) ? (qg * 8 >= 8 ? qg * 8 - 8 : 0) : 0;
    bool done = false, posted = false;
    int lo_w = qg * 8;
    bf16x8 tn_a[RATE], tn_b[RATE]; f32x4 fkN[4]; float FrN = 0.f;
#define ATT_FLOAD(kb_) do { if (MODE == 0) { const int k0_ = (kb_) * 32; fkN[0] = *(const f32x4*)(Fp + k0_ + 8 * hh); fkN[1] = *(const f32x4*)(Fp + k0_ + 8 * hh + 4); fkN[2] = *(const f32x4*)(Fp + k0_ + 16 + 8 * hh); \
        fkN[3] = *(const f32x4*)(Fp + k0_ + 16 + 8 * hh + 4); FrN = Fp[k0_ > 0 ? k0_ - 1 : 0]; } } while (0)
#pragma unroll
    for (int r = 0; r < RATE; ++r) { const int lb_ = qg * 8 - 1 - r; tn_a[r] = *(const bf16x8*)(gsrc + (size_t)(lb_ >= nb_lo ? lb_ : nb_lo) * gstep); }
    ATT_FLOAD(qt);
    __syncthreads();
#define ATT_STEP(I, TO, TN) { \
        const int nb = qg * 8 - 1 - RATE * (I); \
_Pragma("unroll") \
        for (int r = 0; r < RATE; ++r) { const int lb_ = nb - RATE - r; TN[r] = *(const bf16x8*)(gsrc + (size_t)(lb_ >= nb_lo ? lb_ : nb_lo) * gstep); } \
        const int kb = qt - (I); \
        if (!done && kb < kb_lo) done = true; \
        if (!done) { \
            const LAS unsigned char* sl = lds + (kb % ATT_NS) * ATT_SLOT; \
            bf16x8 kf[4]; f32x4 fk[4]; \
_Pragma("unroll") \
            for (int c = 0; c < 4; ++c) { kf[c] = *(const LAS bf16x8*)(sl + ksw * ATT_KPITCH + c * 32 + hh * 16); fk[c] = fkN[c]; } \
            const LAS unsigned char* vp = sl + ATT_VOFF + n * ATT_VPITCH + hh * 16; \
            const bf16x8 v00 = *(const LAS bf16x8*)(vp), v01 = *(const LAS bf16x8*)(vp + 32), v10 = *(const LAS bf16x8*)(vp + 32 * ATT_VPITCH), v11 = *(const LAS bf16x8*)(vp + 32 * ATT_VPITCH + 32); \
            const float Fr = FrN; \
            ATT_FLOAD(kb > kb_lo ? kb - 1 : kb_lo); \
            f32x16 s; \
_Pragma("unroll") \
            for (int r = 0; r < 16; ++r) s[r] = 0.f; \
_Pragma("unroll") \
            for (int c = 0; c < 4; ++c) s = MFMA32(kf[c], qf[c], s); \
            float p[16]; \
            if (MODE == 0 || MODE == 2) { \
                if (MODE == 0) { \
_Pragma("unroll") \
                    for (int r = 0; r < 16; ++r) p[r] = s[r] + (Fq - fk[r >> 2][r & 3]); \
                } else { \
_Pragma("unroll") \
                    for (int r = 0; r < 16; ++r) p[r] = s[r]; \
                } \
                if (kb == qt) { \
_Pragma("unroll") \
                    for (int r = 0; r < 16; ++r) { const int kl = 16 * (r >> 3) + 8 * hh + (r & 7); if (kl > n) p[r] = -1e30f; } \
                } \
                if (MODE == 2 && kb == qt - 4) { \
_Pragma("unroll") \
                    for (int r = 0; r < 16; ++r) { const int kl = 16 * (r >> 3) + 8 * hh + (r & 7); if (kl <= n) p[r] = -1e30f; } \
                } \
                float mx = p[0]; \
_Pragma("unroll") \
                for (int r = 1; r < 16; ++r) mx = fmaxf(mx, p[r]); \
                mx = fmaxf(mx, __shfl_xor(mx, 32)); \
                const float mnew = fmaxf(m_run, mx), alpha = __builtin_amdgcn_exp2f(m_run - mnew); \
                float ps = 0.f; \
_Pragma("unroll") \
                for (int r = 0; r < 16; ++r) { p[r] = __builtin_amdgcn_exp2f(p[r] - mnew); ps += p[r]; } \
                l_run = l_run * alpha + ps; m_run = mnew; \
                if (!__all(alpha == 1.0f)) { _Pragma("unroll") for (int r = 0; r < 16; ++r) { o0[r] *= alpha; o1[r] *= alpha; } } \
            } else { \
                float om[16], ex[16], T[2]; \
_Pragma("unroll") \
                for (int r = 0; r < 16; ++r) { om[r] = __builtin_amdgcn_rcpf(1.0f + __builtin_amdgcn_exp2f(s[r])); p[r] = 1.0f - om[r]; } \
                if (kb == qt) { \
_Pragma("unroll") \
                    for (int r = 0; r < 16; ++r) { const int kl = 16 * (r >> 3) + 8 * hh + (r & 7); if (kl >= n) { om[r] = 1.0f; p[r] = 0.f; } } \
                } \
_Pragma("unroll") \
                for (int c = 0; c < 2; ++c) { float run = 1.0f; \
_Pragma("unroll") \
                    for (int j = 7; j >= 0; --j) { ex[8 * c + j] = run; run *= om[8 * c + j]; } \
                    T[c] = run; } \
                const float P0 = __shfl_xor(T[0], 32), P1 = __shfl_xor(T[1], 32); \
                const float off0 = cfac * (hh == 0 ? (P0 * T[1] * P1) : (P1 * T[1])), off1 = cfac * (hh == 0 ? P1 : 1.0f); \
_Pragma("unroll") \
                for (int r = 0; r < 16; ++r) p[r] = p[r] * ex[r] * (r < 8 ? off0 : off1); \
                const float tot = (T[0] * T[1]) * (P0 * P1); \
                cfac *= tot; carry += __builtin_amdgcn_logf(tot); \
            } \
            bf16x8 pf0, pf1; \
            { u32x4 w0, w1; w0.x = cvtpk(p[0], p[1]); w0.y = cvtpk(p[2], p[3]); w0.z = cvtpk(p[4], p[5]); w0.w = cvtpk(p[6], p[7]); \
              w1.x = cvtpk(p[8], p[9]); w1.y = cvtpk(p[10], p[11]); w1.z = cvtpk(p[12], p[13]); w1.w = cvtpk(p[14], p[15]); \
              pf0 = __builtin_bit_cast(bf16x8, w0); pf1 = __builtin_bit_cast(bf16x8, w1); } \
            o0 = MFMA32(v00, pf0, o0); o0 = MFMA32(v01, pf1, o0); o1 = MFMA32(v10, pf0, o1); o1 = MFMA32(v11, pf1, o1); \
            if (MODE == 0 && (I) >= ATT_MINBLK) { if (__all((qkb + (Fq - Fr) - m_run) < -152.0f)) done = true; } \
            if (MODE == 1 && (I) >= ATT_MINBLK) { if (__all(carry < -152.0f)) done = true; } \
            if (kb == kb_lo) done = true; \
        } \
        if (done && !posted) { posted = true; if (lane == 0) flags[wave] = (I); } \
_Pragma("unroll") \
        for (int r = 0; r < RATE; ++r) { if (nb - r >= nb_lo) { *(LAS bf16x8*)(lds + ((nb - r) % ATT_NS) * ATT_SLOT + loff) = TO[r]; lo_w = nb - r; }  } \
        __syncthreads(); \
        const int fl = flags[lane & 7]; \
        if (__all(fl <= (I))) break; \
    }
    for (int i2 = 0; ; i2 += 2) {
        ATT_STEP(i2, tn_a, tn_b)
        ATT_STEP(i2 + 1, tn_b, tn_a)
    }
#undef ATT_STEP
    float inv = 1.0f;
    if (MODE == 0 || MODE == 2) { float l = l_run + __shfl_xor(l_run, 32); if (MODE == 2) l += __builtin_amdgcn_exp2f(sink2 - m_run); inv = 1.0f / l; }
    bf16_t* Op = O + (rowb + q0 + n) * D + ocol + 4 * hh;
#pragma unroll
    for (int i = 0; i < 4; ++i) {
        u32x2 w; w.x = cvtpk(o0[4 * i] * inv, o0[4 * i + 1] * inv); w.y = cvtpk(o0[4 * i + 2] * inv, o0[4 * i + 3] * inv); *(u32x2*)(Op + 8 * i) = w;
        u32x2 y; y.x = cvtpk(o1[4 * i] * inv, o1[4 * i + 1] * inv); y.y = cvtpk(o1[4 * i + 2] * inv, o1[4 * i + 3] * inv); *(u32x2*)(Op + 32 + 8 * i) = y;
    }
    return lo_w;
}

#undef ATT_FLOAD
#define REP_P0 0
#define REP_GIN0 0
#define REP_ATT0 0
#define REP_GU 0
#define REP_SWA 0
#define REP_SYNC 0
#define ALIGN1 true
#define ALIGNM true
#define REP_T 0
#define REP_NG 0
#define REP_PR 0
#define REP_GOUT0 0
#define REP_DOWN0 0
#define REP_PG0 0
__global__ void __launch_bounds__(NTHREADS, 2) mk_fwd(Params P) {
    extern __shared__ __attribute__((aligned(16))) unsigned char lds_raw[];
    LAS unsigned char* lds = (LAS unsigned char*)lds_raw;
    cg::grid_group grid = cg::this_grid();
    const int G = gridDim.x, NGW = G * NWAVES, NGT = G * NTHREADS;
    if (threadIdx.x < 32) ((LAS unsigned*)(lds + RING_BYTES))[threadIdx.x] = 0u;
    __syncthreads();
    const XcdBarrier xbar = xcd_barrier_post((unsigned*)(P.ws + WS_BAR), (volatile LAS unsigned*)(lds + RING_BYTES));
    if (P.ph_hi < 0) grid.sync();
#define IDS int tid = threadIdx.x; asm volatile("" : "+v"(tid)); const int lane = tid & 63, wave = __builtin_amdgcn_readfirstlane(tid >> 6), gw = blockIdx.x * NWAVES + wave, gt = blockIdx.x * NTHREADS + tid; (void)gw; (void)gt; (void)lane;
    unsigned char* ws = P.ws;
    unsigned* kstat = (unsigned*)(ws + WS_KSTAT); float* tot = (float*)(ws + WS_TOT); float* ropeC = (float*)(ws + WS_ROPEC); float* ropeS = (float*)(ws + WS_ROPES); float* Fc = (float*)(ws + WS_F);
    bf16_t* Win0 = (bf16_t*)(ws + WS_WIN0); bf16_t* Wout0 = (bf16_t*)(ws + WS_WOUT0); bf16_t* Win1 = (bf16_t*)(ws + WS_WIN1); bf16_t* Wout1 = (bf16_t*)(ws + WS_WOUT1);
    bf16_t* Wgu = (bf16_t*)(ws + WS_WGU); bf16_t* Wdn = (bf16_t*)(ws + WS_WDN); bf16_t* Wpp = (bf16_t*)(ws + WS_WPP); bf16_t* Wpg = (bf16_t*)(ws + WS_WPG);
    bf16_t* pbf = (bf16_t*)(ws + WS_PBF); bf16_t* hn = (bf16_t*)(ws + WS_HN); bf16_t* Ob = (bf16_t*)(ws + WS_O); bf16_t* PP = Ob; bf16_t* QK = (bf16_t*)(ws + WS_QK); bf16_t* VT = (bf16_t*)(ws + WS_VT); bf16_t* ACT = (bf16_t*)(ws + WS_ACT);
    bf16_t* hb2 = (bf16_t*)(ws + WS_HB2); bf16_t* VT1 = (bf16_t*)(ws + WS_VT1); float* ssq = (float*)(ws + WS_SSQ); bf16_t* ACT1 = (bf16_t*)(ws + WS_ACT1); bf16_t* PP1 = (bf16_t*)(ws + WS_PP1);
    float* h = P.out;
    const int lo = P.ph_lo, hi = P.ph_hi;
#define IN(k) (lo <= (k) && (k) < hi)
#define SEAM(k) do { if (IN(k) && IN((k) + 1)) xcd_barrier(xbar); } while (0)
#define GEMM(EpiT, E, A_, B_, N_, K_) do { int k_ = (K_); asm volatile("" : "+s"(k_)); pg8::Gemm g_{A_, B_, M, N_, k_}; pg8::StaticOrder S_; S_.init(M, N_, G, (int)blockIdx.x); pg8::gemm_phase<EpiT, pg8::StaticOrder, ALIGNM, true>(lds, g_, S_, E); } while (0)
#define GEMM1(EpiT, E, A_, B_, N_, K_) do { int k_ = (K_); asm volatile("" : "+s"(k_)); pg8::Gemm g_{A_, B_, M, N_, k_}; pg8::StaticOrder S_; S_.init(M, N_, G, (int)blockIdx.x); pg8::gemm_phase<EpiT, pg8::StaticOrder, ALIGN1, true>(lds, g_, S_, E); } while (0)

#define GEMM_SUB(EpiT, E, A_, B_, N_, K_, c0_) do { const int c0v_ = (c0_); if ((int)blockIdx.x >= c0v_) { int k_ = (K_); asm volatile("" : "+s"(k_)); pg8::Gemm g_{A_, B_, M, N_, k_}; pg8::StaticOrder S_; S_.init(M, N_, G - c0v_, (int)blockIdx.x - c0v_); \
        pg8::gemm_phase<EpiT, pg8::StaticOrder, true, true>(lds, g_, S_, E); } } while (0)
    if (IN(0)) for (int rep_ = 0; rep_ <= REP_P0; ++rep_) { IDS
        if (rep_ > 0) xcd_barrier(xbar);
        if (blockIdx.x == 0 && tid < 32) kstat[tid] = 0u;
        for (int i = gt; i < 6 * M; i += NGT) ssq[i] = 0.f;
        LAS float* scr = (LAS float*)(lds + wave * 16384);
        constexpr int I_IN0 = 16 * 96, I_SQ = 16 * 32, I_IN1 = 16 * 48, I_FF = 16 * 88, I_DN = 44 * 32, I_PP = 4 * 32;
        constexpr int NITEMS = I_IN0 + I_SQ + I_IN1 + I_SQ + 4 * I_FF + 2 * I_DN + 2 * I_PP + 2 * I_SQ;
#define T_DECODE(it_, J) do { int r = (it_); \
            if (r < I_IN0) { J = TJob{P.ev_w_in, Win0, nullptr, 3080, D, 3072, 0, 0, r}; break; } r -= I_IN0; \
            if (r < I_SQ) { J = TJob{P.ev_w_out, Wout0, nullptr, D, D, D, 0, 0, r}; break; } r -= I_SQ; \
            if (r < I_IN1) { J = TJob{P.od_w_in, Win1, P.norm_mix + D, 1536, D, 1536, 2, 0, r}; break; } r -= I_IN1; \
            if (r < I_SQ) { J = TJob{P.od_w_out, Wout1, nullptr, D, D, D, 0, 0, r}; break; } r -= I_SQ; \
            if (r < 4 * I_FF) { const int which = r / I_FF, l = which >> 1, up = which & 1; J = TJob{(up ? P.ffn_w_up : P.ffn_w_gate) + (size_t)l * D * DFF, Wgu + l * WGU_STRIDE, P.norm_ffn + l * D, DFF, D, DFF, 1, up * 128, r % I_FF}; break; } r -= 4 * I_FF; \
            if (r < 2 * I_DN) { const int l = r / I_DN; J = TJob{P.ffn_w_down + (size_t)l * DFF * D, Wdn + l * WDN_STRIDE, nullptr, D, DFF, D, 0, 0, r % I_DN}; break; } r -= 2 * I_DN; \
            if (r < 2 * I_PP) { const int l = r / I_PP; J = TJob{P.ple_w_proj + (size_t)l * 256 * D, Wpp + l * WPP_STRIDE, nullptr, D, 256, D, 0, 0, r % I_PP}; break; } r -= 2 * I_PP; \
            { const int l = r / I_SQ; J = TJob{P.ple_w_gate + (size_t)l * D * D, Wpg + l * WPG_STRIDE, P.norm_ple + l * D, D, D, D, 0, 0, r % I_SQ}; } } while (0)
        for (int rt_ = 0; rt_ <= REP_T; ++rt_)
        {
            float tA[32], tB[32]; TJob jc, jn; int it = gw; bool have = it < NITEMS;
            if (have) { T_DECODE(it, jc); transpose_issue(jc, tA, lane); }
            while (have) {
                const int itn = it + NGW; const bool haven = itn < NITEMS;
                if (haven) { T_DECODE(itn, jn); transpose_issue(jn, tB, lane); }
                transpose_finish(jc, tA, scr, lane);
#pragma unroll
                for (int i = 0; i < 32; ++i) tA[i] = tB[i];
                jc = jn; it = itn; have = haven;
            }
        }
#undef T_DECODE
        for (int rp_ = 0; rp_ <= REP_PR; ++rp_)
        for (int i0 = gt; i0 < 2 * M * 256 / 8; i0 += 4 * NGT) { f32x4 a[4], c[4];
#pragma unroll
            for (int k = 0; k < 4; ++k) { const int i = i0 + k * NGT; if (i < 2 * M * 256 / 8) { a[k] = __builtin_nontemporal_load((const f32x4*)P.p + 2 * i); c[k] = __builtin_nontemporal_load((const f32x4*)P.p + 2 * i + 1); } }
#pragma unroll
            for (int k = 0; k < 4; ++k) { const int i = i0 + k * NGT; if (i < 2 * M * 256 / 8) ((u32x4*)pbf)[i] = pg8::pack8(a[k], c[k]); } }
        for (int i = gt; i < M * 32; i += NGT) { float c, s; rope_entry(P.pos[i >> 5], i & 31, c, s); ropeC[i] = c; ropeS[i] = s; }
        __syncthreads();
        for (int rn_ = 0; rn_ <= REP_NG; ++rn_) norm_phase<true, false>(P.x, P.norm_mix, hn, lds, P.ev_w_in, P.ev_b_f, Fc, tot, tid, lane, wave);
    }
    SEAM(0);
    if (IN(1)) { IDS
        LAS float* offs = (LAS float*)lds;
        for (int bh = blockIdx.x; bh < 16; bh += G) {
            if (tid < 128) offs[tid] = tot[bh * 128 + tid];
            __syncthreads();
            if (tid == 0) { float run = 0.f; for (int i = 0; i < 128; ++i) { const float t = offs[i]; offs[i] = run; run += t; } }
            __syncthreads();
            for (int s = tid; s < S; s += NTHREADS) Fc[(size_t)bh * S + s] = (Fc[(size_t)bh * S + s] + offs[s >> 6]) * LOG2E;
            __syncthreads();
        }
        pg8::EpiL0In E{QK, VT, kstat};
        for (int rep_ = 0; rep_ <= REP_GIN0; ++rep_) GEMM(pg8::EpiL0In, E, hn, Win0, 3072, D);
    }
    SEAM(1);
    if (IN(2)) for (int rep_ = 0; rep_ <= REP_ATT0; ++rep_) { IDS
        if (rep_ > 0) xcd_barrier(xbar);
        for (int ch = blockIdx.x; ch < 2 * 8 * 16; ch += G) {
            const int cc = ch >> 4, b = (ch >> 3) & 1, hd = ch & 7; bf16x8 qfN[4]; float FqN = 0.f; int res = 1 << 28;
            for (int q = 1; q >= 0; --q) res = attn_wg<0>(QK, VT, Ob, Fc, kstat, nullptr, b, hd, 2 * cc + q, res, q == 1, q > 0, qfN, FqN, lds, tid, lane, wave);
            res = 1 << 28;
            for (int q = 1; q >= 0; --q) res = attn_wg<1>(QK, VT, Ob, nullptr, nullptr, nullptr, b, hd, 2 * cc + q, res, q == 1, q > 0, qfN, FqN, lds, tid, lane, wave);
        }
        __syncthreads();
    }
    SEAM(2);
    if (IN(3)) { { pg8::EpiResid<true> E{P.x, nullptr, hn, Fc, 1.0f}; for (int rep_ = 0; rep_ < REP_GOUT0; ++rep_) GEMM1(pg8::EpiResid<true>, E, Ob, Wout0, D, D); }
                 pg8::EpiResid<true> E{P.x, nullptr, hn, ssq, 1.0f}; GEMM1(pg8::EpiResid<true>, E, Ob, Wout0, D, D); }
    SEAM(3);
    if (IN(4)) { { pg8::EpiSwiGLU E{ACT, ssq}; for (int rep_ = 0; rep_ <= REP_GU; ++rep_) GEMM(pg8::EpiSwiGLU, E, hn, Wgu, 2 * DFF, D); }
                 { pg8::EpiStore E{PP, D}; GEMM_SUB(pg8::EpiStore, E, pbf, Wpp, D, 256, (64 * 22) % G); } }
    SEAM(4);
    if (IN(5)) { { pg8::EpiResid<false> E{nullptr, hn, hn, Fc, 0.0f}; for (int rep_ = 0; rep_ < REP_DOWN0; ++rep_) GEMM1(pg8::EpiResid<false>, E, ACT, Wdn, D, DFF); }
                 pg8::EpiResid<false> E{nullptr, hn, hn, ssq + M, 1.0f}; GEMM1(pg8::EpiResid<false>, E, ACT, Wdn, D, DFF); }
    SEAM(5);
    if (IN(6)) { { pg8::EpiPle E{hn, PP, ssq + M, hb2, Fc, 0.0f}; for (int rep_ = 0; rep_ < REP_PG0; ++rep_) GEMM1(pg8::EpiPle, E, hn, Wpg, D, D); }
                 pg8::EpiPle E{hn, PP, ssq + M, hb2, ssq + 2 * M, 1.0f}; GEMM1(pg8::EpiPle, E, hn, Wpg, D, D); }
    SEAM(6);
    if (IN(7)) { { pg8::EpiL1In E{QK, VT1, ropeC, ropeS, ssq + 2 * M}; GEMM(pg8::EpiL1In, E, hb2, Win1, 1536, D); }
                 { pg8::EpiStore E{PP1, D}; GEMM_SUB(pg8::EpiStore, E, pbf + (size_t)M * 256, Wpp + WPP_STRIDE, D, 256, (64 * 6) % G); } }
    SEAM(7);
    if (IN(8)) for (int rep_ = 0; rep_ <= REP_SWA; ++rep_) { IDS
        if (rep_ > 0) xcd_barrier(xbar);
        for (int ch = blockIdx.x; ch < 2 * 16 * 8; ch += G) { const int c = ch >> 5, b = (ch >> 4) & 1, hd = ch & 15; int res = 1 << 28; bf16x8 qfN[4]; float FqN = 0.f;
            for (int q = 3; q >= 0; --q) res = attn_wg<2>(QK, VT1, Ob, nullptr, nullptr, P.od_sinks, b, hd, 4 * c + q, res, q == 3, q > 0, qfN, FqN, lds, tid, lane, wave); }
        __syncthreads();
    }
    SEAM(8);
    if (IN(9)) { pg8::EpiResid<false> E{nullptr, hb2, hn, ssq + 3 * M, 1.0f}; GEMM1(pg8::EpiResid<false>, E, Ob, Wout1, D, D); }
    SEAM(9);
    if (IN(10)) { pg8::EpiSwiGLU E{ACT1, ssq + 3 * M}; GEMM(pg8::EpiSwiGLU, E, hn, Wgu + WGU_STRIDE, 2 * DFF, D); }
    SEAM(10);
    if (IN(11)) { pg8::EpiResid<false> E{nullptr, hn, hn, ssq + 4 * M, 1.0f}; GEMM1(pg8::EpiResid<false>, E, ACT1, Wdn + WDN_STRIDE, D, DFF); }
    SEAM(11);
    if (IN(12)) { pg8::EpiPle E{hn, PP1, ssq + 4 * M, hb2, ssq + 5 * M, 1.0f}; GEMM1(pg8::EpiPle, E, hn, Wpg + WPG_STRIDE, D, D); }
    SEAM(12);
    for (int rep_ = 0; rep_ < REP_SYNC; ++rep_) xcd_barrier(xbar);
    if (IN(13)) { IDS
        f32x4 g4[4];
#pragma unroll
        for (int q = 0; q < 4; ++q) g4[q] = *(const f32x4*)(P.norm_final + 8 * lane + 512 * (q >> 1) + 4 * (q & 1));
        for (int r0 = gw * 8; r0 < M; r0 += NGW * 8) {
            u32x4 w[8][2];
#pragma unroll
            for (int rr = 0; rr < 8; ++rr) { const u32x4* hp = (const u32x4*)(hb2 + (size_t)(r0 + rr) * D) + lane; w[rr][0] = __builtin_nontemporal_load(hp); w[rr][1] = __builtin_nontemporal_load(hp + 64); }
#pragma unroll
            for (int rr = 0; rr < 8; ++rr) { const float rs = pg8::row_rstd(ssq + 5 * M, r0 + rr); f32x4* op = (f32x4*)(h + (size_t)(r0 + rr) * D) + 2 * lane;
#pragma unroll
                for (int q = 0; q < 2; ++q) { const u32x4 x = w[rr][q];
                    const f32x4 a = {pg8::bflo(x.x), pg8::bfhi(x.x), pg8::bflo(x.y), pg8::bfhi(x.y)}, c = {pg8::bflo(x.z), pg8::bfhi(x.z), pg8::bflo(x.w), pg8::bfhi(x.w)};
                    __builtin_nontemporal_store(a * rs * g4[2 * q], op + 128 * q); __builtin_nontemporal_store(c * rs * g4[2 * q + 1], op + 128 * q + 1); } }
        }
    }
#undef IN
#undef SEAM
#undef GEMM
}

#ifndef MK_PER_PHASE
#define MK_PER_PHASE 0
#endif
constexpr int N_PHASES = 14;
extern "C" void kernel_launch(void* const* d_in, const int* in_sizes, int n_in, void* d_out, int out_size, void* d_ws, size_t ws_size, hipStream_t stream) {
    static int grid_blocks = 0;
    if (grid_blocks == 0) {
        if (n_in != 18 || out_size != M * D || ws_size < WS_END) { fprintf(stderr, "kernel_launch: unexpected shapes (n_in %d, out %d, ws %zu)\n", n_in, out_size, ws_size); grid_blocks = -1; return; }
        int dev = 0, cus = 0, per_cu = 0;
        hipGetDevice(&dev); hipDeviceGetAttribute(&cus, hipDeviceAttributeMultiprocessorCount, dev);
        if (hipFuncSetAttribute((const void*)mk_fwd, hipFuncAttributeMaxDynamicSharedMemorySize, LDS_BYTES) != hipSuccess) { fprintf(stderr, "kernel_launch: hipFuncSetAttribute failed\n"); grid_blocks = -1; return; }
        if (hipOccupancyMaxActiveBlocksPerMultiprocessor(&per_cu, (const void*)mk_fwd, NTHREADS, LDS_BYTES) != hipSuccess || per_cu < 1) { fprintf(stderr, "kernel_launch: occupancy query gave %d\n", per_cu); per_cu = 1; (void)hipGetLastError(); }
        grid_blocks = cus * 1;
    }
    if (grid_blocks < 0) return;
#define REP_LAUNCH 0
    for (int pass_ = 0; pass_ <= REP_LAUNCH; ++pass_) {
    if (hipMemsetAsync((char*)d_ws, 0, WS_ZERO_BYTES, stream) != hipSuccess) { fprintf(stderr, "kernel_launch: hipMemsetAsync failed\n"); return; }
    Params p{};
    p.x = (const float*)d_in[0]; p.p = (const float*)d_in[1]; p.pos = (const int*)d_in[2];
    p.norm_mix = (const float*)d_in[3]; p.norm_ffn = (const float*)d_in[4]; p.norm_ple = (const float*)d_in[5]; p.norm_final = (const float*)d_in[6];
    p.ev_w_in = (const float*)d_in[7]; p.ev_b_f = (const float*)d_in[8]; p.ev_w_out = (const float*)d_in[9]; p.od_w_in = (const float*)d_in[10]; p.od_sinks = (const float*)d_in[11]; p.od_w_out = (const float*)d_in[12];
    p.ffn_w_gate = (const float*)d_in[13]; p.ffn_w_up = (const float*)d_in[14]; p.ffn_w_down = (const float*)d_in[15]; p.ple_w_proj = (const float*)d_in[16]; p.ple_w_gate = (const float*)d_in[17];
    p.out = (float*)d_out; p.ws = (unsigned char*)d_ws;
#if MK_PER_PHASE
    for (int ph = 0; ph < N_PHASES; ++ph) {
        p.ph_lo = ph; p.ph_hi = ph + 1;
        void* args[] = {&p};
        hipError_t e = hipLaunchCooperativeKernel((const void*)mk_fwd, dim3(grid_blocks), dim3(NTHREADS), args, LDS_BYTES, stream);
        if (e != hipSuccess) { fprintf(stderr, "cooperative launch (phase %d) failed: %s (grid %d)\n", ph, hipGetErrorString(e), grid_blocks); break; }
    }
#else
    p.ph_lo = 0; p.ph_hi = N_PHASES;
    void* args[] = {&p};
    hipError_t e = hipLaunchCooperativeKernel((const void*)mk_fwd, dim3(grid_blocks), dim3(NTHREADS), args, LDS_BYTES, stream);
    if (e != hipSuccess) fprintf(stderr, "cooperative launch failed: %s (grid %d)\n", hipGetErrorString(e), grid_blocks);
#endif
    }
}
```

```cpp
#include <hip/hip_runtime.h>
#include <hip/hip_cooperative_groups.h>
#include <cstdio>
#include <cstdint>
#include <cmath>
namespace cg = cooperative_groups;
namespace pg8 {
#define PG8_LAS __attribute__((address_space(3)))
typedef unsigned short bf16_t;
typedef short bf16x8 __attribute__((ext_vector_type(8)));
typedef float f32x4 __attribute__((ext_vector_type(4)));
typedef unsigned u32x4 __attribute__((ext_vector_type(4)));
constexpr int BM = 256, BK = 64, HALF = 128, HTB = HALF * BK * 2  , STAGE_BYTES = 8 * HTB, NXCD = 8, WGM = 8;

__host__ __device__ __forceinline__ int lds_byte(int r, int c) { const int st = (r >> 4) * 2 + (c >> 5), rr = r & 15, cc = c & 31, ob = rr * 64 + cc * 2; return st * 1024 + (ob ^ (((ob >> 9) & 1) << 5)); }
__host__ __device__ __forceinline__ void stage_rc(int b, int& R, int& C) { const int st = b / 1024, sb = b % 1024, swz = sb ^ (((sb >> 9) & 1) << 5); R = (st >> 1) * 16 + swz / 64; C = (st & 1) * 32 + (swz % 64) / 2; }
__host__ __device__ __forceinline__ int perm32(int rho) { const int n = rho >> 4, i = rho & 15; return 8 * (i >> 2) + 4 * n + (i & 3); }

struct Unit { int pm, pn; };
struct Gemm { const bf16_t* A; const bf16_t* Bt; int M, N, K; };

struct StaticOrder {
    int nM, nN, nwg, G, c;
    __host__ __device__ void init(int M, int N, int G_, int c_) { nM = M / BM; nN = N / BM; nwg = nM * nN; G = G_; c = c_; }
    __host__ __device__ bool next(int i, Unit& u) const {
        const long L = (long)i * G + c; if (L >= nwg) return false;
        int wgid = (int)L; { const int q = nwg / NXCD, r = nwg % NXCD, xcd = wgid % NXCD, off = wgid / NXCD; wgid = (xcd < r ? xcd * (q + 1) : r * (q + 1) + (xcd - r) * q) + off; }
        const int nig = WGM * nN, gid = wgid / nig, fm = gid * WGM, gsz = (nM - fm) < WGM ? (nM - fm) : WGM;
        u.pm = fm + ((wgid % nig) % gsz); u.pn = (wgid % nig) / gsz; return true;
    }
    __device__ __forceinline__ void a_ready(const Unit&) const {}
    __device__ __forceinline__ void done(const Unit&) const {}
};

typedef float f32x2 __attribute__((ext_vector_type(2)));
typedef __bf16 bf16x2_t __attribute__((ext_vector_type(2)));
typedef unsigned u32x2 __attribute__((ext_vector_type(2)));
__device__ __forceinline__ unsigned cvtpk(float lo, float hi) { f32x2 v = {lo, hi}; bf16x2_t b = __builtin_convertvector(v, bf16x2_t); return __builtin_bit_cast(unsigned, b); }
__device__ __forceinline__ u32x4 pack8(f32x4 a, f32x4 b) { u32x4 w; w.x = cvtpk(a[0], a[1]); w.y = cvtpk(a[2], a[3]); w.z = cvtpk(b[0], b[1]); w.w = cvtpk(b[2], b[3]); return w; }
__device__ __forceinline__ float bflo(unsigned w) { return __builtin_bit_cast(float, w << 16); }
__device__ __forceinline__ float bfhi(unsigned w) { return __builtin_bit_cast(float, w & 0xffff0000u); }
__device__ __forceinline__ float fast_sigmoid(float x) { return __builtin_amdgcn_rcpf(1.0f + __builtin_amdgcn_exp2f(-x * 1.4426950408889634f)); }
__device__ __forceinline__ float row_rstd(const float* ssq, int row) { return __builtin_amdgcn_rsqf(ssq[row] * (1.0f / 1024.0f) + 1e-6f); }
__device__ __forceinline__ void st16_wt(void* p, u32x4 v) { asm volatile("global_store_dwordx4 %0, %1, off sc1\n\ts_nop 1" :: "v"(p), "v"(v) : "memory"); }
#ifndef WT_RESID
#define WT_RESID 0
#endif
#ifndef WT_WIDE
#define WT_WIDE 0
#endif
#ifndef WT_QK
#define WT_QK 0
#endif
#ifndef NT_QK
#define NT_QK 0
#endif
#ifndef NT_ACT
#define NT_ACT 0
#endif
#define EPI_ARGS const f32x4 (&acc)[2][2][4][2], const Unit& u, int wr, int wc, int fr, int fq
#define EPI_FLAGS static constexpr bool PERM = true, AFTER_DRAIN = false;
__device__ __forceinline__ void vt_store8(bf16_t* p, f32x4 a, f32x4 b) {
    const unsigned w0 = cvtpk(a[0], a[1]), w1 = cvtpk(a[2], a[3]), w2 = cvtpk(b[0], b[1]), w3 = cvtpk(b[2], b[3]);
    p[0 * 8192] = (bf16_t)(w0 & 0xffffu); p[1 * 8192] = (bf16_t)(w0 >> 16); p[2 * 8192] = (bf16_t)(w1 & 0xffffu); p[3 * 8192] = (bf16_t)(w1 >> 16);
    p[4 * 8192] = (bf16_t)(w2 & 0xffffu); p[5 * 8192] = (bf16_t)(w2 >> 16); p[6 * 8192] = (bf16_t)(w3 & 0xffffu); p[7 * 8192] = (bf16_t)(w3 >> 16);
}

struct EpiStore {
    EPI_FLAGS
    bf16_t* O; int ldc;
    __device__ __forceinline__ void operator()(EPI_ARGS) const {
        const int row0 = u.pm * BM + wr * 64 + fr, col0 = u.pn * BM + wc * 32 + 8 * fq;
#pragma unroll
        for (int ai = 0; ai < 2; ++ai)
#pragma unroll
            for (int m = 0; m < 4; ++m) { bf16_t* rowp = O + (size_t)(row0 + ai * HALF + m * 16) * ldc + col0;
#pragma unroll
                for (int bj = 0; bj < 2; ++bj) { if (WT_WIDE) st16_wt(rowp + bj * HALF, pack8(acc[ai][bj][m][0], acc[ai][bj][m][1])); else *(u32x4*)(rowp + bj * HALF) = pack8(acc[ai][bj][m][0], acc[ai][bj][m][1]); } }
    }
};

struct EpiL0In {
    EPI_FLAGS
    bf16_t* QK; bf16_t* VT; unsigned* kstat;
    __device__ __forceinline__ void operator()(EPI_ARGS) const {
        const int sec = u.pn >> 1, half = u.pn & 1, row0 = u.pm * BM + wr * 64 + fr, b = u.pm >> 5;
        if (sec == 2 || sec == 5) {
#pragma unroll
            for (int ai = 0; ai < 2; ++ai)
#pragma unroll
                for (int m = 0; m < 4; ++m) { const int s = (row0 + ai * HALF + m * 16) & 8191;
#pragma unroll
                    for (int bj = 0; bj < 2; ++bj) { const int colt = half * 256 + bj * 128 + wc * 32 + 8 * fq, head = (colt >> 6) + (sec == 5 ? 8 : 0), d0 = colt & 63;
                        vt_store8(VT + ((size_t)(b * 16 + head) * 64 + d0) * 8192 + s, acc[ai][bj][m][0], acc[ai][bj][m][1]); } }
        } else {
            const float sc = (sec == 0 || sec == 3) ? 0.125f * 1.4426950408889634f : 1.0f;
            const int cbase = (sec == 0 ? 0 : sec == 1 ? 512 : sec == 3 ? 1024 : 1536) + half * 256 + wc * 32 + 8 * fq;
#pragma unroll
            for (int ai = 0; ai < 2; ++ai)
#pragma unroll
                for (int m = 0; m < 4; ++m) { bf16_t* rowp = QK + (size_t)(row0 + ai * HALF + m * 16) * 2048 + cbase;
#pragma unroll
                    for (int bj = 0; bj < 2; ++bj) { if (NT_QK) __builtin_nontemporal_store(pack8(acc[ai][bj][m][0] * sc, acc[ai][bj][m][1] * sc), (u32x4*)(rowp + bj * HALF)); else *(u32x4*)(rowp + bj * HALF) = pack8(acc[ai][bj][m][0] * sc, acc[ai][bj][m][1] * sc); } }
            if (sec == 1) {
#pragma unroll
                for (int bj = 0; bj < 2; ++bj) { float best = 0.f;
#pragma unroll
                    for (int ai = 0; ai < 2; ++ai)
#pragma unroll
                        for (int m = 0; m < 4; ++m) { const f32x4 a = acc[ai][bj][m][0], c = acc[ai][bj][m][1];
                            float ss = (a[0] * a[0] + a[1] * a[1]) + (a[2] * a[2] + a[3] * a[3]) + (c[0] * c[0] + c[1] * c[1]) + (c[2] * c[2] + c[3] * c[3]);
                            ss += __shfl_xor(ss, 16); ss += __shfl_xor(ss, 32); best = fmaxf(best, ss); }
                    best = fmaxf(best, __shfl_xor(best, 1)); best = fmaxf(best, __shfl_xor(best, 2)); best = fmaxf(best, __shfl_xor(best, 4)); best = fmaxf(best, __shfl_xor(best, 8));
                    if (fr == 0 && fq == 0) atomicMax(kstat + ((b * 8 + half * 4 + bj * 2 + (wc >> 1)) * 2 + (wc & 1)), __builtin_bit_cast(unsigned, best)); }
            }
        }
    }
};

struct EpiL1In {
    EPI_FLAGS
    bf16_t* QKV; bf16_t* VT; const float* ropeC; const float* ropeS; const float* ssq;
    __device__ __forceinline__ void operator()(EPI_ARGS) const {
        int fr_ = fr; asm volatile("" : "+v"(fr_));
        const int row0 = u.pm * BM + wr * 64 + fr_, b = u.pm >> 5;
        float sq[2][4];
#pragma unroll
        for (int ai = 0; ai < 2; ++ai)
#pragma unroll
            for (int m = 0; m < 4; ++m) sq[ai][m] = ssq[row0 + ai * HALF + m * 16];
        if (u.pn == 5) {
            asm volatile("" ::: "memory");
#pragma unroll
            for (int ai = 0; ai < 2; ++ai)
#pragma unroll
                for (int m = 0; m < 4; ++m) { const int s = (row0 + ai * HALF + m * 16) & 8191; const float rs = __builtin_amdgcn_rsqf(sq[ai][m] * (1.0f / 1024.0f) + 1e-6f);
#pragma unroll
                    for (int bj = 0; bj < 2; ++bj) { const int colt = bj * 128 + wc * 32 + 8 * fq, head = colt >> 6, d0 = colt & 63;
                        vt_store8(VT + ((size_t)(b * 4 + head) * 64 + d0) * 8192 + s, acc[ai][bj][m][0] * rs, acc[ai][bj][m][1] * rs); } }
        } else {
            const float sc = (u.pn < 4) ? 0.125f * 1.4426950408889634f : 1.0f;
            const int col0 = u.pn * BM + wc * 32 + 8 * fq, j0 = 4 * ((wc & 1) * 4 + fq);
            f32x4 csv[4], snv[4]; u32x4 outs[4][2];
#pragma unroll
            for (int m = 0; m < 4; ++m) { const int row = row0 + m * 16; csv[m] = *(const f32x4*)(ropeC + (size_t)row * 32 + j0); snv[m] = *(const f32x4*)(ropeS + (size_t)row * 32 + j0); }
#pragma unroll
            for (int ai = 0; ai < 2; ++ai) {
                asm volatile("" ::: "memory");
#pragma unroll
                for (int m = 0; m < 4; ++m) { const float rs = __builtin_amdgcn_rsqf(sq[ai][m] * (1.0f / 1024.0f) + 1e-6f) * sc; const f32x4 cs = csv[m] * rs, sn = snv[m] * rs;
#pragma unroll
                    for (int bj = 0; bj < 2; ++bj) { const f32x4 x1 = acc[ai][bj][m][0], x2 = acc[ai][bj][m][1]; outs[m][bj] = pack8(x1 * cs - x2 * sn, x2 * cs + x1 * sn); } }
                if (ai == 0) {
#pragma unroll
                    for (int m = 0; m < 4; ++m) { const int row = row0 + HALF + m * 16; csv[m] = *(const f32x4*)(ropeC + (size_t)row * 32 + j0); snv[m] = *(const f32x4*)(ropeS + (size_t)row * 32 + j0); } }
                asm volatile("" ::: "memory");
#pragma unroll
                for (int m = 0; m < 4; ++m) { bf16_t* rowp = QKV + (size_t)(row0 + ai * HALF + m * 16) * 1280 + col0;
#pragma unroll
                    for (int bj = 0; bj < 2; ++bj) { if (NT_QK) __builtin_nontemporal_store(outs[m][bj], (u32x4*)(rowp + bj * HALF)); else *(u32x4*)(rowp + bj * HALF) = outs[m][bj]; } }
            }
        }
    }
};

#define EPI_FENCE asm volatile("" ::: "memory")
__device__ __forceinline__ float rstd_of(float ssq_row) { return __builtin_amdgcn_rsqf(ssq_row * (1.0f / 1024.0f) + 1e-6f); }
__device__ __forceinline__ float sumsq8(f32x4 r0, f32x4 r1) { return (r0[0] * r0[0] + r0[1] * r0[1]) + (r0[2] * r0[2] + r0[3] * r0[3]) + (r1[0] * r1[0] + r1[1] * r1[1]) + (r1[2] * r1[2] + r1[3] * r1[3]); }

template <bool BASEF32> struct EpiResid {
    EPI_FLAGS
    const float* basef; const bf16_t* baseb; bf16_t* out; float* ssq; float mul;
    __device__ __forceinline__ void load_group(int g, int row0, int col0, f32x4 (&pf)[2][2][2], u32x4 (&pb)[2][2]) const {
#pragma unroll
        for (int r = 0; r < 2; ++r)
#pragma unroll
            for (int bj = 0; bj < 2; ++bj) { const size_t o = (size_t)(row0 + (g >> 1) * HALF + ((g & 1) * 2 + r) * 16) * 1024 + col0 + bj * HALF;
                if (BASEF32) { const f32x4* bp = (const f32x4*)(basef + o); pf[r][bj][0] = __builtin_nontemporal_load(bp); pf[r][bj][1] = __builtin_nontemporal_load(bp + 1); } else pb[r][bj] = *(const u32x4*)(baseb + o); }
    }
    __device__ __forceinline__ void operator()(EPI_ARGS) const {
        const int row0 = u.pm * BM + wr * 64 + fr, col0 = u.pn * BM + wc * 32 + 8 * fq;
        f32x4 pf[2][2][2]; u32x4 pb[2][2], outs[2][2]; float sums[2];
        load_group(0, row0, col0, pf, pb);
#pragma unroll
        for (int g = 0; g < 4; ++g) { const int ai = g >> 1;
            EPI_FENCE;
#pragma unroll
            for (int r = 0; r < 2; ++r) { const int m = (g & 1) * 2 + r; float ss = 0.f;
#pragma unroll
                for (int bj = 0; bj < 2; ++bj) { f32x4 b0, b1;
                    if (BASEF32) { b0 = pf[r][bj][0]; b1 = pf[r][bj][1]; }
                    else { const u32x4 w = pb[r][bj]; b0 = (f32x4){bflo(w.x), bfhi(w.x), bflo(w.y), bfhi(w.y)}; b1 = (f32x4){bflo(w.z), bfhi(w.z), bflo(w.w), bfhi(w.w)}; }
                    const f32x4 r0 = b0 + acc[ai][bj][m][0] * mul, r1 = b1 + acc[ai][bj][m][1] * mul; outs[r][bj] = pack8(r0, r1); ss += sumsq8(r0, r1); }
                sums[r] = ss; }
            if (g < 3) load_group(g + 1, row0, col0, pf, pb);
            EPI_FENCE;
#pragma unroll
            for (int r = 0; r < 2; ++r) { const int row = row0 + ai * HALF + ((g & 1) * 2 + r) * 16; const size_t off = (size_t)row * 1024 + col0;
#pragma unroll
                for (int bj = 0; bj < 2; ++bj) *(u32x4*)(out + off + bj * HALF) = outs[r][bj];
                float ss = sums[r]; ss += __shfl_xor(ss, 16); ss += __shfl_xor(ss, 32); if (fq == 0) atomicAdd(ssq + row, ss); }
        }
    }
};

struct EpiSwiGLU {
    EPI_FLAGS
    bf16_t* ACT; const float* ssq;
    __device__ __forceinline__ void operator()(EPI_ARGS) const {
        const int row0 = u.pm * BM + wr * 64 + fr, col0 = u.pn * HALF + wc * 32 + 8 * fq;
        float sq[2][4];
#pragma unroll
        for (int ai = 0; ai < 2; ++ai)
#pragma unroll
            for (int m = 0; m < 4; ++m) sq[ai][m] = ssq[row0 + ai * HALF + m * 16];
        EPI_FENCE;
#pragma unroll
        for (int ai = 0; ai < 2; ++ai)
#pragma unroll
            for (int m = 0; m < 4; ++m) { f32x4 r[2]; const float rs = rstd_of(sq[ai][m]);
#pragma unroll
                for (int n = 0; n < 2; ++n) { const f32x4 g = acc[ai][0][m][n] * rs, up = acc[ai][1][m][n] * rs;
#pragma unroll
                    for (int e = 0; e < 4; ++e) r[n][e] = g[e] * fast_sigmoid(g[e]) * up[e]; }
                if (NT_ACT) __builtin_nontemporal_store(pack8(r[0], r[1]), (u32x4*)(ACT + (size_t)(row0 + ai * HALF + m * 16) * 2816 + col0)); else *(u32x4*)(ACT + (size_t)(row0 + ai * HALF + m * 16) * 2816 + col0) = pack8(r[0], r[1]); }
    }
};

struct EpiPle {
    EPI_FLAGS
    const bf16_t* base; const bf16_t* PP; const float* ssq_in; bf16_t* outb; float* ssq_out; float mul;
    __device__ __forceinline__ void load_group(int g, int row0, int col0, u32x4 (&hb)[2][2], u32x4 (&pb)[2][2]) const {
#pragma unroll
        for (int r = 0; r < 2; ++r)
#pragma unroll
            for (int bj = 0; bj < 2; ++bj) { const size_t o = (size_t)(row0 + (g >> 1) * HALF + ((g & 1) * 2 + r) * 16) * 1024 + col0 + bj * HALF; hb[r][bj] = *(const u32x4*)(base + o); pb[r][bj] = __builtin_nontemporal_load((const u32x4*)(PP + o)); }
    }
    __device__ __forceinline__ void operator()(EPI_ARGS) const {
        const int row0 = u.pm * BM + wr * 64 + fr, col0 = u.pn * BM + wc * 32 + 8 * fq;
        float sq[2][4]; u32x4 hb[2][2], pb[2][2], outs[2][2]; float sums[2];
#pragma unroll
        for (int ai = 0; ai < 2; ++ai)
#pragma unroll
            for (int m = 0; m < 4; ++m) sq[ai][m] = ssq_in[row0 + ai * HALF + m * 16];
        load_group(0, row0, col0, hb, pb);
#pragma unroll
        for (int g = 0; g < 4; ++g) { const int ai = g >> 1;
            EPI_FENCE;
#pragma unroll
            for (int r = 0; r < 2; ++r) { const int m = (g & 1) * 2 + r; const float rs = rstd_of(sq[ai][m]); float ss = 0.f;
#pragma unroll
                for (int bj = 0; bj < 2; ++bj) { const u32x4 hw = hb[r][bj], pp = pb[r][bj];
                    const f32x4 h0 = {bflo(hw.x), bfhi(hw.x), bflo(hw.y), bfhi(hw.y)}, h1 = {bflo(hw.z), bfhi(hw.z), bflo(hw.w), bfhi(hw.w)};
                    const f32x4 a0 = acc[ai][bj][m][0] * rs, a1 = acc[ai][bj][m][1] * rs;
                    f32x4 p0 = {bflo(pp.x), bfhi(pp.x), bflo(pp.y), bfhi(pp.y)}, p1 = {bflo(pp.z), bfhi(pp.z), bflo(pp.w), bfhi(pp.w)}, g0, g1;
#pragma unroll
                    for (int e = 0; e < 4; ++e) { g0[e] = fast_sigmoid(a0[e]); g1[e] = fast_sigmoid(a1[e]); }
                    const f32x4 r0 = h0 + g0 * p0 * mul, r1 = h1 + g1 * p1 * mul;
                    outs[r][bj] = pack8(r0, r1); ss += sumsq8(r0, r1); }
                sums[r] = ss; }
            if (g < 3) load_group(g + 1, row0, col0, hb, pb);
            EPI_FENCE;
#pragma unroll
            for (int r = 0; r < 2; ++r) { const int row = row0 + ai * HALF + ((g & 1) * 2 + r) * 16; const size_t off = (size_t)row * 1024 + col0;
#pragma unroll
                for (int bj = 0; bj < 2; ++bj) *(u32x4*)(outb + off + bj * HALF) = outs[r][bj];
                float ss = sums[r]; ss += __shfl_xor(ss, 16); ss += __shfl_xor(ss, 32); if (fq == 0) atomicAdd(ssq_out + row, ss); }
        }
    }
};

template <class Epi, class Sched, bool ALIGN_EPI = false, bool SP2 = false>
__device__ __forceinline__ void gemm_phase(PG8_LAS unsigned char* lds, const Gemm g, const Sched& S, const Epi& E) {
    int tid_ = threadIdx.x; asm volatile("" : "+v"(tid_));
    const int tid = tid_, wid = __builtin_amdgcn_readfirstlane(tid >> 6), lane = tid & 63, wr = wid >> 2, wc = wid & 3, fr = lane & 15, fq = lane >> 4;
    const int K = g.K, nt = K / BK;
    unsigned voffA[2], voffB[2];
#pragma unroll
    for (int i = 0; i < 2; ++i) { int R, C; stage_rc(tid * 16 + i * 8192, R, C); const int Rb = Epi::PERM ? ((R & ~31) + perm32(R & 31)) : R;
        voffA[i] = (unsigned)(R * K + C) * 2u; voffB[i] = (unsigned)(Rb * K + C) * 2u; }
    const size_t kstep = (size_t)(BK * 2);
    const size_t hstep = (size_t)HALF * K * 2;
    const size_t tstep = 2 * hstep;
    const unsigned ldsw = (unsigned)wid * 1024u;
    const int aoff = lds_byte(wr * 64 + fr, fq * 8), boff = lds_byte(wc * 32 + fr, fq * 8);
#define PG8_SA(b, h) (((b) * 2 + (h)) * HTB)
#define PG8_SB(b, h) ((4 + (b) * 2 + (h)) * HTB)
#define PG8_STAGE(bufoff, gbase, voff) do { _Pragma("unroll") for (int _i = 0; _i < 2; ++_i) \
        __builtin_amdgcn_global_load_lds((const unsigned*)((const char*)(gbase) + (voff)[_i]), (PG8_LAS unsigned*)(lds + (bufoff) + ldsw + _i * 8192), 16, 0, 0); } while (0)
#define PG8_LDA(dst, b, h) do { _Pragma("unroll") for (int m = 0; m < 4; ++m) _Pragma("unroll") for (int k = 0; k < 2; ++k) dst[m][k] = *(const PG8_LAS bf16x8*)(lds + PG8_SA(b, h) + aoff + m * 2048 + k * 1024); } while (0)
#define PG8_LDB(dst, b, h) do { _Pragma("unroll") for (int n = 0; n < 2; ++n) _Pragma("unroll") for (int k = 0; k < 2; ++k) dst[n][k] = *(const PG8_LAS bf16x8*)(lds + PG8_SB(b, h) + boff + n * 2048 + k * 1024); } while (0)
#define PG8_MMA(ai, bj, At, Bt) do { __builtin_amdgcn_s_setprio(1); _Pragma("unroll") for (int m = 0; m < 4; ++m) _Pragma("unroll") for (int n = 0; n < 2; ++n) _Pragma("unroll") for (int k = 0; k < 2; ++k) \
        acc[ai][bj][m][n] = __builtin_amdgcn_mfma_f32_16x16x32_bf16(Bt[n][k], At[m][k], acc[ai][bj][m][n], 0, 0, 0); __builtin_amdgcn_s_setprio(0); } while (0)
#define PG8_WAIT_V(n) asm volatile("s_waitcnt vmcnt(" #n ")" ::: "memory")
#define PG8_WAIT_L(n) asm volatile("s_waitcnt lgkmcnt(" #n ")" ::: "memory")
#define PG8_BAR __builtin_amdgcn_s_barrier()
#define PG8_SCHED __builtin_amdgcn_sched_barrier(0)
    Unit cur, nxt; int ui = 0;
    if (!S.next(0, cur)) return;
    f32x4 acc[2][2][4][2];
#pragma unroll
    for (int a = 0; a < 2; ++a)
#pragma unroll
        for (int b = 0; b < 2; ++b)
#pragma unroll
            for (int m = 0; m < 4; ++m)
#pragma unroll
                for (int n = 0; n < 2; ++n) acc[a][b][m][n] = (f32x4){0.f, 0.f, 0.f, 0.f};
    bf16x8 At[4][2], B0[2][2], B1[2][2];
    const char* cA = (const char*)g.A + (size_t)cur.pm * tstep; const char* cB = (const char*)g.Bt + (size_t)cur.pn * tstep;
    S.a_ready(cur);
    if constexpr (SP2) {
        PG8_STAGE(PG8_SB(0, 0), cB, voffB); PG8_STAGE(PG8_SB(0, 1), cB + hstep, voffB); PG8_STAGE(PG8_SA(0, 0), cA, voffA); PG8_STAGE(PG8_SA(0, 1), cA + hstep, voffA);
        if (wr == 1) PG8_BAR;
        PG8_WAIT_V(2); PG8_BAR;
        PG8_STAGE(PG8_SB(1, 0), cB + kstep, voffB); PG8_STAGE(PG8_SA(1, 0), cA + kstep, voffA); PG8_STAGE(PG8_SB(1, 1), cB + hstep + kstep, voffB);
        PG8_WAIT_V(6); PG8_BAR;
    } else {
        PG8_STAGE(PG8_SB(0, 0), cB, voffB); PG8_STAGE(PG8_SA(0, 0), cA, voffA); PG8_STAGE(PG8_SB(0, 1), cB + hstep, voffB); PG8_STAGE(PG8_SA(0, 1), cA + hstep, voffA);
        if (wr == 1) PG8_BAR;
        PG8_WAIT_V(4); PG8_BAR;
        PG8_STAGE(PG8_SB(1, 0), cB + kstep, voffB); PG8_STAGE(PG8_SA(1, 0), cA + kstep, voffA); PG8_STAGE(PG8_SB(1, 1), cB + hstep + kstep, voffB);
        PG8_WAIT_V(6); PG8_BAR;
    }
    for (;;) {
        const bool has_next = S.next(ui + 1, nxt);
        const char* nA = has_next ? (const char*)g.A + (size_t)nxt.pm * tstep : cA; const char* nB = has_next ? (const char*)g.Bt + (size_t)nxt.pn * tstep : cB;
        for (int t = 0; t < nt; t += 2) {
            const bool last = (t == nt - 2);
            const char* a1 = cA + (size_t)(t + 1) * kstep;
            const char* a2 = last ? nA : cA + (size_t)(t + 2) * kstep; const char* b2 = last ? nB : cB + (size_t)(t + 2) * kstep;
            const char* a3 = a2 + kstep; const char* b3 = b2 + kstep;
            if (last && has_next) S.a_ready(nxt);
            if constexpr (SP2) {
            PG8_LDB(B0, 0, 0); PG8_LDB(B1, 0, 1); PG8_SCHED; PG8_LDA(At, 0, 0); PG8_STAGE(PG8_SA(1, 1), a1 + hstep, voffA);
            PG8_WAIT_V(8); PG8_WAIT_L(0); PG8_BAR; PG8_MMA(0, 0, At, B0); PG8_MMA(0, 1, At, B1); PG8_BAR; PG8_SCHED;
            PG8_LDA(At, 0, 1); PG8_STAGE(PG8_SB(0, 0), b2, voffB); PG8_STAGE(PG8_SB(0, 1), b2 + hstep, voffB); PG8_STAGE(PG8_SA(0, 0), a2, voffA);
            PG8_WAIT_V(8); PG8_WAIT_L(0); PG8_BAR; PG8_MMA(1, 0, At, B0); PG8_MMA(1, 1, At, B1); PG8_BAR; PG8_SCHED;
            PG8_LDB(B0, 1, 0); PG8_LDB(B1, 1, 1); PG8_SCHED; PG8_LDA(At, 1, 0); PG8_STAGE(PG8_SA(0, 1), a2 + hstep, voffA);
            PG8_WAIT_V(8); PG8_WAIT_L(0); PG8_BAR; PG8_MMA(0, 0, At, B0); PG8_MMA(0, 1, At, B1); PG8_BAR; PG8_SCHED;
            PG8_LDA(At, 1, 1); PG8_STAGE(PG8_SB(1, 0), b3, voffB); PG8_STAGE(PG8_SB(1, 1), b3 + hstep, voffB); PG8_STAGE(PG8_SA(1, 0), a3, voffA);
            PG8_WAIT_V(8); PG8_WAIT_L(0); PG8_BAR; PG8_MMA(1, 0, At, B0); PG8_MMA(1, 1, At, B1); PG8_BAR; PG8_SCHED;
            } else {
            PG8_LDB(B0, 0, 0); PG8_SCHED; PG8_LDA(At, 0, 0); PG8_STAGE(PG8_SA(1, 1), a1 + hstep, voffA);
            PG8_WAIT_L(8); PG8_BAR; PG8_WAIT_L(0); PG8_MMA(0, 0, At, B0); PG8_BAR; PG8_SCHED;
            PG8_LDB(B1, 0, 1); PG8_STAGE(PG8_SB(0, 0), b2, voffB);
            PG8_BAR; PG8_WAIT_L(0); PG8_MMA(0, 1, At, B1); PG8_BAR;
            PG8_LDA(At, 0, 1); PG8_STAGE(PG8_SA(0, 0), a2, voffA);
            PG8_BAR; PG8_WAIT_L(0); PG8_MMA(1, 0, At, B0); PG8_BAR; PG8_SCHED;
            PG8_STAGE(PG8_SB(0, 1), b2 + hstep, voffB);
            PG8_WAIT_V(6); PG8_BAR; PG8_MMA(1, 1, At, B1); PG8_BAR;
            PG8_LDB(B0, 1, 0); PG8_SCHED; PG8_LDA(At, 1, 0); PG8_STAGE(PG8_SA(0, 1), a2 + hstep, voffA);
            PG8_WAIT_L(8); PG8_BAR; PG8_WAIT_L(0); PG8_MMA(0, 0, At, B0); PG8_BAR; PG8_SCHED;
            PG8_LDB(B1, 1, 1); PG8_STAGE(PG8_SB(1, 0), b3, voffB);
            PG8_BAR; PG8_WAIT_L(0); PG8_MMA(0, 1, At, B1); PG8_BAR;
            PG8_LDA(At, 1, 1); PG8_STAGE(PG8_SA(1, 0), a3, voffA);
            PG8_BAR; PG8_WAIT_L(0); PG8_MMA(1, 0, At, B0); PG8_BAR; PG8_SCHED;
            PG8_STAGE(PG8_SB(1, 1), b3 + hstep, voffB);
            PG8_WAIT_V(6); PG8_BAR; PG8_MMA(1, 1, At, B1); PG8_BAR;
            }
        }
        if constexpr (ALIGN_EPI) { if (wr == 0) PG8_BAR; }
        if constexpr (!Epi::AFTER_DRAIN) { E(acc, cur, wr, wc, fr, fq); S.done(cur); }
        if (!has_next) break;
#pragma unroll
        for (int a = 0; a < 2; ++a)
#pragma unroll
            for (int b = 0; b < 2; ++b)
#pragma unroll
                for (int m = 0; m < 4; ++m)
#pragma unroll
                    for (int n = 0; n < 2; ++n) acc[a][b][m][n] = (f32x4){0.f, 0.f, 0.f, 0.f};
        cur = nxt; cA = nA; cB = nB; ++ui;
        if constexpr (ALIGN_EPI) { if (wr == 1) PG8_BAR; }
    }
    PG8_WAIT_V(0);
    if constexpr (!ALIGN_EPI) { if (wr == 0) PG8_BAR; }
    PG8_BAR;
    if constexpr (Epi::AFTER_DRAIN) { E.fused(acc, cur, wr, wc, fr, fq, lds, wid, lane); S.done(cur); }
#undef PG8_SA
#undef PG8_SB
#undef PG8_STAGE
#undef PG8_LDA
#undef PG8_LDB
#undef PG8_MMA
#undef PG8_WAIT_V
#undef PG8_WAIT_L
#undef PG8_BAR
#undef PG8_SCHED
}
}

using pg8::bf16_t; using pg8::bf16x8; using pg8::f32x4; using pg8::u32x4; using pg8::u32x2; using pg8::cvtpk;
typedef float f32x16 __attribute__((ext_vector_type(16)));
#define LAS __attribute__((address_space(3)))
#define DI __device__ __forceinline__
#define MFMA32(a, b, c) __builtin_amdgcn_mfma_f32_32x32x16_bf16((a), (b), (c), 0, 0, 0)
constexpr float LOG2E = 1.4426950408889634f;
constexpr int M = 16384, S = 8192, D = 1024, DFF = 2816, NWAVES = 8, NTHREADS = 512;
constexpr float EPS = 1e-6f;
constexpr size_t MiB = 1u << 20;
constexpr size_t WS_KSTAT = 0, WS_TOT = 4096, WS_BAR = 16384, WS_SSQ = 65536, WS_ZERO_BYTES = 65536;
constexpr size_t WS_ROPEC = 1 * MiB, WS_ROPES = 3 * MiB;
constexpr size_t WS_F = 5 * MiB;
constexpr size_t WS_WIN0 = 6 * MiB, WS_WOUT0 = 12 * MiB, WS_WIN1 = 14 * MiB, WS_WOUT1 = 17 * MiB, WS_WGU = 19 * MiB, WS_WDN = 41 * MiB, WS_WPP = 52 * MiB, WS_WPG = 53 * MiB;
constexpr size_t WGU_STRIDE = (size_t)2 * DFF * D, WDN_STRIDE = (size_t)D * DFF, WPP_STRIDE = (size_t)D * 256, WPG_STRIDE = (size_t)D * D;
constexpr size_t WS_PBF = 58 * MiB, WS_HN = 74 * MiB, WS_O = 106 * MiB, WS_QK = 138 * MiB, WS_VT = 202 * MiB, WS_ACT = 138 * MiB, WS_VT1 = 178 * MiB, WS_HB2 = 186 * MiB, WS_ACT1 = 106 * MiB, WS_PP1 = 218 * MiB, WS_END = 250 * MiB;
constexpr int RING_BYTES = 131072, LDS_BYTES = 135168;

struct Params {
    const float *x, *p; const int* pos;
    const float *norm_mix, *norm_ffn, *norm_ple, *norm_final, *ev_w_in, *ev_b_f, *ev_w_out, *od_w_in, *od_sinks, *od_w_out, *ffn_w_gate, *ffn_w_up, *ffn_w_down, *ple_w_proj, *ple_w_gate;
    float* out; unsigned char* ws; int ph_lo, ph_hi;
};

DI float wave_sum(float v) {
#pragma unroll
    for (int o = 1; o < 64; o <<= 1) v += __shfl_xor(v, o);
    return v;
}

#define XB_TMO      128
#define XB_XCNT(j)  (256  + 64 * (j))
#define XB_XSUB(j)  (1280 + 64 * (j))
#define XB_XGEN(j)  (2304 + 64 * (j))
#define XB_TOP      3328
#define XB_TOPGEN   3392
#define XCD_BAR_WORDS 3456
#define XB_SPIN_CAP (1u << 24)

__device__ __forceinline__ unsigned xb_ld(unsigned* p)              { return __hip_atomic_load(p, __ATOMIC_RELAXED, __HIP_MEMORY_SCOPE_AGENT); }
__device__ __forceinline__ unsigned xb_add(unsigned* p, unsigned v) { return __hip_atomic_fetch_add(p, v, __ATOMIC_RELAXED, __HIP_MEMORY_SCOPE_AGENT); }
__device__ __forceinline__ unsigned xb_xcc_id() { return (unsigned)__builtin_amdgcn_s_getreg((3 << 11) | 20) & 0xFu; }
#define XB_SPIN(cond, bar) do { unsigned _sp = 0; while (cond) { __builtin_amdgcn_s_sleep(1); \
    if ((++_sp & 255u) == 0u) { if (xb_ld(&(bar)[XB_TMO])) break; if (_sp > XB_SPIN_CAP) { atomicAdd(&(bar)[XB_TMO], 1u); break; } } } } while (0)

struct XcdBarrier {
    unsigned* bar; unsigned x;
    volatile LAS unsigned* st;
};

__device__ __forceinline__ XcdBarrier xcd_barrier_post(unsigned* bar, volatile LAS unsigned* st) {
    XcdBarrier b; b.bar = bar; b.x = xb_xcc_id(); b.st = st;
    if (threadIdx.x == 0) (void)xb_add(&bar[XB_XCNT(b.x)], 1u);
    return b;
}
__device__ __forceinline__ void xcd_barrier_complete(unsigned* bar, unsigned x, unsigned& nloc, unsigned& nx) {
    const unsigned G = gridDim.x * gridDim.y * gridDim.z;
    unsigned sum, cnt, mine, sp = 0u;
    for (;;) {
        sum = 0u; cnt = 0u; mine = 0u;
#pragma unroll
        for (unsigned j = 0; j < 16; ++j) { const unsigned c = xb_ld(&bar[XB_XCNT(j)]); sum += c; cnt += (c > 0u) ? 1u : 0u; mine = (j == x) ? c : mine; }
        if (sum == G) break;
        __builtin_amdgcn_s_sleep(1);
        if ((++sp & 255u) == 0u) { if (xb_ld(&bar[XB_TMO])) break; if (sp > XB_SPIN_CAP) { atomicAdd(&bar[XB_TMO], 1u); break; } }
    }
    nloc = mine > 0u ? mine : 1u; nx = cnt > 0u ? cnt : 1u;
}

__device__ __forceinline__ void xcd_barrier(const XcdBarrier& b) {
    asm volatile("s_waitcnt vmcnt(0)" ::: "memory");
    __syncthreads();
    if (threadIdx.x == 0) {
        unsigned* bar = b.bar;
        __builtin_amdgcn_s_waitcnt(0);
        unsigned nloc = b.st[0], nx = b.st[1];
        if (nloc == 0u) { xcd_barrier_complete(bar, b.x, nloc, nx); b.st[0] = nloc; b.st[1] = nx; }
        const unsigned old = xb_add(&bar[XB_XSUB(b.x)], 1u);
        const unsigned gen = old / nloc;
        if (old + 1u == (gen + 1u) * nloc) {
            __builtin_amdgcn_fence(__ATOMIC_RELEASE, "agent");
            asm volatile("s_waitcnt vmcnt(0)" ::: "memory");
            const unsigned og = xb_add(&bar[XB_TOP], 1u);
            const unsigned tg = og / nx;
            if (og + 1u == (tg + 1u) * nx) xb_add(&bar[XB_TOPGEN], 1u);
            else XB_SPIN(xb_ld(&bar[XB_TOPGEN]) == tg, bar);
            __builtin_amdgcn_fence(__ATOMIC_ACQUIRE, "agent");
            xb_add(&bar[XB_XGEN(b.x)], 1u);
            asm volatile("s_waitcnt vmcnt(0)" ::: "memory");
        } else {
            XB_SPIN(xb_ld(&bar[XB_XGEN(b.x)]) == gen, bar);
            __builtin_amdgcn_fence(__ATOMIC_ACQUIRE, "agent");
            asm volatile("s_waitcnt vmcnt(0)" ::: "memory");
        }
    }
    __syncthreads();
}

DI int dest_row(int mode, int n, int row_off) {
    if (mode == 1) return (n >> 7) * 256 + (n & 127) + row_off;
    if (mode == 2 && n < 1280) { const int j = n & 63, jj = j & 31, pos = 8 * (jj >> 2) + (jj & 3) + ((j >> 5) << 2); return (n & ~63) + pos; }
    return n + row_off;
}
struct TJob { const float* W; bf16_t* WT; const float* gk; int ldn, K, ncols, mode, row_off, item; };
DI void transpose_issue(const TJob& j, float (&t)[32], int lane) {
    const int nblk = j.ncols / 32, kb = j.item / nblk, nb = j.item % nblk, k0 = 64 * kb, n0 = 32 * nb;
    const float* Wp = j.W + (size_t)(k0 + (lane >> 5)) * j.ldn + n0 + (lane & 31);
#pragma unroll
    for (int i = 0; i < 32; ++i) t[i] = __builtin_nontemporal_load(Wp + (size_t)(2 * i) * j.ldn);
}
DI void transpose_finish(const TJob& j, const float (&t)[32], LAS float* scr, int lane) {
    const int nblk = j.ncols / 32, kb = j.item / nblk, nb = j.item % nblk, k0 = 64 * kb, n0 = 32 * nb;
    const int c = lane & 7;
    f32x4 g0 = {1.f, 1.f, 1.f, 1.f}, g1 = g0;
    if (j.gk) { g0 = *(const f32x4*)(j.gk + k0 + 8 * c); g1 = *(const f32x4*)(j.gk + k0 + 8 * c + 4); }
#pragma unroll
    for (int i = 0; i < 32; ++i) scr[(2 * i + (lane >> 5)) * 33 + (lane & 31)] = t[i];
    asm volatile("s_waitcnt lgkmcnt(0)" ::: "memory");
#pragma unroll
    for (int q = 0; q < 4; ++q) { const int n = (lane >> 3) + 8 * q; const LAS float* s = scr + (8 * c) * 33 + n;
        u32x4 o; o.x = cvtpk(s[0 * 33] * g0[0], s[1 * 33] * g0[1]); o.y = cvtpk(s[2 * 33] * g0[2], s[3 * 33] * g0[3]); o.z = cvtpk(s[4 * 33] * g1[0], s[5 * 33] * g1[1]); o.w = cvtpk(s[6 * 33] * g1[2], s[7 * 33] * g1[3]);
        *(u32x4*)(j.WT + (size_t)dest_row(j.mode, n0 + n, j.row_off) * j.K + k0 + 8 * c) = o; }
    asm volatile("s_waitcnt lgkmcnt(0)" ::: "memory");
}

DI void rope_entry(int pos, int j, float& c, float& s) {
    const float inv = powf(10000.0f, -(float)j / 32.0f);
    const float angf = (float)pos * inv;
    const double a = (double)angf, kq = rint(a * 0.63661977236758134308);
    double r = fma(-kq, 1.57079632679489655800e+00, a); r = fma(-kq, 6.12323399573676603587e-17, r);
    const int q = ((int)kq) & 3; const double r2 = r * r;
    const double sp = r * (1.0 + r2 * (-1.0 / 6 + r2 * (1.0 / 120 + r2 * (-1.0 / 5040 + r2 * (1.0 / 362880 + r2 * (-1.0 / 39916800 + r2 * (1.0 / 6227020800.0)))))));
    const double cp = 1.0 + r2 * (-0.5 + r2 * (1.0 / 24 + r2 * (-1.0 / 720 + r2 * (1.0 / 40320 + r2 * (-1.0 / 3628800 + r2 * (1.0 / 479001600 + r2 * (-1.0 / 87178291200.0)))))));
    const double cc = (q == 0) ? cp : (q == 1) ? -sp : (q == 2) ? -cp : sp, ss = (q == 0) ? sp : (q == 1) ? cp : (q == 2) ? -sp : -cp;
    c = (float)cc; s = (float)ss;
}

template <bool GATES, bool OUTF32>
DI void norm_phase(const float* src, const float* __restrict__ g, void* dst, LAS unsigned char* lds, const float* __restrict__ w_in0, const float* __restrict__ b_f, float* F, float* tot, int tid, int lane, int wave) {
    LAS float* Wg = (LAS float*)lds; LAS float* lfb = (LAS float*)(lds + 32768);
    if (GATES) { for (int idx = tid; idx < 8192; idx += NTHREADS) Wg[(idx & 7) * 1024 + (idx >> 3)] = w_in0[(size_t)(idx >> 3) * 3080 + 3072 + (idx & 7)]; __syncthreads(); }
    f32x4 gv[4];
#pragma unroll
    for (int j = 0; j < 4; ++j) gv[j] = *(const f32x4*)(g + 4 * lane + 256 * j);
    for (int chunk = blockIdx.x; chunk < M / 64; chunk += gridDim.x) {
        constexpr int RB = OUTF32 ? 2 : 4;
#pragma unroll 1
        for (int rb = 0; rb < 8; rb += RB) {
        f32x4 v[RB][4];
#pragma unroll
        for (int rr = 0; rr < RB; ++rr) { const f32x4* xr = (const f32x4*)(src + (size_t)(chunk * 64 + wave * 8 + rb + rr) * D) + lane;
#pragma unroll
            for (int j = 0; j < 4; ++j) v[rr][j] = GATES ? __builtin_nontemporal_load(xr + 64 * j) : xr[64 * j]; }
#pragma unroll
        for (int rr = 0; rr < RB; ++rr) {
            const int row = chunk * 64 + wave * 8 + rb + rr;
            float ss = 0.f;
#pragma unroll
            for (int j = 0; j < 4; ++j) ss += (v[rr][j][0] * v[rr][j][0] + v[rr][j][1] * v[rr][j][1]) + (v[rr][j][2] * v[rr][j][2] + v[rr][j][3] * v[rr][j][3]);
            const float rstd = 1.0f / sqrtf(wave_sum(ss) * (1.0f / D) + EPS);
#pragma unroll
            for (int j = 0; j < 4; ++j) v[rr][j] = v[rr][j] * rstd * gv[j];
            if (OUTF32) { f32x4* o = (f32x4*)((float*)dst + (size_t)row * D) + lane;
#pragma unroll
                for (int j = 0; j < 4; ++j) o[64 * j] = v[rr][j];
            } else { u32x2* o = (u32x2*)((bf16_t*)dst + (size_t)row * D) + lane;
#pragma unroll
                for (int j = 0; j < 4; ++j) { u32x2 w; w.x = cvtpk(v[rr][j][0], v[rr][j][1]); w.y = cvtpk(v[rr][j][2], v[rr][j][3]); o[64 * j] = w; } }
            if (GATES) {
                float ga[8];
#pragma unroll
                for (int g8 = 0; g8 < 8; ++g8) { float a = 0.f;
#pragma unroll
                    for (int j = 0; j < 4; ++j) { const f32x4 w = *(const LAS f32x4*)(Wg + g8 * 1024 + 256 * j + 4 * lane); a += (w[0] * v[rr][j][0] + w[1] * v[rr][j][1]) + (w[2] * v[rr][j][2] + w[3] * v[rr][j][3]); }
                    ga[g8] = a; }
                const bool b0 = lane & 1, b1 = lane & 2, b2 = lane & 4;
                float k4[4], k2[2], k1;
#pragma unroll
                for (int e = 0; e < 4; ++e) { const float keep = b0 ? ga[4 + e] : ga[e], send = b0 ? ga[e] : ga[4 + e]; k4[e] = keep + __shfl_xor(send, 1); }
#pragma unroll
                for (int e = 0; e < 2; ++e) { const float keep = b1 ? k4[2 + e] : k4[e], send = b1 ? k4[e] : k4[2 + e]; k2[e] = keep + __shfl_xor(send, 2); }
                { const float keep = b2 ? k2[1] : k2[0], send = b2 ? k2[0] : k2[1]; k1 = keep + __shfl_xor(send, 4); }
                k1 += __shfl_xor(k1, 8); k1 += __shfl_xor(k1, 16); k1 += __shfl_xor(k1, 32);
                if (lane < 8) { const int gate = 4 * (lane & 1) + (lane & 2) + ((lane >> 2) & 1); const float x0 = k1 + b_f[gate];
                    lfb[(wave * 8 + rb + rr) * 8 + gate] = fminf(x0, 0.f) - __builtin_amdgcn_logf(1.0f + __builtin_amdgcn_exp2f(-fabsf(x0) * LOG2E)) * 0.6931471805599453f; }
            }
        }
        }
        if (GATES) {
            __syncthreads();
            if (tid < 8) { const int b = chunk >> 7, blk = chunk & 127; float run = 0.f; float* Fp = F + (size_t)(b * 8 + tid) * S + blk * 64;
                for (int r = 0; r < 64; ++r) { run += lfb[r * 8 + tid]; Fp[r] = run; }
                tot[(b * 8 + tid) * 128 + blk] = run; }
            __syncthreads();
        }
    }
}

#ifndef ATT_MINBLK
#define ATT_MINBLK 0
#endif
constexpr int ATT_NS = 13, ATT_KPITCH = 144, ATT_VPITCH = 80, ATT_VOFF = 32 * ATT_KPITCH, ATT_SLOT = ATT_VOFF + 64 * ATT_VPITCH, ATT_FLAGS = ATT_NS * ATT_SLOT;
template <int MODE  >
DI int attn_wg(const bf16_t* __restrict__ QK, const bf16_t* __restrict__ VT, bf16_t* __restrict__ O, const float* __restrict__ F, const unsigned* __restrict__ kstat, const float* __restrict__ sinks,
               int b, int h, int qg, int res_lo, bool first, bool more, bf16x8 (&qfN)[4], float& FqN, LAS unsigned char* lds, int tid, int lane, int wave) {
    constexpr int PITCH = (MODE == 2) ? 1280 : 2048;
    const int n = lane & 31, hh = lane >> 5, qt = qg * 8 + wave, q0 = qt * 32;
    const int qcol = (MODE == 1) ? 1024 + h * 64 : h * 64;
    const int kcol = (MODE == 0) ? 512 + h * 64 : (MODE == 1) ? 1536 + h * 64 : 1024 + (h >> 2) * 64;
    const int vhead = (MODE == 0) ? b * 16 + h : (MODE == 1) ? b * 16 + 8 + h : b * 4 + (h >> 2);
    const int ocol = (MODE == 1) ? 512 + h * 64 : h * 64;
    const size_t rowb = (size_t)b * S;
    const int ksw = (n & 0x13) | ((n & 4) << 1) | ((n & 8) >> 1);
    const bool isK = tid < 256; const int tv = tid - 256;
    const bf16_t* gsrc = isK ? QK + (rowb + (tid >> 3)) * PITCH + kcol + 8 * (tid & 7) : VT + ((size_t)vhead * 64 + (tv >> 2)) * S + 8 * (tv & 3);
    const size_t gstep = isK ? (size_t)32 * PITCH : (size_t)32;
    const int loff = isK ? (tid >> 3) * ATT_KPITCH + (tid & 7) * 16 : ATT_VOFF + (tv >> 2) * ATT_VPITCH + (tv & 3) * 16;
    volatile LAS int* flags = (volatile LAS int*)(lds + ATT_FLAGS);
    __syncthreads();
    if (tid < 8) flags[tid] = 0x7fffffff;
    { bf16x8 t[8];
#pragma unroll
      for (int j = 0; j < 8; ++j) { const int blk = qg * 8 + j; if (blk < res_lo || blk > res_lo + 12) t[j] = *(const bf16x8*)(gsrc + (size_t)blk * gstep); }
#pragma unroll
      for (int j = 0; j < 8; ++j) { const int blk = qg * 8 + j; if (blk < res_lo || blk > res_lo + 12) *(LAS bf16x8*)(lds + (blk % ATT_NS) * ATT_SLOT + loff) = t[j]; } }
    bf16x8 qf[4];
    const float* Fp = (MODE == 0) ? F + (size_t)(b * 8 + h) * S : F;
    { const bf16_t* Qp = QK + (rowb + q0 + n) * PITCH + qcol + 8 * hh;
      if (first) {
#pragma unroll
          for (int c = 0; c < 4; ++c) qfN[c] = *(const bf16x8*)(Qp + 16 * c);
          if (MODE == 0) FqN = Fp[q0 + n]; }
#pragma unroll
      for (int c = 0; c < 4; ++c) qf[c] = qfN[c];
    }
    float m_run = -1e30f, l_run = 0.f, carry = 0.f, cfac = 1.0f, Fq = 0.f, qkb = 0.f, sink2 = 0.f;
    if (MODE == 0) Fq = FqN;
    if (more) { const bf16_t* Qp = QK + (rowb + q0 - 256 + n) * PITCH + qcol + 8 * hh;
#pragma unroll
        for (int c = 0; c < 4; ++c) qfN[c] = *(const bf16x8*)(Qp + 16 * c);
        if (MODE == 0) FqN = Fp[q0 - 256 + n]; }
    if (MODE == 0) {
        float qs = 0.f;
#pragma unroll
        for (int c = 0; c < 4; ++c)
#pragma unroll
            for (int j = 0; j < 8; ++j) { const float v = __builtin_bit_cast(float, ((unsigned)(unsigned short)qf[c][j]) << 16); qs += v * v; }
        qs += __shfl_xor(qs, 32);
        const float kmax2 = __builtin_bit_cast(float, kstat[(b * 8 + h) * 2]) + __builtin_bit_cast(float, kstat[(b * 8 + h) * 2 + 1]);
        qkb = sqrtf(qs * kmax2) * 1.02f + 0.01f;
    }
    if (MODE == 2) { sink2 = sinks[h] * LOG2E; m_run = sink2; }
    f32x16 o0, o1;
#pragma unroll
    for (int r = 0; r < 16; ++r) { o0[r] = 0.f; o1[r] = 0.f; }
    const int kb_lo = (MODE == 2) ? (qt >= 4 ? qt - 4 : 0) : 0;
    constexpr int RATE = (MODE == 2) ? 2 : 1;
    const int nb_lo = (MODE == 2) ? (qg * 8 >= 8 ? qg * 8 - 8 : 0) : 0;
    bool done = false, posted = false;
    int lo_w = qg * 8;
    bf16x8 tn_a[RATE], tn_b[RATE]; f32x4 fkN[4]; float FrN = 0.f;
#define ATT_FLOAD(kb_) do { if (MODE == 0) { const int k0_ = (kb_) * 32; fkN[0] = *(const f32x4*)(Fp + k0_ + 8 * hh); fkN[1] = *(const f32x4*)(Fp + k0_ + 8 * hh + 4); fkN[2] = *(const f32x4*)(Fp + k0_ + 16 + 8 * hh); \
        fkN[3] = *(const f32x4*)(Fp + k0_ + 16 + 8 * hh + 4); FrN = Fp[k0_ > 0 ? k0_ - 1 : 0]; } } while (0)
#pragma unroll
    for (int r = 0; r < RATE; ++r) { const int lb_ = qg * 8 - 1 - r; tn_a[r] = *(const bf16x8*)(gsrc + (size_t)(lb_ >= nb_lo ? lb_ : nb_lo) * gstep); }
    ATT_FLOAD(qt);
    __syncthreads();
#define ATT_STEP(I, TO, TN) { \
        const int nb = qg * 8 - 1 - RATE * (I); \
_Pragma("unroll") \
        for (int r = 0; r < RATE; ++r) { const int lb_ = nb - RATE - r; TN[r] = *(const bf16x8*)(gsrc + (size_t)(lb_ >= nb_lo ? lb_ : nb_lo) * gstep); } \
        const int kb = qt - (I); \
        if (!done && kb < kb_lo) done = true; \
        if (!done) { \
            const LAS unsigned char* sl = lds + (kb % ATT_NS) * ATT_SLOT; \
            bf16x8 kf[4]; f32x4 fk[4]; \
_Pragma("unroll") \
            for (int c = 0; c < 4; ++c) { kf[c] = *(const LAS bf16x8*)(sl + ksw * ATT_KPITCH + c * 32 + hh * 16); fk[c] = fkN[c]; } \
            const LAS unsigned char* vp = sl + ATT_VOFF + n * ATT_VPITCH + hh * 16; \
            const bf16x8 v00 = *(const LAS bf16x8*)(vp), v01 = *(const LAS bf16x8*)(vp + 32), v10 = *(const LAS bf16x8*)(vp + 32 * ATT_VPITCH), v11 = *(const LAS bf16x8*)(vp + 32 * ATT_VPITCH + 32); \
            const float Fr = FrN; \
            ATT_FLOAD(kb > kb_lo ? kb - 1 : kb_lo); \
            f32x16 s; \
_Pragma("unroll") \
            for (int r = 0; r < 16; ++r) s[r] = 0.f; \
_Pragma("unroll") \
            for (int c = 0; c < 4; ++c) s = MFMA32(kf[c], qf[c], s); \
            float p[16]; \
            if (MODE == 0 || MODE == 2) { \
                if (MODE == 0) { \
_Pragma("unroll") \
                    for (int r = 0; r < 16; ++r) p[r] = s[r] + (Fq - fk[r >> 2][r & 3]); \
                } else { \
_Pragma("unroll") \
                    for (int r = 0; r < 16; ++r) p[r] = s[r]; \
                } \
                if (kb == qt) { \
_Pragma("unroll") \
                    for (int r = 0; r < 16; ++r) { const int kl = 16 * (r >> 3) + 8 * hh + (r & 7); if (kl > n) p[r] = -1e30f; } \
                } \
                if (MODE == 2 && kb == qt - 4) { \
_Pragma("unroll") \
                    for (int r = 0; r < 16; ++r) { const int kl = 16 * (r >> 3) + 8 * hh + (r & 7); if (kl <= n) p[r] = -1e30f; } \
                } \
                float mx = p[0]; \
_Pragma("unroll") \
                for (int r = 1; r < 16; ++r) mx = fmaxf(mx, p[r]); \
                mx = fmaxf(mx, __shfl_xor(mx, 32)); \
                const float mnew = fmaxf(m_run, mx), alpha = __builtin_amdgcn_exp2f(m_run - mnew); \
                float ps = 0.f; \
_Pragma("unroll") \
                for (int r = 0; r < 16; ++r) { p[r] = __builtin_amdgcn_exp2f(p[r] - mnew); ps += p[r]; } \
                l_run = l_run * alpha + ps; m_run = mnew; \
                if (!__all(alpha == 1.0f)) { _Pragma("unroll") for (int r = 0; r < 16; ++r) { o0[r] *= alpha; o1[r] *= alpha; } } \
            } else { \
                float om[16], ex[16], T[2]; \
_Pragma("unroll") \
                for (int r = 0; r < 16; ++r) { om[r] = __builtin_amdgcn_rcpf(1.0f + __builtin_amdgcn_exp2f(s[r])); p[r] = 1.0f - om[r]; } \
                if (kb == qt) { \
_Pragma("unroll") \
                    for (int r = 0; r < 16; ++r) { const int kl = 16 * (r >> 3) + 8 * hh + (r & 7); if (kl >= n) { om[r] = 1.0f; p[r] = 0.f; } } \
                } \
_Pragma("unroll") \
                for (int c = 0; c < 2; ++c) { float run = 1.0f; \
_Pragma("unroll") \
                    for (int j = 7; j >= 0; --j) { ex[8 * c + j] = run; run *= om[8 * c + j]; } \
                    T[c] = run; } \
                const float P0 = __shfl_xor(T[0], 32), P1 = __shfl_xor(T[1], 32); \
                const float off0 = cfac * (hh == 0 ? (P0 * T[1] * P1) : (P1 * T[1])), off1 = cfac * (hh == 0 ? P1 : 1.0f); \
_Pragma("unroll") \
                for (int r = 0; r < 16; ++r) p[r] = p[r] * ex[r] * (r < 8 ? off0 : off1); \
                const float tot = (T[0] * T[1]) * (P0 * P1); \
                cfac *= tot; carry += __builtin_amdgcn_logf(tot); \
            } \
            bf16x8 pf0, pf1; \
            { u32x4 w0, w1; w0.x = cvtpk(p[0], p[1]); w0.y = cvtpk(p[2], p[3]); w0.z = cvtpk(p[4], p[5]); w0.w = cvtpk(p[6], p[7]); \
              w1.x = cvtpk(p[8], p[9]); w1.y = cvtpk(p[10], p[11]); w1.z = cvtpk(p[12], p[13]); w1.w = cvtpk(p[14], p[15]); \
              pf0 = __builtin_bit_cast(bf16x8, w0); pf1 = __builtin_bit_cast(bf16x8, w1); } \
            o0 = MFMA32(v00, pf0, o0); o0 = MFMA32(v01, pf1, o0); o1 = MFMA32(v10, pf0, o1); o1 = MFMA32(v11, pf1, o1); \
            if (MODE == 0 && (I) >= ATT_MINBLK) { if (__all((qkb + (Fq - Fr) - m_run) < -152.0f)) done = true; } \
            if (MODE == 1 && (I) >= ATT_MINBLK) { if (__all(carry < -152.0f)) done = true; } \
            if (kb == kb_lo) done = true; \
        } \
        if (done && !posted) { posted = true; if (lane == 0) flags[wave] = (I); } \
_Pragma("unroll") \
        for (int r = 0; r < RATE; ++r) { if (nb - r >= nb_lo) { *(LAS bf16x8*)(lds + ((nb - r) % ATT_NS) * ATT_SLOT + loff) = TO[r]; lo_w = nb - r; }  } \
        __syncthreads(); \
        const int fl = flags[lane & 7]; \
        if (__all(fl <= (I))) break; \
    }
    for (int i2 = 0; ; i2 += 2) {
        ATT_STEP(i2, tn_a, tn_b)
        ATT_STEP(i2 + 1, tn_b, tn_a)
    }
#undef ATT_STEP
    float inv = 1.0f;
    if (MODE == 0 || MODE == 2) { float l = l_run + __shfl_xor(l_run, 32); if (MODE == 2) l += __builtin_amdgcn_exp2f(sink2 - m_run); inv = 1.0f / l; }
    bf16_t* Op = O + (rowb + q0 + n) * D + ocol + 4 * hh;
#pragma unroll
    for (int i = 0; i < 4; ++i) {
        u32x2 w; w.x = cvtpk(o0[4 * i] * inv, o0[4 * i + 1] * inv); w.y = cvtpk(o0[4 * i + 2] * inv, o0[4 * i + 3] * inv); *(u32x2*)(Op + 8 * i) = w;
        u32x2 y; y.x = cvtpk(o1[4 * i] * inv, o1[4 * i + 1] * inv); y.y = cvtpk(o1[4 * i + 2] * inv, o1[4 * i + 3] * inv); *(u32x2*)(Op + 32 + 8 * i) = y;
    }
    return lo_w;
}

#undef ATT_FLOAD
#define REP_P0 0
#define REP_GIN0 0
#define REP_ATT0 0
#define REP_GU 0
#define REP_SWA 0
#define REP_SYNC 0
#define ALIGN1 true
#define ALIGNM true
#define REP_T 0
#define REP_NG 0
#define REP_PR 0
#define REP_GOUT0 0
#define REP_DOWN0 0
#define REP_PG0 0
__global__ void __launch_bounds__(NTHREADS, 2) mk_fwd(Params P) {
    extern __shared__ __attribute__((aligned(16))) unsigned char lds_raw[];
    LAS unsigned char* lds = (LAS unsigned char*)lds_raw;
    cg::grid_group grid = cg::this_grid();
    const int G = gridDim.x, NGW = G * NWAVES, NGT = G * NTHREADS;
    if (threadIdx.x < 32) ((LAS unsigned*)(lds + RING_BYTES))[threadIdx.x] = 0u;
    __syncthreads();
    const XcdBarrier xbar = xcd_barrier_post((unsigned*)(P.ws + WS_BAR), (volatile LAS unsigned*)(lds + RING_BYTES));
    if (P.ph_hi < 0) grid.sync();
#define IDS int tid = threadIdx.x; asm volatile("" : "+v"(tid)); const int lane = tid & 63, wave = __builtin_amdgcn_readfirstlane(tid >> 6), gw = blockIdx.x * NWAVES + wave, gt = blockIdx.x * NTHREADS + tid; (void)gw; (void)gt; (void)lane;
    unsigned char* ws = P.ws;
    unsigned* kstat = (unsigned*)(ws + WS_KSTAT); float* tot = (float*)(ws + WS_TOT); float* ropeC = (float*)(ws + WS_ROPEC); float* ropeS = (float*)(ws + WS_ROPES); float* Fc = (float*)(ws + WS_F);
    bf16_t* Win0 = (bf16_t*)(ws + WS_WIN0); bf16_t* Wout0 = (bf16_t*)(ws + WS_WOUT0); bf16_t* Win1 = (bf16_t*)(ws + WS_WIN1); bf16_t* Wout1 = (bf16_t*)(ws + WS_WOUT1);
    bf16_t* Wgu = (bf16_t*)(ws + WS_WGU); bf16_t* Wdn = (bf16_t*)(ws + WS_WDN); bf16_t* Wpp = (bf16_t*)(ws + WS_WPP); bf16_t* Wpg = (bf16_t*)(ws + WS_WPG);
    bf16_t* pbf = (bf16_t*)(ws + WS_PBF); bf16_t* hn = (bf16_t*)(ws + WS_HN); bf16_t* Ob = (bf16_t*)(ws + WS_O); bf16_t* PP = Ob; bf16_t* QK = (bf16_t*)(ws + WS_QK); bf16_t* VT = (bf16_t*)(ws + WS_VT); bf16_t* ACT = (bf16_t*)(ws + WS_ACT);
    bf16_t* hb2 = (bf16_t*)(ws + WS_HB2); bf16_t* VT1 = (bf16_t*)(ws + WS_VT1); float* ssq = (float*)(ws + WS_SSQ); bf16_t* ACT1 = (bf16_t*)(ws + WS_ACT1); bf16_t* PP1 = (bf16_t*)(ws + WS_PP1);
    float* h = P.out;
    const int lo = P.ph_lo, hi = P.ph_hi;
#define IN(k) (lo <= (k) && (k) < hi)
#define SEAM(k) do { if (IN(k) && IN((k) + 1)) xcd_barrier(xbar); } while (0)
#define GEMM(EpiT, E, A_, B_, N_, K_) do { int k_ = (K_); asm volatile("" : "+s"(k_)); pg8::Gemm g_{A_, B_, M, N_, k_}; pg8::StaticOrder S_; S_.init(M, N_, G, (int)blockIdx.x); pg8::gemm_phase<EpiT, pg8::StaticOrder, ALIGNM, true>(lds, g_, S_, E); } while (0)
#define GEMM1(EpiT, E, A_, B_, N_, K_) do { int k_ = (K_); asm volatile("" : "+s"(k_)); pg8::Gemm g_{A_, B_, M, N_, k_}; pg8::StaticOrder S_; S_.init(M, N_, G, (int)blockIdx.x); pg8::gemm_phase<EpiT, pg8::StaticOrder, ALIGN1, true>(lds, g_, S_, E); } while (0)

#define GEMM_SUB(EpiT, E, A_, B_, N_, K_, c0_) do { const int c0v_ = (c0_); if ((int)blockIdx.x >= c0v_) { int k_ = (K_); asm volatile("" : "+s"(k_)); pg8::Gemm g_{A_, B_, M, N_, k_}; pg8::StaticOrder S_; S_.init(M, N_, G - c0v_, (int)blockIdx.x - c0v_); \
        pg8::gemm_phase<EpiT, pg8::StaticOrder, true, true>(lds, g_, S_, E); } } while (0)
    if (IN(0)) for (int rep_ = 0; rep_ <= REP_P0; ++rep_) { IDS
        if (rep_ > 0) xcd_barrier(xbar);
        if (blockIdx.x == 0 && tid < 32) kstat[tid] = 0u;
        for (int i = gt; i < 6 * M; i += NGT) ssq[i] = 0.f;
        LAS float* scr = (LAS float*)(lds + wave * 16384);
        constexpr int I_IN0 = 16 * 96, I_SQ = 16 * 32, I_IN1 = 16 * 48, I_FF = 16 * 88, I_DN = 44 * 32, I_PP = 4 * 32;
        constexpr int NITEMS = I_IN0 + I_SQ + I_IN1 + I_SQ + 4 * I_FF + 2 * I_DN + 2 * I_PP + 2 * I_SQ;
#define T_DECODE(it_, J) do { int r = (it_); \
            if (r < I_IN0) { J = TJob{P.ev_w_in, Win0, nullptr, 3080, D, 3072, 0, 0, r}; break; } r -= I_IN0; \
            if (r < I_SQ) { J = TJob{P.ev_w_out, Wout0, nullptr, D, D, D, 0, 0, r}; break; } r -= I_SQ; \
            if (r < I_IN1) { J = TJob{P.od_w_in, Win1, P.norm_mix + D, 1536, D, 1536, 2, 0, r}; break; } r -= I_IN1; \
            if (r < I_SQ) { J = TJob{P.od_w_out, Wout1, nullptr, D, D, D, 0, 0, r}; break; } r -= I_SQ; \
            if (r < 4 * I_FF) { const int which = r / I_FF, l = which >> 1, up = which & 1; J = TJob{(up ? P.ffn_w_up : P.ffn_w_gate) + (size_t)l * D * DFF, Wgu + l * WGU_STRIDE, P.norm_ffn + l * D, DFF, D, DFF, 1, up * 128, r % I_FF}; break; } r -= 4 * I_FF; \
            if (r < 2 * I_DN) { const int l = r / I_DN; J = TJob{P.ffn_w_down + (size_t)l * DFF * D, Wdn + l * WDN_STRIDE, nullptr, D, DFF, D, 0, 0, r % I_DN}; break; } r -= 2 * I_DN; \
            if (r < 2 * I_PP) { const int l = r / I_PP; J = TJob{P.ple_w_proj + (size_t)l * 256 * D, Wpp + l * WPP_STRIDE, nullptr, D, 256, D, 0, 0, r % I_PP}; break; } r -= 2 * I_PP; \
            { const int l = r / I_SQ; J = TJob{P.ple_w_gate + (size_t)l * D * D, Wpg + l * WPG_STRIDE, P.norm_ple + l * D, D, D, D, 0, 0, r % I_SQ}; } } while (0)
        for (int rt_ = 0; rt_ <= REP_T; ++rt_)
        {
            float tA[32], tB[32]; TJob jc, jn; int it = gw; bool have = it < NITEMS;
            if (have) { T_DECODE(it, jc); transpose_issue(jc, tA, lane); }
            while (have) {
                const int itn = it + NGW; const bool haven = itn < NITEMS;
                if (haven) { T_DECODE(itn, jn); transpose_issue(jn, tB, lane); }
                transpose_finish(jc, tA, scr, lane);
#pragma unroll
                for (int i = 0; i < 32; ++i) tA[i] = tB[i];
                jc = jn; it = itn; have = haven;
            }
        }
#undef T_DECODE
        for (int rp_ = 0; rp_ <= REP_PR; ++rp_)
        for (int i0 = gt; i0 < 2 * M * 256 / 8; i0 += 4 * NGT) { f32x4 a[4], c[4];
#pragma unroll
            for (int k = 0; k < 4; ++k) { const int i = i0 + k * NGT; if (i < 2 * M * 256 / 8) { a[k] = __builtin_nontemporal_load((const f32x4*)P.p + 2 * i); c[k] = __builtin_nontemporal_load((const f32x4*)P.p + 2 * i + 1); } }
#pragma unroll
            for (int k = 0; k < 4; ++k) { const int i = i0 + k * NGT; if (i < 2 * M * 256 / 8) ((u32x4*)pbf)[i] = pg8::pack8(a[k], c[k]); } }
        for (int i = gt; i < M * 32; i += NGT) { float c, s; rope_entry(P.pos[i >> 5], i & 31, c, s); ropeC[i] = c; ropeS[i] = s; }
        __syncthreads();
        for (int rn_ = 0; rn_ <= REP_NG; ++rn_) norm_phase<true, false>(P.x, P.norm_mix, hn, lds, P.ev_w_in, P.ev_b_f, Fc, tot, tid, lane, wave);
    }
    SEAM(0);
    if (IN(1)) { IDS
        LAS float* offs = (LAS float*)lds;
        for (int item = blockIdx.x; item < 256; item += G) {
            const int bh = item >> 4, part = item & 15;
            if (tid < 128) offs[tid] = tot[bh * 128 + tid];
            __syncthreads();
            if (wave == 0) { const float a = offs[2 * lane], b2 = offs[2 * lane + 1], s2 = a + b2; float inc = s2;
#pragma unroll
                for (int o = 1; o < 64; o <<= 1) { const float t = __shfl_up(inc, o); if (lane >= o) inc += t; }
                const float exc = inc - s2; offs[128 + 2 * lane] = exc; offs[128 + 2 * lane + 1] = exc + a; }
            __syncthreads();
            { const int sidx = part * 512 + tid; float* fp = Fc + (size_t)bh * S + sidx; *fp = (*fp + offs[128 + (sidx >> 6)]) * LOG2E; }
            __syncthreads();
        }
        pg8::EpiL0In E{QK, VT, kstat};
        for (int rep_ = 0; rep_ <= REP_GIN0; ++rep_) GEMM(pg8::EpiL0In, E, hn, Win0, 3072, D);
    }
    SEAM(1);
    if (IN(2)) for (int rep_ = 0; rep_ <= REP_ATT0; ++rep_) { IDS
        if (rep_ > 0) xcd_barrier(xbar);
        for (int ch = blockIdx.x; ch < 2 * 8 * 16; ch += G) {
            const int cc = ch >> 4, b = (ch >> 3) & 1, hd = ch & 7; bf16x8 qfN[4]; float FqN = 0.f; int res = 1 << 28;
            for (int q = 1; q >= 0; --q) res = attn_wg<0>(QK, VT, Ob, Fc, kstat, nullptr, b, hd, 2 * cc + q, res, q == 1, q > 0, qfN, FqN, lds, tid, lane, wave);
            res = 1 << 28;
            for (int q = 1; q >= 0; --q) res = attn_wg<1>(QK, VT, Ob, nullptr, nullptr, nullptr, b, hd, 2 * cc + q, res, q == 1, q > 0, qfN, FqN, lds, tid, lane, wave);
        }
        __syncthreads();
    }
    SEAM(2);
    if (IN(3)) { { pg8::EpiResid<true> E{P.x, nullptr, hn, Fc, 1.0f}; for (int rep_ = 0; rep_ < REP_GOUT0; ++rep_) GEMM1(pg8::EpiResid<true>, E, Ob, Wout0, D, D); }
                 pg8::EpiResid<true> E{P.x, nullptr, hn, ssq, 1.0f}; GEMM1(pg8::EpiResid<true>, E, Ob, Wout0, D, D); }
    SEAM(3);
    if (IN(4)) { { pg8::EpiSwiGLU E{ACT, ssq}; for (int rep_ = 0; rep_ <= REP_GU; ++rep_) GEMM(pg8::EpiSwiGLU, E, hn, Wgu, 2 * DFF, D); }
                 { pg8::EpiStore E{PP, D}; GEMM_SUB(pg8::EpiStore, E, pbf, Wpp, D, 256, (64 * 22) % G); } }
    SEAM(4);
    if (IN(5)) { { pg8::EpiResid<false> E{nullptr, hn, hn, Fc, 0.0f}; for (int rep_ = 0; rep_ < REP_DOWN0; ++rep_) GEMM1(pg8::EpiResid<false>, E, ACT, Wdn, D, DFF); }
                 pg8::EpiResid<false> E{nullptr, hn, hn, ssq + M, 1.0f}; GEMM1(pg8::EpiResid<false>, E, ACT, Wdn, D, DFF); }
    SEAM(5);
    if (IN(6)) { { pg8::EpiPle E{hn, PP, ssq + M, hb2, Fc, 0.0f}; for (int rep_ = 0; rep_ < REP_PG0; ++rep_) GEMM1(pg8::EpiPle, E, hn, Wpg, D, D); }
                 pg8::EpiPle E{hn, PP, ssq + M, hb2, ssq + 2 * M, 1.0f}; GEMM1(pg8::EpiPle, E, hn, Wpg, D, D); }
    SEAM(6);
    if (IN(7)) { { pg8::EpiL1In E{QK, VT1, ropeC, ropeS, ssq + 2 * M}; GEMM(pg8::EpiL1In, E, hb2, Win1, 1536, D); }
                 { pg8::EpiStore E{PP1, D}; GEMM_SUB(pg8::EpiStore, E, pbf + (size_t)M * 256, Wpp + WPP_STRIDE, D, 256, (64 * 6) % G); } }
    SEAM(7);
    if (IN(8)) for (int rep_ = 0; rep_ <= REP_SWA; ++rep_) { IDS
        if (rep_ > 0) xcd_barrier(xbar);
        for (int ch = blockIdx.x; ch < 2 * 16 * 8; ch += G) { const int c = ch >> 5, b = (ch >> 4) & 1, hd = ch & 15; int res = 1 << 28; bf16x8 qfN[4]; float FqN = 0.f;
            for (int q = 3; q >= 0; --q) res = attn_wg<2>(QK, VT1, Ob, nullptr, nullptr, P.od_sinks, b, hd, 4 * c + q, res, q == 3, q > 0, qfN, FqN, lds, tid, lane, wave); }
        __syncthreads();
    }
    SEAM(8);
    if (IN(9)) { pg8::EpiResid<false> E{nullptr, hb2, hn, ssq + 3 * M, 1.0f}; GEMM1(pg8::EpiResid<false>, E, Ob, Wout1, D, D); }
    SEAM(9);
    if (IN(10)) { pg8::EpiSwiGLU E{ACT1, ssq + 3 * M}; GEMM(pg8::EpiSwiGLU, E, hn, Wgu + WGU_STRIDE, 2 * DFF, D); }
    SEAM(10);
    if (IN(11)) { pg8::EpiResid<false> E{nullptr, hn, hn, ssq + 4 * M, 1.0f}; GEMM1(pg8::EpiResid<false>, E, ACT1, Wdn + WDN_STRIDE, D, DFF); }
    SEAM(11);
    if (IN(12)) { pg8::EpiPle E{hn, PP1, ssq + 4 * M, hb2, ssq + 5 * M, 1.0f}; GEMM1(pg8::EpiPle, E, hn, Wpg + WPG_STRIDE, D, D); }
    SEAM(12);
    for (int rep_ = 0; rep_ < REP_SYNC; ++rep_) xcd_barrier(xbar);
    if (IN(13)) { IDS
        f32x4 g4[4];
#pragma unroll
        for (int q = 0; q < 4; ++q) g4[q] = *(const f32x4*)(P.norm_final + 8 * lane + 512 * (q >> 1) + 4 * (q & 1));
        for (int r0 = gw * 8; r0 < M; r0 += NGW * 8) {
            u32x4 w[8][2];
#pragma unroll
            for (int rr = 0; rr < 8; ++rr) { const u32x4* hp = (const u32x4*)(hb2 + (size_t)(r0 + rr) * D) + lane; w[rr][0] = __builtin_nontemporal_load(hp); w[rr][1] = __builtin_nontemporal_load(hp + 64); }
#pragma unroll
            for (int rr = 0; rr < 8; ++rr) { const float rs = pg8::row_rstd(ssq + 5 * M, r0 + rr); f32x4* op = (f32x4*)(h + (size_t)(r0 + rr) * D) + 2 * lane;
#pragma unroll
                for (int q = 0; q < 2; ++q) { const u32x4 x = w[rr][q];
                    const f32x4 a = {pg8::bflo(x.x), pg8::bfhi(x.x), pg8::bflo(x.y), pg8::bfhi(x.y)}, c = {pg8::bflo(x.z), pg8::bfhi(x.z), pg8::bflo(x.w), pg8::bfhi(x.w)};
                    __builtin_nontemporal_store(a * rs * g4[2 * q], op + 128 * q); __builtin_nontemporal_store(c * rs * g4[2 * q + 1], op + 128 * q + 1); } }
        }
    }
#undef IN
#undef SEAM
#undef GEMM
}

#ifndef MK_PER_PHASE
#define MK_PER_PHASE 0
#endif
constexpr int N_PHASES = 14;
extern "C" void kernel_launch(void* const* d_in, const int* in_sizes, int n_in, void* d_out, int out_size, void* d_ws, size_t ws_size, hipStream_t stream) {
    static int grid_blocks = 0;
    if (grid_blocks == 0) {
        if (n_in != 18 || out_size != M * D || ws_size < WS_END) { fprintf(stderr, "kernel_launch: unexpected shapes (n_in %d, out %d, ws %zu)\n", n_in, out_size, ws_size); grid_blocks = -1; return; }
        int dev = 0, cus = 0, per_cu = 0;
        hipGetDevice(&dev); hipDeviceGetAttribute(&cus, hipDeviceAttributeMultiprocessorCount, dev);
        if (hipFuncSetAttribute((const void*)mk_fwd, hipFuncAttributeMaxDynamicSharedMemorySize, LDS_BYTES) != hipSuccess) { fprintf(stderr, "kernel_launch: hipFuncSetAttribute failed\n"); grid_blocks = -1; return; }
        if (hipOccupancyMaxActiveBlocksPerMultiprocessor(&per_cu, (const void*)mk_fwd, NTHREADS, LDS_BYTES) != hipSuccess || per_cu < 1) { fprintf(stderr, "kernel_launch: occupancy query gave %d\n", per_cu); per_cu = 1; (void)hipGetLastError(); }
        grid_blocks = cus * 1;
    }
    if (grid_blocks < 0) return;
#define REP_LAUNCH 0
    for (int pass_ = 0; pass_ <= REP_LAUNCH; ++pass_) {
    if (hipMemsetAsync((char*)d_ws, 0, WS_ZERO_BYTES, stream) != hipSuccess) { fprintf(stderr, "kernel_launch: hipMemsetAsync failed\n"); return; }
    Params p{};
    p.x = (const float*)d_in[0]; p.p = (const float*)d_in[1]; p.pos = (const int*)d_in[2];
    p.norm_mix = (const float*)d_in[3]; p.norm_ffn = (const float*)d_in[4]; p.norm_ple = (const float*)d_in[5]; p.norm_final = (const float*)d_in[6];
    p.ev_w_in = (const float*)d_in[7]; p.ev_b_f = (const float*)d_in[8]; p.ev_w_out = (const float*)d_in[9]; p.od_w_in = (const float*)d_in[10]; p.od_sinks = (const float*)d_in[11]; p.od_w_out = (const float*)d_in[12];
    p.ffn_w_gate = (const float*)d_in[13]; p.ffn_w_up = (const float*)d_in[14]; p.ffn_w_down = (const float*)d_in[15]; p.ple_w_proj = (const float*)d_in[16]; p.ple_w_gate = (const float*)d_in[17];
    p.out = (float*)d_out; p.ws = (unsigned char*)d_ws;
#if MK_PER_PHASE
    for (int ph = 0; ph < N_PHASES; ++ph) {
        p.ph_lo = ph; p.ph_hi = ph + 1;
        void* args[] = {&p};
        hipError_t e = hipLaunchCooperativeKernel((const void*)mk_fwd, dim3(grid_blocks), dim3(NTHREADS), args, LDS_BYTES, stream);
        if (e != hipSuccess) { fprintf(stderr, "cooperative launch (phase %d) failed: %s (grid %d)\n", ph, hipGetErrorString(e), grid_blocks); break; }
    }
#else
    p.ph_lo = 0; p.ph_hi = N_PHASES;
    void* args[] = {&p};
    hipError_t e = hipLaunchCooperativeKernel((const void*)mk_fwd, dim3(grid_blocks), dim3(NTHREADS), args, LDS_BYTES, stream);
    if (e != hipSuccess) fprintf(stderr, "cooperative launch failed: %s (grid %d)\n", hipGetErrorString(e), grid_blocks);
#endif
    }
}
```

```cpp
#include <hip/hip_runtime.h>
#include <hip/hip_cooperative_groups.h>
#include <cstdio>
#include <cstdint>
#include <cmath>
namespace cg = cooperative_groups;
namespace pg8 {
#define PG8_LAS __attribute__((address_space(3)))
typedef unsigned short bf16_t;
typedef short bf16x8 __attribute__((ext_vector_type(8)));
typedef float f32x4 __attribute__((ext_vector_type(4)));
typedef unsigned u32x4 __attribute__((ext_vector_type(4)));
constexpr int BM = 256, BK = 64, HALF = 128, HTB = HALF * BK * 2  , STAGE_BYTES = 8 * HTB, NXCD = 8, WGM = 8;

__host__ __device__ __forceinline__ int lds_byte(int r, int c) { const int st = (r >> 4) * 2 + (c >> 5), rr = r & 15, cc = c & 31, ob = rr * 64 + cc * 2; return st * 1024 + (ob ^ (((ob >> 9) & 1) << 5)); }
__host__ __device__ __forceinline__ void stage_rc(int b, int& R, int& C) { const int st = b / 1024, sb = b % 1024, swz = sb ^ (((sb >> 9) & 1) << 5); R = (st >> 1) * 16 + swz / 64; C = (st & 1) * 32 + (swz % 64) / 2; }
__host__ __device__ __forceinline__ int perm32(int rho) { const int n = rho >> 4, i = rho & 15; return 8 * (i >> 2) + 4 * n + (i & 3); }

struct Unit { int pm, pn; };
struct Gemm { const bf16_t* A; const bf16_t* Bt; int M, N, K; };

struct StaticOrder {
    int nM, nN, nwg, G, c;
    __host__ __device__ void init(int M, int N, int G_, int c_) { nM = M / BM; nN = N / BM; nwg = nM * nN; G = G_; c = c_; }
    __host__ __device__ bool next(int i, Unit& u) const {
        const long L = (long)i * G + c; if (L >= nwg) return false;
        int wgid = (int)L; { const int q = nwg / NXCD, r = nwg % NXCD, xcd = wgid % NXCD, off = wgid / NXCD; wgid = (xcd < r ? xcd * (q + 1) : r * (q + 1) + (xcd - r) * q) + off; }
        const int nig = WGM * nN, gid = wgid / nig, fm = gid * WGM, gsz = (nM - fm) < WGM ? (nM - fm) : WGM;
        u.pm = fm + ((wgid % nig) % gsz); u.pn = (wgid % nig) / gsz; return true;
    }
    __device__ __forceinline__ void a_ready(const Unit&) const {}
    __device__ __forceinline__ void done(const Unit&) const {}
};

typedef float f32x2 __attribute__((ext_vector_type(2)));
typedef __bf16 bf16x2_t __attribute__((ext_vector_type(2)));
typedef unsigned u32x2 __attribute__((ext_vector_type(2)));
__device__ __forceinline__ unsigned cvtpk(float lo, float hi) { f32x2 v = {lo, hi}; bf16x2_t b = __builtin_convertvector(v, bf16x2_t); return __builtin_bit_cast(unsigned, b); }
__device__ __forceinline__ u32x4 pack8(f32x4 a, f32x4 b) { u32x4 w; w.x = cvtpk(a[0], a[1]); w.y = cvtpk(a[2], a[3]); w.z = cvtpk(b[0], b[1]); w.w = cvtpk(b[2], b[3]); return w; }
__device__ __forceinline__ float bflo(unsigned w) { return __builtin_bit_cast(float, w << 16); }
__device__ __forceinline__ float bfhi(unsigned w) { return __builtin_bit_cast(float, w & 0xffff0000u); }
__device__ __forceinline__ float fast_sigmoid(float x) { return __builtin_amdgcn_rcpf(1.0f + __builtin_amdgcn_exp2f(-x * 1.4426950408889634f)); }
__device__ __forceinline__ float row_rstd(const float* ssq, int row) { return __builtin_amdgcn_rsqf(ssq[row] * (1.0f / 1024.0f) + 1e-6f); }
__device__ __forceinline__ void st16_wt(void* p, u32x4 v) { asm volatile("global_store_dwordx4 %0, %1, off sc1\n\ts_nop 1" :: "v"(p), "v"(v) : "memory"); }
#ifndef WT_RESID
#define WT_RESID 0
#endif
#ifndef WT_WIDE
#define WT_WIDE 0
#endif
#ifndef WT_QK
#define WT_QK 0
#endif
#ifndef NT_QK
#define NT_QK 0
#endif
#ifndef NT_ACT
#define NT_ACT 0
#endif
#define EPI_ARGS const f32x4 (&acc)[2][2][4][2], const Unit& u, int wr, int wc, int fr, int fq
#define EPI_FLAGS static constexpr bool PERM = true, AFTER_DRAIN = false;
__device__ __forceinline__ void vt_store8(bf16_t* p, f32x4 a, f32x4 b) {
    const unsigned w0 = cvtpk(a[0], a[1]), w1 = cvtpk(a[2], a[3]), w2 = cvtpk(b[0], b[1]), w3 = cvtpk(b[2], b[3]);
    p[0 * 8192] = (bf16_t)(w0 & 0xffffu); p[1 * 8192] = (bf16_t)(w0 >> 16); p[2 * 8192] = (bf16_t)(w1 & 0xffffu); p[3 * 8192] = (bf16_t)(w1 >> 16);
    p[4 * 8192] = (bf16_t)(w2 & 0xffffu); p[5 * 8192] = (bf16_t)(w2 >> 16); p[6 * 8192] = (bf16_t)(w3 & 0xffffu); p[7 * 8192] = (bf16_t)(w3 >> 16);
}

struct EpiStore {
    EPI_FLAGS
    bf16_t* O; int ldc;
    __device__ __forceinline__ void operator()(EPI_ARGS) const {
        const int row0 = u.pm * BM + wr * 64 + fr, col0 = u.pn * BM + wc * 32 + 8 * fq;
#pragma unroll
        for (int ai = 0; ai < 2; ++ai)
#pragma unroll
            for (int m = 0; m < 4; ++m) { bf16_t* rowp = O + (size_t)(row0 + ai * HALF + m * 16) * ldc + col0;
#pragma unroll
                for (int bj = 0; bj < 2; ++bj) { if (WT_WIDE) st16_wt(rowp + bj * HALF, pack8(acc[ai][bj][m][0], acc[ai][bj][m][1])); else *(u32x4*)(rowp + bj * HALF) = pack8(acc[ai][bj][m][0], acc[ai][bj][m][1]); } }
    }
};

struct EpiL0In {
    EPI_FLAGS
    bf16_t* QK; bf16_t* VT; unsigned* kstat;
    __device__ __forceinline__ void operator()(EPI_ARGS) const {
        const int sec = u.pn >> 1, half = u.pn & 1, row0 = u.pm * BM + wr * 64 + fr, b = u.pm >> 5;
        if (sec == 2 || sec == 5) {
#pragma unroll
            for (int ai = 0; ai < 2; ++ai)
#pragma unroll
                for (int m = 0; m < 4; ++m) { const int s = (row0 + ai * HALF + m * 16) & 8191;
#pragma unroll
                    for (int bj = 0; bj < 2; ++bj) { const int colt = half * 256 + bj * 128 + wc * 32 + 8 * fq, head = (colt >> 6) + (sec == 5 ? 8 : 0), d0 = colt & 63;
                        vt_store8(VT + ((size_t)(b * 16 + head) * 64 + d0) * 8192 + s, acc[ai][bj][m][0], acc[ai][bj][m][1]); } }
        } else {
            const float sc = (sec == 0 || sec == 3) ? 0.125f * 1.4426950408889634f : 1.0f;
            const int cbase = (sec == 0 ? 0 : sec == 1 ? 512 : sec == 3 ? 1024 : 1536) + half * 256 + wc * 32 + 8 * fq;
#pragma unroll
            for (int ai = 0; ai < 2; ++ai)
#pragma unroll
                for (int m = 0; m < 4; ++m) { bf16_t* rowp = QK + (size_t)(row0 + ai * HALF + m * 16) * 2048 + cbase;
#pragma unroll
                    for (int bj = 0; bj < 2; ++bj) { if (NT_QK) __builtin_nontemporal_store(pack8(acc[ai][bj][m][0] * sc, acc[ai][bj][m][1] * sc), (u32x4*)(rowp + bj * HALF)); else *(u32x4*)(rowp + bj * HALF) = pack8(acc[ai][bj][m][0] * sc, acc[ai][bj][m][1] * sc); } }
            if (sec == 1) {
#pragma unroll
                for (int bj = 0; bj < 2; ++bj) { float best = 0.f;
#pragma unroll
                    for (int ai = 0; ai < 2; ++ai)
#pragma unroll
                        for (int m = 0; m < 4; ++m) { const f32x4 a = acc[ai][bj][m][0], c = acc[ai][bj][m][1];
                            float ss = (a[0] * a[0] + a[1] * a[1]) + (a[2] * a[2] + a[3] * a[3]) + (c[0] * c[0] + c[1] * c[1]) + (c[2] * c[2] + c[3] * c[3]);
                            ss += __shfl_xor(ss, 16); ss += __shfl_xor(ss, 32); best = fmaxf(best, ss); }
                    best = fmaxf(best, __shfl_xor(best, 1)); best = fmaxf(best, __shfl_xor(best, 2)); best = fmaxf(best, __shfl_xor(best, 4)); best = fmaxf(best, __shfl_xor(best, 8));
                    if (fr == 0 && fq == 0) atomicMax(kstat + ((b * 8 + half * 4 + bj * 2 + (wc >> 1)) * 2 + (wc & 1)), __builtin_bit_cast(unsigned, best)); }
            }
        }
    }
};

struct EpiL1In {
    EPI_FLAGS
    bf16_t* QKV; bf16_t* VT; const float* ropeC; const float* ropeS; const float* ssq;
    __device__ __forceinline__ void operator()(EPI_ARGS) const {
        int fr_ = fr; asm volatile("" : "+v"(fr_));
        const int row0 = u.pm * BM + wr * 64 + fr_, b = u.pm >> 5;
        float sq[2][4];
#pragma unroll
        for (int ai = 0; ai < 2; ++ai)
#pragma unroll
            for (int m = 0; m < 4; ++m) sq[ai][m] = ssq[row0 + ai * HALF + m * 16];
        if (u.pn == 5) {
            asm volatile("" ::: "memory");
#pragma unroll
            for (int ai = 0; ai < 2; ++ai)
#pragma unroll
                for (int m = 0; m < 4; ++m) { const int s = (row0 + ai * HALF + m * 16) & 8191; const float rs = __builtin_amdgcn_rsqf(sq[ai][m] * (1.0f / 1024.0f) + 1e-6f);
#pragma unroll
                    for (int bj = 0; bj < 2; ++bj) { const int colt = bj * 128 + wc * 32 + 8 * fq, head = colt >> 6, d0 = colt & 63;
                        vt_store8(VT + ((size_t)(b * 4 + head) * 64 + d0) * 8192 + s, acc[ai][bj][m][0] * rs, acc[ai][bj][m][1] * rs); } }
        } else {
            const float sc = (u.pn < 4) ? 0.125f * 1.4426950408889634f : 1.0f;
            const int col0 = u.pn * BM + wc * 32 + 8 * fq, j0 = 4 * ((wc & 1) * 4 + fq);
            f32x4 csv[4], snv[4]; u32x4 outs[4][2];
#pragma unroll
            for (int m = 0; m < 4; ++m) { const int row = row0 + m * 16; csv[m] = *(const f32x4*)(ropeC + (size_t)row * 32 + j0); snv[m] = *(const f32x4*)(ropeS + (size_t)row * 32 + j0); }
#pragma unroll
            for (int ai = 0; ai < 2; ++ai) {
                asm volatile("" ::: "memory");
#pragma unroll
                for (int m = 0; m < 4; ++m) { const float rs = __builtin_amdgcn_rsqf(sq[ai][m] * (1.0f / 1024.0f) + 1e-6f) * sc; const f32x4 cs = csv[m] * rs, sn = snv[m] * rs;
#pragma unroll
                    for (int bj = 0; bj < 2; ++bj) { const f32x4 x1 = acc[ai][bj][m][0], x2 = acc[ai][bj][m][1]; outs[m][bj] = pack8(x1 * cs - x2 * sn, x2 * cs + x1 * sn); } }
                if (ai == 0) {
#pragma unroll
                    for (int m = 0; m < 4; ++m) { const int row = row0 + HALF + m * 16; csv[m] = *(const f32x4*)(ropeC + (size_t)row * 32 + j0); snv[m] = *(const f32x4*)(ropeS + (size_t)row * 32 + j0); } }
                asm volatile("" ::: "memory");
#pragma unroll
                for (int m = 0; m < 4; ++m) { bf16_t* rowp = QKV + (size_t)(row0 + ai * HALF + m * 16) * 1280 + col0;
#pragma unroll
                    for (int bj = 0; bj < 2; ++bj) { if (NT_QK) __builtin_nontemporal_store(outs[m][bj], (u32x4*)(rowp + bj * HALF)); else *(u32x4*)(rowp + bj * HALF) = outs[m][bj]; } }
            }
        }
    }
};

#define EPI_FENCE asm volatile("" ::: "memory")
__device__ __forceinline__ float rstd_of(float ssq_row) { return __builtin_amdgcn_rsqf(ssq_row * (1.0f / 1024.0f) + 1e-6f); }
__device__ __forceinline__ float sumsq8(f32x4 r0, f32x4 r1) { return (r0[0] * r0[0] + r0[1] * r0[1]) + (r0[2] * r0[2] + r0[3] * r0[3]) + (r1[0] * r1[0] + r1[1] * r1[1]) + (r1[2] * r1[2] + r1[3] * r1[3]); }

template <bool BASEF32> struct EpiResid {
    EPI_FLAGS
    const float* basef; const bf16_t* baseb; bf16_t* out; float* ssq; float mul;
    __device__ __forceinline__ void load_group(int g, int row0, int col0, f32x4 (&pf)[2][2][2], u32x4 (&pb)[2][2]) const {
#pragma unroll
        for (int r = 0; r < 2; ++r)
#pragma unroll
            for (int bj = 0; bj < 2; ++bj) { const size_t o = (size_t)(row0 + (g >> 1) * HALF + ((g & 1) * 2 + r) * 16) * 1024 + col0 + bj * HALF;
                if (BASEF32) { const f32x4* bp = (const f32x4*)(basef + o); pf[r][bj][0] = __builtin_nontemporal_load(bp); pf[r][bj][1] = __builtin_nontemporal_load(bp + 1); } else pb[r][bj] = *(const u32x4*)(baseb + o); }
    }
    __device__ __forceinline__ void operator()(EPI_ARGS) const {
        const int row0 = u.pm * BM + wr * 64 + fr, col0 = u.pn * BM + wc * 32 + 8 * fq;
        f32x4 pf[2][2][2]; u32x4 pb[2][2], outs[2][2]; float sums[2];
        load_group(0, row0, col0, pf, pb);
#pragma unroll
        for (int g = 0; g < 4; ++g) { const int ai = g >> 1;
            EPI_FENCE;
#pragma unroll
            for (int r = 0; r < 2; ++r) { const int m = (g & 1) * 2 + r; float ss = 0.f;
#pragma unroll
                for (int bj = 0; bj < 2; ++bj) { f32x4 b0, b1;
                    if (BASEF32) { b0 = pf[r][bj][0]; b1 = pf[r][bj][1]; }
                    else { const u32x4 w = pb[r][bj]; b0 = (f32x4){bflo(w.x), bfhi(w.x), bflo(w.y), bfhi(w.y)}; b1 = (f32x4){bflo(w.z), bfhi(w.z), bflo(w.w), bfhi(w.w)}; }
                    const f32x4 r0 = b0 + acc[ai][bj][m][0] * mul, r1 = b1 + acc[ai][bj][m][1] * mul; outs[r][bj] = pack8(r0, r1); ss += sumsq8(r0, r1); }
                sums[r] = ss; }
            if (g < 3) load_group(g + 1, row0, col0, pf, pb);
            EPI_FENCE;
#pragma unroll
            for (int r = 0; r < 2; ++r) { const int row = row0 + ai * HALF + ((g & 1) * 2 + r) * 16; const size_t off = (size_t)row * 1024 + col0;
#pragma unroll
                for (int bj = 0; bj < 2; ++bj) *(u32x4*)(out + off + bj * HALF) = outs[r][bj];
                float ss = sums[r]; ss += __shfl_xor(ss, 16); ss += __shfl_xor(ss, 32); if (fq == 0) atomicAdd(ssq + row, ss); }
        }
    }
};

struct EpiSwiGLU {
    EPI_FLAGS
    bf16_t* ACT; const float* ssq;
    __device__ __forceinline__ void operator()(EPI_ARGS) const {
        const int row0 = u.pm * BM + wr * 64 + fr, col0 = u.pn * HALF + wc * 32 + 8 * fq;
        float sq[2][4];
#pragma unroll
        for (int ai = 0; ai < 2; ++ai)
#pragma unroll
            for (int m = 0; m < 4; ++m) sq[ai][m] = ssq[row0 + ai * HALF + m * 16];
        EPI_FENCE;
#pragma unroll
        for (int ai = 0; ai < 2; ++ai)
#pragma unroll
            for (int m = 0; m < 4; ++m) { f32x4 r[2]; const float rs = rstd_of(sq[ai][m]);
#pragma unroll
                for (int n = 0; n < 2; ++n) { const f32x4 g = acc[ai][0][m][n] * rs, up = acc[ai][1][m][n] * rs;
#pragma unroll
                    for (int e = 0; e < 4; ++e) r[n][e] = g[e] * fast_sigmoid(g[e]) * up[e]; }
                if (NT_ACT) __builtin_nontemporal_store(pack8(r[0], r[1]), (u32x4*)(ACT + (size_t)(row0 + ai * HALF + m * 16) * 2816 + col0)); else *(u32x4*)(ACT + (size_t)(row0 + ai * HALF + m * 16) * 2816 + col0) = pack8(r[0], r[1]); }
    }
};

struct EpiPle {
    EPI_FLAGS
    const bf16_t* base; const bf16_t* PP; const float* ssq_in; bf16_t* outb; float* ssq_out; float mul;
    __device__ __forceinline__ void load_group(int g, int row0, int col0, u32x4 (&hb)[2][2], u32x4 (&pb)[2][2]) const {
#pragma unroll
        for (int r = 0; r < 2; ++r)
#pragma unroll
            for (int bj = 0; bj < 2; ++bj) { const size_t o = (size_t)(row0 + (g >> 1) * HALF + ((g & 1) * 2 + r) * 16) * 1024 + col0 + bj * HALF; hb[r][bj] = *(const u32x4*)(base + o); pb[r][bj] = *(const u32x4*)(PP + o); }
    }
    __device__ __forceinline__ void operator()(EPI_ARGS) const {
        const int row0 = u.pm * BM + wr * 64 + fr, col0 = u.pn * BM + wc * 32 + 8 * fq;
        float sq[2][4]; u32x4 hb[2][2], pb[2][2], outs[2][2]; float sums[2];
#pragma unroll
        for (int ai = 0; ai < 2; ++ai)
#pragma unroll
            for (int m = 0; m < 4; ++m) sq[ai][m] = ssq_in[row0 + ai * HALF + m * 16];
        load_group(0, row0, col0, hb, pb);
#pragma unroll
        for (int g = 0; g < 4; ++g) { const int ai = g >> 1;
            EPI_FENCE;
#pragma unroll
            for (int r = 0; r < 2; ++r) { const int m = (g & 1) * 2 + r; const float rs = rstd_of(sq[ai][m]); float ss = 0.f;
#pragma unroll
                for (int bj = 0; bj < 2; ++bj) { const u32x4 hw = hb[r][bj], pp = pb[r][bj];
                    const f32x4 h0 = {bflo(hw.x), bfhi(hw.x), bflo(hw.y), bfhi(hw.y)}, h1 = {bflo(hw.z), bfhi(hw.z), bflo(hw.w), bfhi(hw.w)};
                    const f32x4 a0 = acc[ai][bj][m][0] * rs, a1 = acc[ai][bj][m][1] * rs;
                    f32x4 p0 = {bflo(pp.x), bfhi(pp.x), bflo(pp.y), bfhi(pp.y)}, p1 = {bflo(pp.z), bfhi(pp.z), bflo(pp.w), bfhi(pp.w)}, g0, g1;
#pragma unroll
                    for (int e = 0; e < 4; ++e) { g0[e] = fast_sigmoid(a0[e]); g1[e] = fast_sigmoid(a1[e]); }
                    const f32x4 r0 = h0 + g0 * p0 * mul, r1 = h1 + g1 * p1 * mul;
                    outs[r][bj] = pack8(r0, r1); ss += sumsq8(r0, r1); }
                sums[r] = ss; }
            if (g < 3) load_group(g + 1, row0, col0, hb, pb);
            EPI_FENCE;
#pragma unroll
            for (int r = 0; r < 2; ++r) { const int row = row0 + ai * HALF + ((g & 1) * 2 + r) * 16; const size_t off = (size_t)row * 1024 + col0;
#pragma unroll
                for (int bj = 0; bj < 2; ++bj) *(u32x4*)(outb + off + bj * HALF) = outs[r][bj];
                float ss = sums[r]; ss += __shfl_xor(ss, 16); ss += __shfl_xor(ss, 32); if (fq == 0) atomicAdd(ssq_out + row, ss); }
        }
    }
};

template <class Epi, class Sched, bool ALIGN_EPI = false, bool SP2 = false>
__device__ __forceinline__ void gemm_phase(PG8_LAS unsigned char* lds, const Gemm g, const Sched& S, const Epi& E) {
    int tid_ = threadIdx.x; asm volatile("" : "+v"(tid_));
    const int tid = tid_, wid = __builtin_amdgcn_readfirstlane(tid >> 6), lane = tid & 63, wr = wid >> 2, wc = wid & 3, fr = lane & 15, fq = lane >> 4;
    const int K = g.K, nt = K / BK;
    unsigned voffA[2], voffB[2];
#pragma unroll
    for (int i = 0; i < 2; ++i) { int R, C; stage_rc(tid * 16 + i * 8192, R, C); const int Rb = Epi::PERM ? ((R & ~31) + perm32(R & 31)) : R;
        voffA[i] = (unsigned)(R * K + C) * 2u; voffB[i] = (unsigned)(Rb * K + C) * 2u; }
    const size_t kstep = (size_t)(BK * 2);
    const size_t hstep = (size_t)HALF * K * 2;
    const size_t tstep = 2 * hstep;
    const unsigned ldsw = (unsigned)wid * 1024u;
    const int aoff = lds_byte(wr * 64 + fr, fq * 8), boff = lds_byte(wc * 32 + fr, fq * 8);
#define PG8_SA(b, h) (((b) * 2 + (h)) * HTB)
#define PG8_SB(b, h) ((4 + (b) * 2 + (h)) * HTB)
#define PG8_STAGE(bufoff, gbase, voff) do { _Pragma("unroll") for (int _i = 0; _i < 2; ++_i) \
        __builtin_amdgcn_global_load_lds((const unsigned*)((const char*)(gbase) + (voff)[_i]), (PG8_LAS unsigned*)(lds + (bufoff) + ldsw + _i * 8192), 16, 0, 0); } while (0)
#define PG8_LDA(dst, b, h) do { _Pragma("unroll") for (int m = 0; m < 4; ++m) _Pragma("unroll") for (int k = 0; k < 2; ++k) dst[m][k] = *(const PG8_LAS bf16x8*)(lds + PG8_SA(b, h) + aoff + m * 2048 + k * 1024); } while (0)
#define PG8_LDB(dst, b, h) do { _Pragma("unroll") for (int n = 0; n < 2; ++n) _Pragma("unroll") for (int k = 0; k < 2; ++k) dst[n][k] = *(const PG8_LAS bf16x8*)(lds + PG8_SB(b, h) + boff + n * 2048 + k * 1024); } while (0)
#define PG8_MMA(ai, bj, At, Bt) do { __builtin_amdgcn_s_setprio(1); _Pragma("unroll") for (int m = 0; m < 4; ++m) _Pragma("unroll") for (int n = 0; n < 2; ++n) _Pragma("unroll") for (int k = 0; k < 2; ++k) \
        acc[ai][bj][m][n] = __builtin_amdgcn_mfma_f32_16x16x32_bf16(Bt[n][k], At[m][k], acc[ai][bj][m][n], 0, 0, 0); __builtin_amdgcn_s_setprio(0); } while (0)
#define PG8_WAIT_V(n) asm volatile("s_waitcnt vmcnt(" #n ")" ::: "memory")
#define PG8_WAIT_L(n) asm volatile("s_waitcnt lgkmcnt(" #n ")" ::: "memory")
#define PG8_BAR __builtin_amdgcn_s_barrier()
#define PG8_SCHED __builtin_amdgcn_sched_barrier(0)
    Unit cur, nxt; int ui = 0;
    if (!S.next(0, cur)) return;
    f32x4 acc[2][2][4][2];
#pragma unroll
    for (int a = 0; a < 2; ++a)
#pragma unroll
        for (int b = 0; b < 2; ++b)
#pragma unroll
            for (int m = 0; m < 4; ++m)
#pragma unroll
                for (int n = 0; n < 2; ++n) acc[a][b][m][n] = (f32x4){0.f, 0.f, 0.f, 0.f};
    bf16x8 At[4][2], B0[2][2], B1[2][2];
    const char* cA = (const char*)g.A + (size_t)cur.pm * tstep; const char* cB = (const char*)g.Bt + (size_t)cur.pn * tstep;
    S.a_ready(cur);
    if constexpr (SP2) {
        PG8_STAGE(PG8_SB(0, 0), cB, voffB); PG8_STAGE(PG8_SB(0, 1), cB + hstep, voffB); PG8_STAGE(PG8_SA(0, 0), cA, voffA); PG8_STAGE(PG8_SA(0, 1), cA + hstep, voffA);
        if (wr == 1) PG8_BAR;
        PG8_WAIT_V(2); PG8_BAR;
        PG8_STAGE(PG8_SB(1, 0), cB + kstep, voffB); PG8_STAGE(PG8_SA(1, 0), cA + kstep, voffA); PG8_STAGE(PG8_SB(1, 1), cB + hstep + kstep, voffB);
        PG8_WAIT_V(6); PG8_BAR;
    } else {
        PG8_STAGE(PG8_SB(0, 0), cB, voffB); PG8_STAGE(PG8_SA(0, 0), cA, voffA); PG8_STAGE(PG8_SB(0, 1), cB + hstep, voffB); PG8_STAGE(PG8_SA(0, 1), cA + hstep, voffA);
        if (wr == 1) PG8_BAR;
        PG8_WAIT_V(4); PG8_BAR;
        PG8_STAGE(PG8_SB(1, 0), cB + kstep, voffB); PG8_STAGE(PG8_SA(1, 0), cA + kstep, voffA); PG8_STAGE(PG8_SB(1, 1), cB + hstep + kstep, voffB);
        PG8_WAIT_V(6); PG8_BAR;
    }
    for (;;) {
        const bool has_next = S.next(ui + 1, nxt);
        const char* nA = has_next ? (const char*)g.A + (size_t)nxt.pm * tstep : cA; const char* nB = has_next ? (const char*)g.Bt + (size_t)nxt.pn * tstep : cB;
        for (int t = 0; t < nt; t += 2) {
            const bool last = (t == nt - 2);
            const char* a1 = cA + (size_t)(t + 1) * kstep;
            const char* a2 = last ? nA : cA + (size_t)(t + 2) * kstep; const char* b2 = last ? nB : cB + (size_t)(t + 2) * kstep;
            const char* a3 = a2 + kstep; const char* b3 = b2 + kstep;
            if (last && has_next) S.a_ready(nxt);
            if constexpr (SP2) {
            PG8_LDB(B0, 0, 0); PG8_LDB(B1, 0, 1); PG8_SCHED; PG8_LDA(At, 0, 0); PG8_STAGE(PG8_SA(1, 1), a1 + hstep, voffA);
            PG8_WAIT_V(8); PG8_WAIT_L(0); PG8_BAR; PG8_MMA(0, 0, At, B0); PG8_MMA(0, 1, At, B1); PG8_BAR; PG8_SCHED;
            PG8_LDA(At, 0, 1); PG8_STAGE(PG8_SB(0, 0), b2, voffB); PG8_STAGE(PG8_SB(0, 1), b2 + hstep, voffB); PG8_STAGE(PG8_SA(0, 0), a2, voffA);
            PG8_WAIT_V(8); PG8_WAIT_L(0); PG8_BAR; PG8_MMA(1, 0, At, B0); PG8_MMA(1, 1, At, B1); PG8_BAR; PG8_SCHED;
            PG8_LDB(B0, 1, 0); PG8_LDB(B1, 1, 1); PG8_SCHED; PG8_LDA(At, 1, 0); PG8_STAGE(PG8_SA(0, 1), a2 + hstep, voffA);
            PG8_WAIT_V(8); PG8_WAIT_L(0); PG8_BAR; PG8_MMA(0, 0, At, B0); PG8_MMA(0, 1, At, B1); PG8_BAR; PG8_SCHED;
            PG8_LDA(At, 1, 1); PG8_STAGE(PG8_SB(1, 0), b3, voffB); PG8_STAGE(PG8_SB(1, 1), b3 + hstep, voffB); PG8_STAGE(PG8_SA(1, 0), a3, voffA);
            PG8_WAIT_V(8); PG8_WAIT_L(0); PG8_BAR; PG8_MMA(1, 0, At, B0); PG8_MMA(1, 1, At, B1); PG8_BAR; PG8_SCHED;
            } else {
            PG8_LDB(B0, 0, 0); PG8_SCHED; PG8_LDA(At, 0, 0); PG8_STAGE(PG8_SA(1, 1), a1 + hstep, voffA);
            PG8_WAIT_L(8); PG8_BAR; PG8_WAIT_L(0); PG8_MMA(0, 0, At, B0); PG8_BAR; PG8_SCHED;
            PG8_LDB(B1, 0, 1); PG8_STAGE(PG8_SB(0, 0), b2, voffB);
            PG8_BAR; PG8_WAIT_L(0); PG8_MMA(0, 1, At, B1); PG8_BAR;
            PG8_LDA(At, 0, 1); PG8_STAGE(PG8_SA(0, 0), a2, voffA);
            PG8_BAR; PG8_WAIT_L(0); PG8_MMA(1, 0, At, B0); PG8_BAR; PG8_SCHED;
            PG8_STAGE(PG8_SB(0, 1), b2 + hstep, voffB);
            PG8_WAIT_V(6); PG8_BAR; PG8_MMA(1, 1, At, B1); PG8_BAR;
            PG8_LDB(B0, 1, 0); PG8_SCHED; PG8_LDA(At, 1, 0); PG8_STAGE(PG8_SA(0, 1), a2 + hstep, voffA);
            PG8_WAIT_L(8); PG8_BAR; PG8_WAIT_L(0); PG8_MMA(0, 0, At, B0); PG8_BAR; PG8_SCHED;
            PG8_LDB(B1, 1, 1); PG8_STAGE(PG8_SB(1, 0), b3, voffB);
            PG8_BAR; PG8_WAIT_L(0); PG8_MMA(0, 1, At, B1); PG8_BAR;
            PG8_LDA(At, 1, 1); PG8_STAGE(PG8_SA(1, 0), a3, voffA);
            PG8_BAR; PG8_WAIT_L(0); PG8_MMA(1, 0, At, B0); PG8_BAR; PG8_SCHED;
            PG8_STAGE(PG8_SB(1, 1), b3 + hstep, voffB);
            PG8_WAIT_V(6); PG8_BAR; PG8_MMA(1, 1, At, B1); PG8_BAR;
            }
        }
        if constexpr (ALIGN_EPI) { if (wr == 0) PG8_BAR; }
        if constexpr (!Epi::AFTER_DRAIN) { E(acc, cur, wr, wc, fr, fq); S.done(cur); }
        if (!has_next) break;
#pragma unroll
        for (int a = 0; a < 2; ++a)
#pragma unroll
            for (int b = 0; b < 2; ++b)
#pragma unroll
                for (int m = 0; m < 4; ++m)
#pragma unroll
                    for (int n = 0; n < 2; ++n) acc[a][b][m][n] = (f32x4){0.f, 0.f, 0.f, 0.f};
        cur = nxt; cA = nA; cB = nB; ++ui;
        if constexpr (ALIGN_EPI) { if (wr == 1) PG8_BAR; }
    }
    PG8_WAIT_V(0);
    if constexpr (!ALIGN_EPI) { if (wr == 0) PG8_BAR; }
    PG8_BAR;
    if constexpr (Epi::AFTER_DRAIN) { E.fused(acc, cur, wr, wc, fr, fq, lds, wid, lane); S.done(cur); }
#undef PG8_SA
#undef PG8_SB
#undef PG8_STAGE
#undef PG8_LDA
#undef PG8_LDB
#undef PG8_MMA
#undef PG8_WAIT_V
#undef PG8_WAIT_L
#undef PG8_BAR
#undef PG8_SCHED
}
}

using pg8::bf16_t; using pg8::bf16x8; using pg8::f32x4; using pg8::u32x4; using pg8::u32x2; using pg8::cvtpk;
typedef float f32x16 __attribute__((ext_vector_type(16)));
#define LAS __attribute__((address_space(3)))
#define DI __device__ __forceinline__
#define MFMA32(a, b, c) __builtin_amdgcn_mfma_f32_32x32x16_bf16((a), (b), (c), 0, 0, 0)
constexpr float LOG2E = 1.4426950408889634f;
constexpr int M = 16384, S = 8192, D = 1024, DFF = 2816, NWAVES = 8, NTHREADS = 512;
constexpr float EPS = 1e-6f;
constexpr size_t MiB = 1u << 20;
constexpr size_t WS_KSTAT = 0, WS_TOT = 4096, WS_BAR = 16384, WS_SSQ = 65536, WS_ZERO_BYTES = 65536;
constexpr size_t WS_ROPEC = 1 * MiB, WS_ROPES = 3 * MiB;
constexpr size_t WS_F = 5 * MiB;
constexpr size_t WS_WIN0 = 6 * MiB, WS_WOUT0 = 12 * MiB, WS_WIN1 = 14 * MiB, WS_WOUT1 = 17 * MiB, WS_WGU = 19 * MiB, WS_WDN = 41 * MiB, WS_WPP = 52 * MiB, WS_WPG = 53 * MiB;
constexpr size_t WGU_STRIDE = (size_t)2 * DFF * D, WDN_STRIDE = (size_t)D * DFF, WPP_STRIDE = (size_t)D * 256, WPG_STRIDE = (size_t)D * D;
constexpr size_t WS_PBF = 58 * MiB, WS_HN = 74 * MiB, WS_O = 106 * MiB, WS_QK = 138 * MiB, WS_VT = 202 * MiB, WS_ACT = 138 * MiB, WS_VT1 = 178 * MiB, WS_HB2 = 186 * MiB, WS_ACT1 = 106 * MiB, WS_PP1 = 218 * MiB, WS_END = 250 * MiB;
constexpr int RING_BYTES = 131072, LDS_BYTES = 135168;

struct Params {
    const float *x, *p; const int* pos;
    const float *norm_mix, *norm_ffn, *norm_ple, *norm_final, *ev_w_in, *ev_b_f, *ev_w_out, *od_w_in, *od_sinks, *od_w_out, *ffn_w_gate, *ffn_w_up, *ffn_w_down, *ple_w_proj, *ple_w_gate;
    float* out; unsigned char* ws; int ph_lo, ph_hi;
};

DI float wave_sum(float v) {
#pragma unroll
    for (int o = 1; o < 64; o <<= 1) v += __shfl_xor(v, o);
    return v;
}

#define XB_TMO      128
#define XB_XCNT(j)  (256  + 64 * (j))
#define XB_XSUB(j)  (1280 + 64 * (j))
#define XB_XGEN(j)  (2304 + 64 * (j))
#define XB_TOP      3328
#define XB_TOPGEN   3392
#define XCD_BAR_WORDS 3456
#define XB_SPIN_CAP (1u << 24)

__device__ __forceinline__ unsigned xb_ld(unsigned* p)              { return __hip_atomic_load(p, __ATOMIC_RELAXED, __HIP_MEMORY_SCOPE_AGENT); }
__device__ __forceinline__ unsigned xb_add(unsigned* p, unsigned v) { return __hip_atomic_fetch_add(p, v, __ATOMIC_RELAXED, __HIP_MEMORY_SCOPE_AGENT); }
__device__ __forceinline__ unsigned xb_xcc_id() { return (unsigned)__builtin_amdgcn_s_getreg((3 << 11) | 20) & 0xFu; }
#define XB_SPIN(cond, bar) do { unsigned _sp = 0; while (cond) { __builtin_amdgcn_s_sleep(1); \
    if ((++_sp & 255u) == 0u) { if (xb_ld(&(bar)[XB_TMO])) break; if (_sp > XB_SPIN_CAP) { atomicAdd(&(bar)[XB_TMO], 1u); break; } } } } while (0)

struct XcdBarrier {
    unsigned* bar; unsigned x;
    volatile LAS unsigned* st;
};

__device__ __forceinline__ XcdBarrier xcd_barrier_post(unsigned* bar, volatile LAS unsigned* st) {
    XcdBarrier b; b.bar = bar; b.x = xb_xcc_id(); b.st = st;
    if (threadIdx.x == 0) (void)xb_add(&bar[XB_XCNT(b.x)], 1u);
    return b;
}
__device__ __forceinline__ void xcd_barrier_complete(unsigned* bar, unsigned x, unsigned& nloc, unsigned& nx) {
    const unsigned G = gridDim.x * gridDim.y * gridDim.z;
    unsigned sum, cnt, mine, sp = 0u;
    for (;;) {
        sum = 0u; cnt = 0u; mine = 0u;
#pragma unroll
        for (unsigned j = 0; j < 16; ++j) { const unsigned c = xb_ld(&bar[XB_XCNT(j)]); sum += c; cnt += (c > 0u) ? 1u : 0u; mine = (j == x) ? c : mine; }
        if (sum == G) break;
        __builtin_amdgcn_s_sleep(1);
        if ((++sp & 255u) == 0u) { if (xb_ld(&bar[XB_TMO])) break; if (sp > XB_SPIN_CAP) { atomicAdd(&bar[XB_TMO], 1u); break; } }
    }
    nloc = mine > 0u ? mine : 1u; nx = cnt > 0u ? cnt : 1u;
}

__device__ __forceinline__ void xcd_barrier(const XcdBarrier& b) {
    asm volatile("s_waitcnt vmcnt(0)" ::: "memory");
    __syncthreads();
    if (threadIdx.x == 0) {
        unsigned* bar = b.bar;
        __builtin_amdgcn_s_waitcnt(0);
        unsigned nloc = b.st[0], nx = b.st[1];
        if (nloc == 0u) { xcd_barrier_complete(bar, b.x, nloc, nx); b.st[0] = nloc; b.st[1] = nx; }
        const unsigned old = xb_add(&bar[XB_XSUB(b.x)], 1u);
        const unsigned gen = old / nloc;
        if (old + 1u == (gen + 1u) * nloc) {
            __builtin_amdgcn_fence(__ATOMIC_RELEASE, "agent");
            asm volatile("s_waitcnt vmcnt(0)" ::: "memory");
            const unsigned og = xb_add(&bar[XB_TOP], 1u);
            const unsigned tg = og / nx;
            if (og + 1u == (tg + 1u) * nx) xb_add(&bar[XB_TOPGEN], 1u);
            else XB_SPIN(xb_ld(&bar[XB_TOPGEN]) == tg, bar);
            __builtin_amdgcn_fence(__ATOMIC_ACQUIRE, "agent");
            xb_add(&bar[XB_XGEN(b.x)], 1u);
            asm volatile("s_waitcnt vmcnt(0)" ::: "memory");
        } else {
            XB_SPIN(xb_ld(&bar[XB_XGEN(b.x)]) == gen, bar);
            __builtin_amdgcn_fence(__ATOMIC_ACQUIRE, "agent");
            asm volatile("s_waitcnt vmcnt(0)" ::: "memory");
        }
    }
    __syncthreads();
}

DI int dest_row(int mode, int n, int row_off) {
    if (mode == 1) return (n >> 7) * 256 + (n & 127) + row_off;
    if (mode == 2 && n < 1280) { const int j = n & 63, jj = j & 31, pos = 8 * (jj >> 2) + (jj & 3) + ((j >> 5) << 2); return (n & ~63) + pos; }
    return n + row_off;
}
struct TJob { const float* W; bf16_t* WT; const float* gk; int ldn, K, ncols, mode, row_off, item; };
DI void transpose_issue(const TJob& j, float (&t)[32], int lane) {
    const int nblk = j.ncols / 32, kb = j.item / nblk, nb = j.item % nblk, k0 = 64 * kb, n0 = 32 * nb;
    const float* Wp = j.W + (size_t)(k0 + (lane >> 5)) * j.ldn + n0 + (lane & 31);
#pragma unroll
    for (int i = 0; i < 32; ++i) t[i] = __builtin_nontemporal_load(Wp + (size_t)(2 * i) * j.ldn);
}
DI void transpose_finish(const TJob& j, const float (&t)[32], LAS float* scr, int lane) {
    const int nblk = j.ncols / 32, kb = j.item / nblk, nb = j.item % nblk, k0 = 64 * kb, n0 = 32 * nb;
    const int c = lane & 7;
    f32x4 g0 = {1.f, 1.f, 1.f, 1.f}, g1 = g0;
    if (j.gk) { g0 = *(const f32x4*)(j.gk + k0 + 8 * c); g1 = *(const f32x4*)(j.gk + k0 + 8 * c + 4); }
#pragma unroll
    for (int i = 0; i < 32; ++i) scr[(2 * i + (lane >> 5)) * 33 + (lane & 31)] = t[i];
    asm volatile("s_waitcnt lgkmcnt(0)" ::: "memory");
#pragma unroll
    for (int q = 0; q < 4; ++q) { const int n = (lane >> 3) + 8 * q; const LAS float* s = scr + (8 * c) * 33 + n;
        u32x4 o; o.x = cvtpk(s[0 * 33] * g0[0], s[1 * 33] * g0[1]); o.y = cvtpk(s[2 * 33] * g0[2], s[3 * 33] * g0[3]); o.z = cvtpk(s[4 * 33] * g1[0], s[5 * 33] * g1[1]); o.w = cvtpk(s[6 * 33] * g1[2], s[7 * 33] * g1[3]);
        *(u32x4*)(j.WT + (size_t)dest_row(j.mode, n0 + n, j.row_off) * j.K + k0 + 8 * c) = o; }
    asm volatile("s_waitcnt lgkmcnt(0)" ::: "memory");
}

DI void rope_entry(int pos, int j, float& c, float& s) {
    const float inv = powf(10000.0f, -(float)j / 32.0f);
    const float angf = (float)pos * inv;
    const double a = (double)angf, kq = rint(a * 0.63661977236758134308);
    double r = fma(-kq, 1.57079632679489655800e+00, a); r = fma(-kq, 6.12323399573676603587e-17, r);
    const int q = ((int)kq) & 3; const double r2 = r * r;
    const double sp = r * (1.0 + r2 * (-1.0 / 6 + r2 * (1.0 / 120 + r2 * (-1.0 / 5040 + r2 * (1.0 / 362880 + r2 * (-1.0 / 39916800 + r2 * (1.0 / 6227020800.0)))))));
    const double cp = 1.0 + r2 * (-0.5 + r2 * (1.0 / 24 + r2 * (-1.0 / 720 + r2 * (1.0 / 40320 + r2 * (-1.0 / 3628800 + r2 * (1.0 / 479001600 + r2 * (-1.0 / 87178291200.0)))))));
    const double cc = (q == 0) ? cp : (q == 1) ? -sp : (q == 2) ? -cp : sp, ss = (q == 0) ? sp : (q == 1) ? cp : (q == 2) ? -sp : -cp;
    c = (float)cc; s = (float)ss;
}

template <bool GATES, bool OUTF32>
DI void norm_phase(const float* src, const float* __restrict__ g, void* dst, LAS unsigned char* lds, const float* __restrict__ w_in0, const float* __restrict__ b_f, float* F, float* tot, int tid, int lane, int wave) {
    LAS float* Wg = (LAS float*)lds; LAS float* lfb = (LAS float*)(lds + 32768);
    if (GATES) { for (int idx = tid; idx < 8192; idx += NTHREADS) Wg[(idx & 7) * 1024 + (idx >> 3)] = w_in0[(size_t)(idx >> 3) * 3080 + 3072 + (idx & 7)]; __syncthreads(); }
    f32x4 gv[4];
#pragma unroll
    for (int j = 0; j < 4; ++j) gv[j] = *(const f32x4*)(g + 4 * lane + 256 * j);
    for (int chunk = blockIdx.x; chunk < M / 64; chunk += gridDim.x) {
        constexpr int RB = OUTF32 ? 2 : 4;
#pragma unroll 1
        for (int rb = 0; rb < 8; rb += RB) {
        f32x4 v[RB][4];
#pragma unroll
        for (int rr = 0; rr < RB; ++rr) { const f32x4* xr = (const f32x4*)(src + (size_t)(chunk * 64 + wave * 8 + rb + rr) * D) + lane;
#pragma unroll
            for (int j = 0; j < 4; ++j) v[rr][j] = GATES ? __builtin_nontemporal_load(xr + 64 * j) : xr[64 * j]; }
#pragma unroll
        for (int rr = 0; rr < RB; ++rr) {
            const int row = chunk * 64 + wave * 8 + rb + rr;
            float ss = 0.f;
#pragma unroll
            for (int j = 0; j < 4; ++j) ss += (v[rr][j][0] * v[rr][j][0] + v[rr][j][1] * v[rr][j][1]) + (v[rr][j][2] * v[rr][j][2] + v[rr][j][3] * v[rr][j][3]);
            const float rstd = 1.0f / sqrtf(wave_sum(ss) * (1.0f / D) + EPS);
#pragma unroll
            for (int j = 0; j < 4; ++j) v[rr][j] = v[rr][j] * rstd * gv[j];
            if (OUTF32) { f32x4* o = (f32x4*)((float*)dst + (size_t)row * D) + lane;
#pragma unroll
                for (int j = 0; j < 4; ++j) o[64 * j] = v[rr][j];
            } else { u32x2* o = (u32x2*)((bf16_t*)dst + (size_t)row * D) + lane;
#pragma unroll
                for (int j = 0; j < 4; ++j) { u32x2 w; w.x = cvtpk(v[rr][j][0], v[rr][j][1]); w.y = cvtpk(v[rr][j][2], v[rr][j][3]); o[64 * j] = w; } }
            if (GATES) {
                float ga[8];
#pragma unroll
                for (int g8 = 0; g8 < 8; ++g8) { float a = 0.f;
#pragma unroll
                    for (int j = 0; j < 4; ++j) { const f32x4 w = *(const LAS f32x4*)(Wg + g8 * 1024 + 256 * j + 4 * lane); a += (w[0] * v[rr][j][0] + w[1] * v[rr][j][1]) + (w[2] * v[rr][j][2] + w[3] * v[rr][j][3]); }
                    ga[g8] = a; }
                const bool b0 = lane & 1, b1 = lane & 2, b2 = lane & 4;
                float k4[4], k2[2], k1;
#pragma unroll
                for (int e = 0; e < 4; ++e) { const float keep = b0 ? ga[4 + e] : ga[e], send = b0 ? ga[e] : ga[4 + e]; k4[e] = keep + __shfl_xor(send, 1); }
#pragma unroll
                for (int e = 0; e < 2; ++e) { const float keep = b1 ? k4[2 + e] : k4[e], send = b1 ? k4[e] : k4[2 + e]; k2[e] = keep + __shfl_xor(send, 2); }
                { const float keep = b2 ? k2[1] : k2[0], send = b2 ? k2[0] : k2[1]; k1 = keep + __shfl_xor(send, 4); }
                k1 += __shfl_xor(k1, 8); k1 += __shfl_xor(k1, 16); k1 += __shfl_xor(k1, 32);
                if (lane < 8) { const int gate = 4 * (lane & 1) + (lane & 2) + ((lane >> 2) & 1); const float x0 = k1 + b_f[gate];
                    lfb[(wave * 8 + rb + rr) * 8 + gate] = fminf(x0, 0.f) - __builtin_amdgcn_logf(1.0f + __builtin_amdgcn_exp2f(-fabsf(x0) * LOG2E)) * 0.6931471805599453f; }
            }
        }
        }
        if (GATES) {
            __syncthreads();
            if (tid < 8) { const int b = chunk >> 7, blk = chunk & 127; float run = 0.f; float* Fp = F + (size_t)(b * 8 + tid) * S + blk * 64;
                for (int r = 0; r < 64; ++r) { run += lfb[r * 8 + tid]; Fp[r] = run; }
                tot[(b * 8 + tid) * 128 + blk] = run; }
            __syncthreads();
        }
    }
}

#ifndef ATT_MINBLK
#define ATT_MINBLK 0
#endif
constexpr int ATT_NS = 13, ATT_KPITCH = 144, ATT_VPITCH = 80, ATT_VOFF = 32 * ATT_KPITCH, ATT_SLOT = ATT_VOFF + 64 * ATT_VPITCH, ATT_FLAGS = ATT_NS * ATT_SLOT;
template <int MODE  >
DI int attn_wg(const bf16_t* __restrict__ QK, const bf16_t* __restrict__ VT, bf16_t* __restrict__ O, const float* __restrict__ F, const unsigned* __restrict__ kstat, const float* __restrict__ sinks,
               int b, int h, int qg, int res_lo, bool first, bool more, bf16x8 (&qfN)[4], float& FqN, LAS unsigned char* lds, int tid, int lane, int wave) {
    constexpr int PITCH = (MODE == 2) ? 1280 : 2048;
    const int n = lane & 31, hh = lane >> 5, qt = qg * 8 + wave, q0 = qt * 32;
    const int qcol = (MODE == 1) ? 1024 + h * 64 : h * 64;
    const int kcol = (MODE == 0) ? 512 + h * 64 : (MODE == 1) ? 1536 + h * 64 : 1024 + (h >> 2) * 64;
    const int vhead = (MODE == 0) ? b * 16 + h : (MODE == 1) ? b * 16 + 8 + h : b * 4 + (h >> 2);
    const int ocol = (MODE == 1) ? 512 + h * 64 : h * 64;
    const size_t rowb = (size_t)b * S;
    const int ksw = (n & 0x13) | ((n & 4) << 1) | ((n & 8) >> 1);
    const bool isK = tid < 256; const int tv = tid - 256;
    const bf16_t* gsrc = isK ? QK + (rowb + (tid >> 3)) * PITCH + kcol + 8 * (tid & 7) : VT + ((size_t)vhead * 64 + (tv >> 2)) * S + 8 * (tv & 3);
    const size_t gstep = isK ? (size_t)32 * PITCH : (size_t)32;
    const int loff = isK ? (tid >> 3) * ATT_KPITCH + (tid & 7) * 16 : ATT_VOFF + (tv >> 2) * ATT_VPITCH + (tv & 3) * 16;
    volatile LAS int* flags = (volatile LAS int*)(lds + ATT_FLAGS);
    __syncthreads();
    if (tid < 8) flags[tid] = 0x7fffffff;
    { bf16x8 t[8];
#pragma unroll
      for (int j = 0; j < 8; ++j) { const int blk = qg * 8 + j; if (blk < res_lo || blk > res_lo + 12) t[j] = *(const bf16x8*)(gsrc + (size_t)blk * gstep); }
#pragma unroll
      for (int j = 0; j < 8; ++j) { const int blk = qg * 8 + j; if (blk < res_lo || blk > res_lo + 12) *(LAS bf16x8*)(lds + (blk % ATT_NS) * ATT_SLOT + loff) = t[j]; } }
    bf16x8 qf[4];
    const float* Fp = (MODE == 0) ? F + (size_t)(b * 8 + h) * S : F;
    { const bf16_t* Qp = QK + (rowb + q0 + n) * PITCH + qcol + 8 * hh;
      if (first) {
#pragma unroll
          for (int c = 0; c < 4; ++c) qfN[c] = *(const bf16x8*)(Qp + 16 * c);
          if (MODE == 0) FqN = Fp[q0 + n]; }
#pragma unroll
      for (int c = 0; c < 4; ++c) qf[c] = qfN[c];
    }
    float m_run = -1e30f, l_run = 0.f, carry = 0.f, cfac = 1.0f, Fq = 0.f, qkb = 0.f, sink2 = 0.f;
    if (MODE == 0) Fq = FqN;
    if (more) { const bf16_t* Qp = QK + (rowb + q0 - 256 + n) * PITCH + qcol + 8 * hh;
#pragma unroll
        for (int c = 0; c < 4; ++c) qfN[c] = *(const bf16x8*)(Qp + 16 * c);
        if (MODE == 0) FqN = Fp[q0 - 256 + n]; }
    if (MODE == 0) {
        float qs = 0.f;
#pragma unroll
        for (int c = 0; c < 4; ++c)
#pragma unroll
            for (int j = 0; j < 8; ++j) { const float v = __builtin_bit_cast(float, ((unsigned)(unsigned short)qf[c][j]) << 16); qs += v * v; }
        qs += __shfl_xor(qs, 32);
        const float kmax2 = __builtin_bit_cast(float, kstat[(b * 8 + h) * 2]) + __builtin_bit_cast(float, kstat[(b * 8 + h) * 2 + 1]);
        qkb = sqrtf(qs * kmax2) * 1.02f + 0.01f;
    }
    if (MODE == 2) { sink2 = sinks[h] * LOG2E; m_run = sink2; }
    f32x16 o0, o1;
#pragma unroll
    for (int r = 0; r < 16; ++r) { o0[r] = 0.f; o1[r] = 0.f; }
    const int kb_lo = (MODE == 2) ? (qt >= 4 ? qt - 4 : 0) : 0;
    constexpr int RATE = (MODE == 2) ? 2 : 1;
    const int nb_lo = (MODE == 2) ? (qg * 8 >= 8 ? qg * 8 - 8 : 0) : 0;
    bool done = false, posted = false;
    int lo_w = qg * 8;
    bf16x8 tn_a[RATE], tn_b[RATE]; f32x4 fkN[4]; float FrN = 0.f;
#define ATT_FLOAD(kb_) do { if (MODE == 0) { const int k0_ = (kb_) * 32; fkN[0] = *(const f32x4*)(Fp + k0_ + 8 * hh); fkN[1] = *(const f32x4*)(Fp + k0_ + 8 * hh + 4); fkN[2] = *(const f32x4*)(Fp + k0_ + 16 + 8 * hh); \
        fkN[3] = *(const f32x4*)(Fp + k0_ + 16 + 8 * hh + 4); FrN = Fp[k0_ > 0 ? k0_ - 1 : 0]; } } while (0)
#pragma unroll
    for (int r = 0; r < RATE; ++r) { const int lb_ = qg * 8 - 1 - r; tn_a[r] = *(const bf16x8*)(gsrc + (size_t)(lb_ >= nb_lo ? lb_ : nb_lo) * gstep); }
    ATT_FLOAD(qt);
    __syncthreads();
#define ATT_STEP(I, TO, TN) { \
        const int nb = qg * 8 - 1 - RATE * (I); \
_Pragma("unroll") \
        for (int r = 0; r < RATE; ++r) { const int lb_ = nb - RATE - r; TN[r] = *(const bf16x8*)(gsrc + (size_t)(lb_ >= nb_lo ? lb_ : nb_lo) * gstep); } \
        const int kb = qt - (I); \
        if (!done && kb < kb_lo) done = true; \
        if (!done) { \
            const LAS unsigned char* sl = lds + (kb % ATT_NS) * ATT_SLOT; \
            bf16x8 kf[4]; f32x4 fk[4]; \
_Pragma("unroll") \
            for (int c = 0; c < 4; ++c) { kf[c] = *(const LAS bf16x8*)(sl + ksw * ATT_KPITCH + c * 32 + hh * 16); fk[c] = fkN[c]; } \
            const LAS unsigned char* vp = sl + ATT_VOFF + n * ATT_VPITCH + hh * 16; \
            const bf16x8 v00 = *(const LAS bf16x8*)(vp), v01 = *(const LAS bf16x8*)(vp + 32), v10 = *(const LAS bf16x8*)(vp + 32 * ATT_VPITCH), v11 = *(const LAS bf16x8*)(vp + 32 * ATT_VPITCH + 32); \
            const float Fr = FrN; \
            ATT_FLOAD(kb > kb_lo ? kb - 1 : kb_lo); \
            f32x16 s; \
_Pragma("unroll") \
            for (int r = 0; r < 16; ++r) s[r] = 0.f; \
_Pragma("unroll") \
            for (int c = 0; c < 4; ++c) s = MFMA32(kf[c], qf[c], s); \
            float p[16]; \
            if (MODE == 0 || MODE == 2) { \
                if (MODE == 0) { \
_Pragma("unroll") \
                    for (int r = 0; r < 16; ++r) p[r] = s[r] + (Fq - fk[r >> 2][r & 3]); \
                } else { \
_Pragma("unroll") \
                    for (int r = 0; r < 16; ++r) p[r] = s[r]; \
                } \
                if (kb == qt) { \
_Pragma("unroll") \
                    for (int r = 0; r < 16; ++r) { const int kl = 16 * (r >> 3) + 8 * hh + (r & 7); if (kl > n) p[r] = -1e30f; } \
                } \
                if (MODE == 2 && kb == qt - 4) { \
_Pragma("unroll") \
                    for (int r = 0; r < 16; ++r) { const int kl = 16 * (r >> 3) + 8 * hh + (r & 7); if (kl <= n) p[r] = -1e30f; } \
                } \
                float mx = p[0]; \
_Pragma("unroll") \
                for (int r = 1; r < 16; ++r) mx = fmaxf(mx, p[r]); \
                mx = fmaxf(mx, __shfl_xor(mx, 32)); \
                const float mnew = fmaxf(m_run, mx), alpha = __builtin_amdgcn_exp2f(m_run - mnew); \
                float ps = 0.f; \
_Pragma("unroll") \
                for (int r = 0; r < 16; ++r) { p[r] = __builtin_amdgcn_exp2f(p[r] - mnew); ps += p[r]; } \
                l_run = l_run * alpha + ps; m_run = mnew; \
                if (!__all(alpha == 1.0f)) { _Pragma("unroll") for (int r = 0; r < 16; ++r) { o0[r] *= alpha; o1[r] *= alpha; } } \
            } else { \
                float om[16], ex[16], T[2]; \
_Pragma("unroll") \
                for (int r = 0; r < 16; ++r) { om[r] = __builtin_amdgcn_rcpf(1.0f + __builtin_amdgcn_exp2f(s[r])); p[r] = 1.0f - om[r]; } \
                if (kb == qt) { \
_Pragma("unroll") \
                    for (int r = 0; r < 16; ++r) { const int kl = 16 * (r >> 3) + 8 * hh + (r & 7); if (kl >= n) { om[r] = 1.0f; p[r] = 0.f; } } \
                } \
_Pragma("unroll") \
                for (int c = 0; c < 2; ++c) { float run = 1.0f; \
_Pragma("unroll") \
                    for (int j = 7; j >= 0; --j) { ex[8 * c + j] = run; run *= om[8 * c + j]; } \
                    T[c] = run; } \
                const float P0 = __shfl_xor(T[0], 32), P1 = __shfl_xor(T[1], 32); \
                const float off0 = cfac * (hh == 0 ? (P0 * T[1] * P1) : (P1 * T[1])), off1 = cfac * (hh == 0 ? P1 : 1.0f); \
_Pragma("unroll") \
                for (int r = 0; r < 16; ++r) p[r] = p[r] * ex[r] * (r < 8 ? off0 : off1); \
                const float tot = (T[0] * T[1]) * (P0 * P1); \
                cfac *= tot; carry += __builtin_amdgcn_logf(tot); \
            } \
            bf16x8 pf0, pf1; \
            { u32x4 w0, w1; w0.x = cvtpk(p[0], p[1]); w0.y = cvtpk(p[2], p[3]); w0.z = cvtpk(p[4], p[5]); w0.w = cvtpk(p[6], p[7]); \
              w1.x = cvtpk(p[8], p[9]); w1.y = cvtpk(p[10], p[11]); w1.z = cvtpk(p[12], p[13]); w1.w = cvtpk(p[14], p[15]); \
              pf0 = __builtin_bit_cast(bf16x8, w0); pf1 = __builtin_bit_cast(bf16x8, w1); } \
            o0 = MFMA32(v00, pf0, o0); o0 = MFMA32(v01, pf1, o0); o1 = MFMA32(v10, pf0, o1); o1 = MFMA32(v11, pf1, o1); \
            if (MODE == 0 && (I) >= ATT_MINBLK) { if (__all((qkb + (Fq - Fr) - m_run) < -152.0f)) done = true; } \
            if (MODE == 1 && (I) >= ATT_MINBLK) { if (__all(carry < -152.0f)) done = true; } \
            if (kb == kb_lo) done = true; \
        } \
        if (done && !posted) { posted = true; if (lane == 0) flags[wave] = (I); } \
_Pragma("unroll") \
        for (int r = 0; r < RATE; ++r) { if (nb - r >= nb_lo) { *(LAS bf16x8*)(lds + ((nb - r) % ATT_NS) * ATT_SLOT + loff) = TO[r]; lo_w = nb - r; }  } \
        __syncthreads(); \
        const int fl = flags[lane & 7]; \
        if (__all(fl <= (I))) break; \
    }
    for (int i2 = 0; ; i2 += 2) {
        ATT_STEP(i2, tn_a, tn_b)
        ATT_STEP(i2 + 1, tn_b, tn_a)
    }
#undef ATT_STEP
    float inv = 1.0f;
    if (MODE == 0 || MODE == 2) { float l = l_run + __shfl_xor(l_run, 32); if (MODE == 2) l += __builtin_amdgcn_exp2f(sink2 - m_run); inv = 1.0f / l; }
    bf16_t* Op = O + (rowb + q0 + n) * D + ocol + 4 * hh;
#pragma unroll
    for (int i = 0; i < 4; ++i) {
        u32x2 w; w.x = cvtpk(o0[4 * i] * inv, o0[4 * i + 1] * inv); w.y = cvtpk(o0[4 * i + 2] * inv, o0[4 * i + 3] * inv); *(u32x2*)(Op + 8 * i) = w;
        u32x2 y; y.x = cvtpk(o1[4 * i] * inv, o1[4 * i + 1] * inv); y.y = cvtpk(o1[4 * i + 2] * inv, o1[4 * i + 3] * inv); *(u32x2*)(Op + 32 + 8 * i) = y;
    }
    return lo_w;
}

#undef ATT_FLOAD
#define REP_P0 0
#define REP_GIN0 0
#define REP_ATT0 0
#define REP_GU 0
#define REP_SWA 0
#define REP_SYNC 0
#define ALIGN1 true
#define ALIGNM true
#define REP_T 0
#define REP_NG 0
#define REP_PR 0
#define REP_GOUT0 0
#define REP_DOWN0 0
#define REP_PG0 0
__global__ void __launch_bounds__(NTHREADS, 2) mk_fwd(Params P) {
    extern __shared__ __attribute__((aligned(16))) unsigned char lds_raw[];
    LAS unsigned char* lds = (LAS unsigned char*)lds_raw;
    cg::grid_group grid = cg::this_grid();
    const int G = gridDim.x, NGW = G * NWAVES, NGT = G * NTHREADS;
    if (threadIdx.x < 32) ((LAS unsigned*)(lds + RING_BYTES))[threadIdx.x] = 0u;
    __syncthreads();
    const XcdBarrier xbar = xcd_barrier_post((unsigned*)(P.ws + WS_BAR), (volatile LAS unsigned*)(lds + RING_BYTES));
    if (P.ph_hi < 0) grid.sync();
#define IDS int tid = threadIdx.x; asm volatile("" : "+v"(tid)); const int lane = tid & 63, wave = __builtin_amdgcn_readfirstlane(tid >> 6), gw = blockIdx.x * NWAVES + wave, gt = blockIdx.x * NTHREADS + tid; (void)gw; (void)gt; (void)lane;
    unsigned char* ws = P.ws;
    unsigned* kstat = (unsigned*)(ws + WS_KSTAT); float* tot = (float*)(ws + WS_TOT); float* ropeC = (float*)(ws + WS_ROPEC); float* ropeS = (float*)(ws + WS_ROPES); float* Fc = (float*)(ws + WS_F);
    bf16_t* Win0 = (bf16_t*)(ws + WS_WIN0); bf16_t* Wout0 = (bf16_t*)(ws + WS_WOUT0); bf16_t* Win1 = (bf16_t*)(ws + WS_WIN1); bf16_t* Wout1 = (bf16_t*)(ws + WS_WOUT1);
    bf16_t* Wgu = (bf16_t*)(ws + WS_WGU); bf16_t* Wdn = (bf16_t*)(ws + WS_WDN); bf16_t* Wpp = (bf16_t*)(ws + WS_WPP); bf16_t* Wpg = (bf16_t*)(ws + WS_WPG);
    bf16_t* pbf = (bf16_t*)(ws + WS_PBF); bf16_t* hn = (bf16_t*)(ws + WS_HN); bf16_t* Ob = (bf16_t*)(ws + WS_O); bf16_t* PP = Ob; bf16_t* QK = (bf16_t*)(ws + WS_QK); bf16_t* VT = (bf16_t*)(ws + WS_VT); bf16_t* ACT = (bf16_t*)(ws + WS_ACT);
    bf16_t* hb2 = (bf16_t*)(ws + WS_HB2); bf16_t* VT1 = (bf16_t*)(ws + WS_VT1); float* ssq = (float*)(ws + WS_SSQ); bf16_t* ACT1 = (bf16_t*)(ws + WS_ACT1); bf16_t* PP1 = (bf16_t*)(ws + WS_PP1);
    float* h = P.out;
    const int lo = P.ph_lo, hi = P.ph_hi;
#define IN(k) (lo <= (k) && (k) < hi)
#define SEAM(k) do { if (IN(k) && IN((k) + 1)) xcd_barrier(xbar); } while (0)
#define GEMM(EpiT, E, A_, B_, N_, K_) do { int k_ = (K_); asm volatile("" : "+s"(k_)); pg8::Gemm g_{A_, B_, M, N_, k_}; pg8::StaticOrder S_; S_.init(M, N_, G, (int)blockIdx.x); pg8::gemm_phase<EpiT, pg8::StaticOrder, ALIGNM, true>(lds, g_, S_, E); } while (0)
#define GEMM1(EpiT, E, A_, B_, N_, K_) do { int k_ = (K_); asm volatile("" : "+s"(k_)); pg8::Gemm g_{A_, B_, M, N_, k_}; pg8::StaticOrder S_; S_.init(M, N_, G, (int)blockIdx.x); pg8::gemm_phase<EpiT, pg8::StaticOrder, ALIGN1, true>(lds, g_, S_, E); } while (0)

#define GEMM_SUB(EpiT, E, A_, B_, N_, K_, c0_) do { const int c0v_ = (c0_); if ((int)blockIdx.x >= c0v_) { int k_ = (K_); asm volatile("" : "+s"(k_)); pg8::Gemm g_{A_, B_, M, N_, k_}; pg8::StaticOrder S_; S_.init(M, N_, G - c0v_, (int)blockIdx.x - c0v_); \
        pg8::gemm_phase<EpiT, pg8::StaticOrder, true, true>(lds, g_, S_, E); } } while (0)
    if (IN(0)) for (int rep_ = 0; rep_ <= REP_P0; ++rep_) { IDS
        if (rep_ > 0) xcd_barrier(xbar);
        if (blockIdx.x == 0 && tid < 32) kstat[tid] = 0u;
        for (int i = gt; i < 6 * M; i += NGT) ssq[i] = 0.f;
        LAS float* scr = (LAS float*)(lds + wave * 16384);
        constexpr int I_IN0 = 16 * 96, I_SQ = 16 * 32, I_IN1 = 16 * 48, I_FF = 16 * 88, I_DN = 44 * 32, I_PP = 4 * 32;
        constexpr int NITEMS = I_IN0 + I_SQ + I_IN1 + I_SQ + 4 * I_FF + 2 * I_DN + 2 * I_PP + 2 * I_SQ;
#define T_DECODE(it_, J) do { int r = (it_); \
            if (r < I_IN0) { J = TJob{P.ev_w_in, Win0, nullptr, 3080, D, 3072, 0, 0, r}; break; } r -= I_IN0; \
            if (r < I_SQ) { J = TJob{P.ev_w_out, Wout0, nullptr, D, D, D, 0, 0, r}; break; } r -= I_SQ; \
            if (r < I_IN1) { J = TJob{P.od_w_in, Win1, P.norm_mix + D, 1536, D, 1536, 2, 0, r}; break; } r -= I_IN1; \
            if (r < I_SQ) { J = TJob{P.od_w_out, Wout1, nullptr, D, D, D, 0, 0, r}; break; } r -= I_SQ; \
            if (r < 4 * I_FF) { const int which = r / I_FF, l = which >> 1, up = which & 1; J = TJob{(up ? P.ffn_w_up : P.ffn_w_gate) + (size_t)l * D * DFF, Wgu + l * WGU_STRIDE, P.norm_ffn + l * D, DFF, D, DFF, 1, up * 128, r % I_FF}; break; } r -= 4 * I_FF; \
            if (r < 2 * I_DN) { const int l = r / I_DN; J = TJob{P.ffn_w_down + (size_t)l * DFF * D, Wdn + l * WDN_STRIDE, nullptr, D, DFF, D, 0, 0, r % I_DN}; break; } r -= 2 * I_DN; \
            if (r < 2 * I_PP) { const int l = r / I_PP; J = TJob{P.ple_w_proj + (size_t)l * 256 * D, Wpp + l * WPP_STRIDE, nullptr, D, 256, D, 0, 0, r % I_PP}; break; } r -= 2 * I_PP; \
            { const int l = r / I_SQ; J = TJob{P.ple_w_gate + (size_t)l * D * D, Wpg + l * WPG_STRIDE, P.norm_ple + l * D, D, D, D, 0, 0, r % I_SQ}; } } while (0)
        for (int rt_ = 0; rt_ <= REP_T; ++rt_)
        {
            float tA[32], tB[32]; TJob jc, jn; int it = gw; bool have = it < NITEMS;
            if (have) { T_DECODE(it, jc); transpose_issue(jc, tA, lane); }
            while (have) {
                const int itn = it + NGW; const bool haven = itn < NITEMS;
                if (haven) { T_DECODE(itn, jn); transpose_issue(jn, tB, lane); }
                transpose_finish(jc, tA, scr, lane);
#pragma unroll
                for (int i = 0; i < 32; ++i) tA[i] = tB[i];
                jc = jn; it = itn; have = haven;
            }
        }
#undef T_DECODE
        for (int rp_ = 0; rp_ <= REP_PR; ++rp_)
        for (int i0 = gt; i0 < 2 * M * 256 / 8; i0 += 4 * NGT) { f32x4 a[4], c[4];
#pragma unroll
            for (int k = 0; k < 4; ++k) { const int i = i0 + k * NGT; if (i < 2 * M * 256 / 8) { a[k] = __builtin_nontemporal_load((const f32x4*)P.p + 2 * i); c[k] = __builtin_nontemporal_load((const f32x4*)P.p + 2 * i + 1); } }
#pragma unroll
            for (int k = 0; k < 4; ++k) { const int i = i0 + k * NGT; if (i < 2 * M * 256 / 8) ((u32x4*)pbf)[i] = pg8::pack8(a[k], c[k]); } }
        for (int i = gt; i < M * 32; i += NGT) { float c, s; rope_entry(P.pos[i >> 5], i & 31, c, s); ropeC[i] = c; ropeS[i] = s; }
        __syncthreads();
        for (int rn_ = 0; rn_ <= REP_NG; ++rn_) norm_phase<true, false>(P.x, P.norm_mix, hn, lds, P.ev_w_in, P.ev_b_f, Fc, tot, tid, lane, wave);
    }
    SEAM(0);
    if (IN(1)) { IDS
        LAS float* offs = (LAS float*)lds;
        for (int item = blockIdx.x; item < 256; item += G) {
            const int bh = item >> 4, part = item & 15;
            if (tid < 128) offs[tid] = tot[bh * 128 + tid];
            __syncthreads();
            if (wave == 0) { const float a = offs[2 * lane], b2 = offs[2 * lane + 1], s2 = a + b2; float inc = s2;
#pragma unroll
                for (int o = 1; o < 64; o <<= 1) { const float t = __shfl_up(inc, o); if (lane >= o) inc += t; }
                const float exc = inc - s2; offs[128 + 2 * lane] = exc; offs[128 + 2 * lane + 1] = exc + a; }
            __syncthreads();
            { const int sidx = part * 512 + tid; float* fp = Fc + (size_t)bh * S + sidx; *fp = (*fp + offs[128 + (sidx >> 6)]) * LOG2E; }
            __syncthreads();
        }
        pg8::EpiL0In E{QK, VT, kstat};
        for (int rep_ = 0; rep_ <= REP_GIN0; ++rep_) GEMM(pg8::EpiL0In, E, hn, Win0, 3072, D);
    }
    SEAM(1);
    if (IN(2)) for (int rep_ = 0; rep_ <= REP_ATT0; ++rep_) { IDS
        if (rep_ > 0) xcd_barrier(xbar);
        for (int ch = blockIdx.x; ch < 2 * 8 * 16; ch += G) {
            const int cc = ch >> 4, b = (ch >> 3) & 1, hd = ch & 7; bf16x8 qfN[4]; float FqN = 0.f; int res = 1 << 28;
            for (int q = 1; q >= 0; --q) res = attn_wg<0>(QK, VT, Ob, Fc, kstat, nullptr, b, hd, 2 * cc + q, res, q == 1, q > 0, qfN, FqN, lds, tid, lane, wave);
            res = 1 << 28;
            for (int q = 1; q >= 0; --q) res = attn_wg<1>(QK, VT, Ob, nullptr, nullptr, nullptr, b, hd, 2 * cc + q, res, q == 1, q > 0, qfN, FqN, lds, tid, lane, wave);
        }
        __syncthreads();
    }
    SEAM(2);
    if (IN(3)) { { pg8::EpiResid<true> E{P.x, nullptr, hn, Fc, 1.0f}; for (int rep_ = 0; rep_ < REP_GOUT0; ++rep_) GEMM1(pg8::EpiResid<true>, E, Ob, Wout0, D, D); }
                 pg8::EpiResid<true> E{P.x, nullptr, hn, ssq, 1.0f}; GEMM1(pg8::EpiResid<true>, E, Ob, Wout0, D, D); }
    SEAM(3);
    if (IN(4)) { { pg8::EpiSwiGLU E{ACT, ssq}; for (int rep_ = 0; rep_ <= REP_GU; ++rep_) GEMM(pg8::EpiSwiGLU, E, hn, Wgu, 2 * DFF, D); }
                 { pg8::EpiStore E{PP, D}; GEMM_SUB(pg8::EpiStore, E, pbf, Wpp, D, 256, (64 * 22) % G); } }
    SEAM(4);
    if (IN(5)) { { pg8::EpiResid<false> E{nullptr, hn, hn, Fc, 0.0f}; for (int rep_ = 0; rep_ < REP_DOWN0; ++rep_) GEMM1(pg8::EpiResid<false>, E, ACT, Wdn, D, DFF); }
                 pg8::EpiResid<false> E{nullptr, hn, hn, ssq + M, 1.0f}; GEMM1(pg8::EpiResid<false>, E, ACT, Wdn, D, DFF); }
    SEAM(5);
    if (IN(6)) { { pg8::EpiPle E{hn, PP, ssq + M, hb2, Fc, 0.0f}; for (int rep_ = 0; rep_ < REP_PG0; ++rep_) GEMM1(pg8::EpiPle, E, hn, Wpg, D, D); }
                 pg8::EpiPle E{hn, PP, ssq + M, hb2, ssq + 2 * M, 1.0f}; GEMM1(pg8::EpiPle, E, hn, Wpg, D, D); }
    SEAM(6);
    if (IN(7)) { { pg8::EpiL1In E{QK, VT1, ropeC, ropeS, ssq + 2 * M}; GEMM(pg8::EpiL1In, E, hb2, Win1, 1536, D); }
                 { pg8::EpiStore E{PP1, D}; GEMM_SUB(pg8::EpiStore, E, pbf + (size_t)M * 256, Wpp + WPP_STRIDE, D, 256, (64 * 6) % G); } }
    SEAM(7);
    if (IN(8)) for (int rep_ = 0; rep_ <= REP_SWA; ++rep_) { IDS
        if (rep_ > 0) xcd_barrier(xbar);
        for (int ch = blockIdx.x; ch < 2 * 16 * 8; ch += G) { const int c = ch >> 5, b = (ch >> 4) & 1, hd = ch & 15; int res = 1 << 28; bf16x8 qfN[4]; float FqN = 0.f;
            for (int q = 3; q >= 0; --q) res = attn_wg<2>(QK, VT1, Ob, nullptr, nullptr, P.od_sinks, b, hd, 4 * c + q, res, q == 3, q > 0, qfN, FqN, lds, tid, lane, wave); }
        __syncthreads();
    }
    SEAM(8);
    if (IN(9)) { pg8::EpiResid<false> E{nullptr, hb2, hn, ssq + 3 * M, 1.0f}; GEMM1(pg8::EpiResid<false>, E, Ob, Wout1, D, D); }
    SEAM(9);
    if (IN(10)) { pg8::EpiSwiGLU E{ACT1, ssq + 3 * M}; GEMM(pg8::EpiSwiGLU, E, hn, Wgu + WGU_STRIDE, 2 * DFF, D); }
    SEAM(10);
    if (IN(11)) { pg8::EpiResid<false> E{nullptr, hn, hn, ssq + 4 * M, 1.0f}; GEMM1(pg8::EpiResid<false>, E, ACT1, Wdn + WDN_STRIDE, D, DFF); }
    SEAM(11);
    if (IN(12)) { pg8::EpiPle E{hn, PP1, ssq + 4 * M, hb2, ssq + 5 * M, 1.0f}; GEMM1(pg8::EpiPle, E, hn, Wpg + WPG_STRIDE, D, D); }
    SEAM(12);
    for (int rep_ = 0; rep_ < REP_SYNC; ++rep_) xcd_barrier(xbar);
    if (IN(13)) { IDS
        f32x4 g4[4];
#pragma unroll
        for (int q = 0; q < 4; ++q) g4[q] = *(const f32x4*)(P.norm_final + 8 * lane + 512 * (q >> 1) + 4 * (q & 1));
        for (int r0 = gw * 8; r0 < M; r0 += NGW * 8) {
            u32x4 w[8][2];
#pragma unroll
            for (int rr = 0; rr < 8; ++rr) { const u32x4* hp = (const u32x4*)(hb2 + (size_t)(r0 + rr) * D) + lane; w[rr][0] = __builtin_nontemporal_load(hp); w[rr][1] = __builtin_nontemporal_load(hp + 64); }
#pragma unroll
            for (int rr = 0; rr < 8; ++rr) { const float rs = pg8::row_rstd(ssq + 5 * M, r0 + rr); f32x4* op = (f32x4*)(h + (size_t)(r0 + rr) * D) + 2 * lane;
#pragma unroll
                for (int q = 0; q < 2; ++q) { const u32x4 x = w[rr][q];
                    const f32x4 a = {pg8::bflo(x.x), pg8::bfhi(x.x), pg8::bflo(x.y), pg8::bfhi(x.y)}, c = {pg8::bflo(x.z), pg8::bfhi(x.z), pg8::bflo(x.w), pg8::bfhi(x.w)};
                    __builtin_nontemporal_store(a * rs * g4[2 * q], op + 128 * q); __builtin_nontemporal_store(c * rs * g4[2 * q + 1], op + 128 * q + 1); } }
        }
    }
#undef IN
#undef SEAM
#undef GEMM
}

#ifndef MK_PER_PHASE
#define MK_PER_PHASE 0
#endif
constexpr int N_PHASES = 14;
extern "C" void kernel_launch(void* const* d_in, const int* in_sizes, int n_in, void* d_out, int out_size, void* d_ws, size_t ws_size, hipStream_t stream) {
    static int grid_blocks = 0;
    if (grid_blocks == 0) {
        if (n_in != 18 || out_size != M * D || ws_size < WS_END) { fprintf(stderr, "kernel_launch: unexpected shapes (n_in %d, out %d, ws %zu)\n", n_in, out_size, ws_size); grid_blocks = -1; return; }
        int dev = 0, cus = 0, per_cu = 0;
        hipGetDevice(&dev); hipDeviceGetAttribute(&cus, hipDeviceAttributeMultiprocessorCount, dev);
        if (hipFuncSetAttribute((const void*)mk_fwd, hipFuncAttributeMaxDynamicSharedMemorySize, LDS_BYTES) != hipSuccess) { fprintf(stderr, "kernel_launch: hipFuncSetAttribute failed\n"); grid_blocks = -1; return; }
        if (hipOccupancyMaxActiveBlocksPerMultiprocessor(&per_cu, (const void*)mk_fwd, NTHREADS, LDS_BYTES) != hipSuccess || per_cu < 1) { fprintf(stderr, "kernel_launch: occupancy query gave %d\n", per_cu); per_cu = 1; (void)hipGetLastError(); }
        grid_blocks = cus * 1;
    }
    if (grid_blocks < 0) return;
#define REP_LAUNCH 0
    for (int pass_ = 0; pass_ <= REP_LAUNCH; ++pass_) {
    if (hipMemsetAsync((char*)d_ws, 0, WS_ZERO_BYTES, stream) != hipSuccess) { fprintf(stderr, "kernel_launch: hipMemsetAsync failed\n"); return; }
    Params p{};
    p.x = (const float*)d_in[0]; p.p = (const float*)d_in[1]; p.pos = (const int*)d_in[2];
    p.norm_mix = (const float*)d_in[3]; p.norm_ffn = (const float*)d_in[4]; p.norm_ple = (const float*)d_in[5]; p.norm_final = (const float*)d_in[6];
    p.ev_w_in = (const float*)d_in[7]; p.ev_b_f = (const float*)d_in[8]; p.ev_w_out = (const float*)d_in[9]; p.od_w_in = (const float*)d_in[10]; p.od_sinks = (const float*)d_in[11]; p.od_w_out = (const float*)d_in[12];
    p.ffn_w_gate = (const float*)d_in[13]; p.ffn_w_up = (const float*)d_in[14]; p.ffn_w_down = (const float*)d_in[15]; p.ple_w_proj = (const float*)d_in[16]; p.ple_w_gate = (const float*)d_in[17];
    p.out = (float*)d_out; p.ws = (unsigned char*)d_ws;
#if MK_PER_PHASE
    for (int ph = 0; ph < N_PHASES; ++ph) {
        p.ph_lo = ph; p.ph_hi = ph + 1;
        void* args[] = {&p};
        hipError_t e = hipLaunchCooperativeKernel((const void*)mk_fwd, dim3(grid_blocks), dim3(NTHREADS), args, LDS_BYTES, stream);
        if (e != hipSuccess) { fprintf(stderr, "cooperative launch (phase %d) failed: %s (grid %d)\n", ph, hipGetErrorString(e), grid_blocks); break; }
    }
#else
    p.ph_lo = 0; p.ph_hi = N_PHASES;
    void* args[] = {&p};
    hipError_t e = hipLaunchCooperativeKernel((const void*)mk_fwd, dim3(grid_blocks), dim3(NTHREADS), args, LDS_BYTES, stream);
    if (e != hipSuccess) fprintf(stderr, "cooperative launch failed: %s (grid %d)\n", hipGetErrorString(e), grid_blocks);
#endif
    }
}
```

```cpp
#include <hip/hip_runtime.h>
#include <hip/hip_cooperative_groups.h>
#include <cstdio>
#include <cstdint>
#include <cmath>
namespace cg = cooperative_groups;
namespace pg8 {
#define PG8_LAS __attribute__((address_space(3)))
typedef unsigned short bf16_t;
typedef short bf16x8 __attribute__((ext_vector_type(8)));
typedef float f32x4 __attribute__((ext_vector_type(4)));
typedef unsigned u32x4 __attribute__((ext_vector_type(4)));
constexpr int BM = 256, BK = 64, HALF = 128, HTB = HALF * BK * 2  , STAGE_BYTES = 8 * HTB, NXCD = 8, WGM = 8;

__host__ __device__ __forceinline__ int lds_byte(int r, int c) { const int st = (r >> 4) * 2 + (c >> 5), rr = r & 15, cc = c & 31, ob = rr * 64 + cc * 2; return st * 1024 + (ob ^ (((ob >> 9) & 1) << 5)); }
__host__ __device__ __forceinline__ void stage_rc(int b, int& R, int& C) { const int st = b / 1024, sb = b % 1024, swz = sb ^ (((sb >> 9) & 1) << 5); R = (st >> 1) * 16 + swz / 64; C = (st & 1) * 32 + (swz % 64) / 2; }
__host__ __device__ __forceinline__ int perm32(int rho) { const int n = rho >> 4, i = rho & 15; return 8 * (i >> 2) + 4 * n + (i & 3); }

struct Unit { int pm, pn; };
struct Gemm { const bf16_t* A; const bf16_t* Bt; int M, N, K; };

struct StaticOrder {
    int nM, nN, nwg, G, c;
    __host__ __device__ void init(int M, int N, int G_, int c_) { nM = M / BM; nN = N / BM; nwg = nM * nN; G = G_; c = c_; }
    __host__ __device__ bool next(int i, Unit& u) const {
        const long L = (long)i * G + c; if (L >= nwg) return false;
        int wgid = (int)L; { const int q = nwg / NXCD, r = nwg % NXCD, xcd = wgid % NXCD, off = wgid / NXCD; wgid = (xcd < r ? xcd * (q + 1) : r * (q + 1) + (xcd - r) * q) + off; }
        const int nig = WGM * nN, gid = wgid / nig, fm = gid * WGM, gsz = (nM - fm) < WGM ? (nM - fm) : WGM;
        u.pm = fm + ((wgid % nig) % gsz); u.pn = (wgid % nig) / gsz; return true;
    }
    __device__ __forceinline__ void a_ready(const Unit&) const {}
    __device__ __forceinline__ void done(const Unit&) const {}
};

typedef float f32x2 __attribute__((ext_vector_type(2)));
typedef __bf16 bf16x2_t __attribute__((ext_vector_type(2)));
typedef unsigned u32x2 __attribute__((ext_vector_type(2)));
__device__ __forceinline__ unsigned cvtpk(float lo, float hi) { f32x2 v = {lo, hi}; bf16x2_t b = __builtin_convertvector(v, bf16x2_t); return __builtin_bit_cast(unsigned, b); }
__device__ __forceinline__ u32x4 pack8(f32x4 a, f32x4 b) { u32x4 w; w.x = cvtpk(a[0], a[1]); w.y = cvtpk(a[2], a[3]); w.z = cvtpk(b[0], b[1]); w.w = cvtpk(b[2], b[3]); return w; }
__device__ __forceinline__ float bflo(unsigned w) { return __builtin_bit_cast(float, w << 16); }
__device__ __forceinline__ float bfhi(unsigned w) { return __builtin_bit_cast(float, w & 0xffff0000u); }
__device__ __forceinline__ float fast_sigmoid(float x) { return __builtin_amdgcn_rcpf(1.0f + __builtin_amdgcn_exp2f(-x * 1.4426950408889634f)); }
__device__ __forceinline__ float row_rstd(const float* ssq, int row) { return __builtin_amdgcn_rsqf(ssq[row] * (1.0f / 1024.0f) + 1e-6f); }
__device__ __forceinline__ void st16_wt(void* p, u32x4 v) { asm volatile("global_store_dwordx4 %0, %1, off sc1\n\ts_nop 1" :: "v"(p), "v"(v) : "memory"); }
#ifndef WT_RESID
#define WT_RESID 0
#endif
#ifndef WT_WIDE
#define WT_WIDE 0
#endif
#ifndef WT_QK
#define WT_QK 0
#endif
#ifndef NT_QK
#define NT_QK 0
#endif
#ifndef NT_ACT
#define NT_ACT 0
#endif
#define EPI_ARGS const f32x4 (&acc)[2][2][4][2], const Unit& u, int wr, int wc, int fr, int fq
#define EPI_FLAGS static constexpr bool PERM = true, AFTER_DRAIN = false;
__device__ __forceinline__ void vt_store8(bf16_t* p, f32x4 a, f32x4 b) {
    const unsigned w0 = cvtpk(a[0], a[1]), w1 = cvtpk(a[2], a[3]), w2 = cvtpk(b[0], b[1]), w3 = cvtpk(b[2], b[3]);
    p[0 * 8192] = (bf16_t)(w0 & 0xffffu); p[1 * 8192] = (bf16_t)(w0 >> 16); p[2 * 8192] = (bf16_t)(w1 & 0xffffu); p[3 * 8192] = (bf16_t)(w1 >> 16);
    p[4 * 8192] = (bf16_t)(w2 & 0xffffu); p[5 * 8192] = (bf16_t)(w2 >> 16); p[6 * 8192] = (bf16_t)(w3 & 0xffffu); p[7 * 8192] = (bf16_t)(w3 >> 16);
}

struct EpiStore {
    EPI_FLAGS
    bf16_t* O; int ldc;
    __device__ __forceinline__ void operator()(EPI_ARGS) const {
        const int row0 = u.pm * BM + wr * 64 + fr, col0 = u.pn * BM + wc * 32 + 8 * fq;
#pragma unroll
        for (int ai = 0; ai < 2; ++ai)
#pragma unroll
            for (int m = 0; m < 4; ++m) { bf16_t* rowp = O + (size_t)(row0 + ai * HALF + m * 16) * ldc + col0;
#pragma unroll
                for (int bj = 0; bj < 2; ++bj) { if (WT_WIDE) st16_wt(rowp + bj * HALF, pack8(acc[ai][bj][m][0], acc[ai][bj][m][1])); else *(u32x4*)(rowp + bj * HALF) = pack8(acc[ai][bj][m][0], acc[ai][bj][m][1]); } }
    }
};

struct EpiL0In {
    EPI_FLAGS
    bf16_t* QK; bf16_t* VT; unsigned* kstat;
    __device__ __forceinline__ void operator()(EPI_ARGS) const {
        const int sec = u.pn >> 1, half = u.pn & 1, row0 = u.pm * BM + wr * 64 + fr, b = u.pm >> 5;
        if (sec == 2 || sec == 5) {
#pragma unroll
            for (int ai = 0; ai < 2; ++ai)
#pragma unroll
                for (int m = 0; m < 4; ++m) { const int s = (row0 + ai * HALF + m * 16) & 8191;
#pragma unroll
                    for (int bj = 0; bj < 2; ++bj) { const int colt = half * 256 + bj * 128 + wc * 32 + 8 * fq, head = (colt >> 6) + (sec == 5 ? 8 : 0), d0 = colt & 63;
                        vt_store8(VT + ((size_t)(b * 16 + head) * 64 + d0) * 8192 + s, acc[ai][bj][m][0], acc[ai][bj][m][1]); } }
        } else {
            const float sc = (sec == 0 || sec == 3) ? 0.125f * 1.4426950408889634f : 1.0f;
            const int cbase = (sec == 0 ? 0 : sec == 1 ? 512 : sec == 3 ? 1024 : 1536) + half * 256 + wc * 32 + 8 * fq;
#pragma unroll
            for (int ai = 0; ai < 2; ++ai)
#pragma unroll
                for (int m = 0; m < 4; ++m) { bf16_t* rowp = QK + (size_t)(row0 + ai * HALF + m * 16) * 2048 + cbase;
#pragma unroll
                    for (int bj = 0; bj < 2; ++bj) { if (NT_QK) __builtin_nontemporal_store(pack8(acc[ai][bj][m][0] * sc, acc[ai][bj][m][1] * sc), (u32x4*)(rowp + bj * HALF)); else *(u32x4*)(rowp + bj * HALF) = pack8(acc[ai][bj][m][0] * sc, acc[ai][bj][m][1] * sc); } }
            if (sec == 1) {
#pragma unroll
                for (int bj = 0; bj < 2; ++bj) { float best = 0.f;
#pragma unroll
                    for (int ai = 0; ai < 2; ++ai)
#pragma unroll
                        for (int m = 0; m < 4; ++m) { const f32x4 a = acc[ai][bj][m][0], c = acc[ai][bj][m][1];
                            float ss = (a[0] * a[0] + a[1] * a[1]) + (a[2] * a[2] + a[3] * a[3]) + (c[0] * c[0] + c[1] * c[1]) + (c[2] * c[2] + c[3] * c[3]);
                            ss += __shfl_xor(ss, 16); ss += __shfl_xor(ss, 32); best = fmaxf(best, ss); }
                    best = fmaxf(best, __shfl_xor(best, 1)); best = fmaxf(best, __shfl_xor(best, 2)); best = fmaxf(best, __shfl_xor(best, 4)); best = fmaxf(best, __shfl_xor(best, 8));
                    if (fr == 0 && fq == 0) atomicMax(kstat + ((b * 8 + half * 4 + bj * 2 + (wc >> 1)) * 2 + (wc & 1)), __builtin_bit_cast(unsigned, best)); }
            }
        }
    }
};

struct EpiL1In {
    EPI_FLAGS
    bf16_t* QKV; bf16_t* VT; const float* ropeC; const float* ropeS; const float* ssq;
    __device__ __forceinline__ void operator()(EPI_ARGS) const {
        int fr_ = fr; asm volatile("" : "+v"(fr_));
        const int row0 = u.pm * BM + wr * 64 + fr_, b = u.pm >> 5;
        float sq[2][4];
#pragma unroll
        for (int ai = 0; ai < 2; ++ai)
#pragma unroll
            for (int m = 0; m < 4; ++m) sq[ai][m] = ssq[row0 + ai * HALF + m * 16];
        if (u.pn == 5) {
            asm volatile("" ::: "memory");
#pragma unroll
            for (int ai = 0; ai < 2; ++ai)
#pragma unroll
                for (int m = 0; m < 4; ++m) { const int s = (row0 + ai * HALF + m * 16) & 8191; const float rs = __builtin_amdgcn_rsqf(sq[ai][m] * (1.0f / 1024.0f) + 1e-6f);
#pragma unroll
                    for (int bj = 0; bj < 2; ++bj) { const int colt = bj * 128 + wc * 32 + 8 * fq, head = colt >> 6, d0 = colt & 63;
                        vt_store8(VT + ((size_t)(b * 4 + head) * 64 + d0) * 8192 + s, acc[ai][bj][m][0] * rs, acc[ai][bj][m][1] * rs); } }
        } else {
            const float sc = (u.pn < 4) ? 0.125f * 1.4426950408889634f : 1.0f;
            const int col0 = u.pn * BM + wc * 32 + 8 * fq, j0 = 4 * ((wc & 1) * 4 + fq);
            f32x4 csv[4], snv[4]; u32x4 outs[4][2];
#pragma unroll
            for (int m = 0; m < 4; ++m) { const int row = row0 + m * 16; csv[m] = *(const f32x4*)(ropeC + (size_t)row * 32 + j0); snv[m] = *(const f32x4*)(ropeS + (size_t)row * 32 + j0); }
#pragma unroll
            for (int ai = 0; ai < 2; ++ai) {
                asm volatile("" ::: "memory");
#pragma unroll
                for (int m = 0; m < 4; ++m) { const float rs = __builtin_amdgcn_rsqf(sq[ai][m] * (1.0f / 1024.0f) + 1e-6f) * sc; const f32x4 cs = csv[m] * rs, sn = snv[m] * rs;
#pragma unroll
                    for (int bj = 0; bj < 2; ++bj) { const f32x4 x1 = acc[ai][bj][m][0], x2 = acc[ai][bj][m][1]; outs[m][bj] = pack8(x1 * cs - x2 * sn, x2 * cs + x1 * sn); } }
                if (ai == 0) {
#pragma unroll
                    for (int m = 0; m < 4; ++m) { const int row = row0 + HALF + m * 16; csv[m] = *(const f32x4*)(ropeC + (size_t)row * 32 + j0); snv[m] = *(const f32x4*)(ropeS + (size_t)row * 32 + j0); } }
                asm volatile("" ::: "memory");
#pragma unroll
                for (int m = 0; m < 4; ++m) { bf16_t* rowp = QKV + (size_t)(row0 + ai * HALF + m * 16) * 1280 + col0;
#pragma unroll
                    for (int bj = 0; bj < 2; ++bj) { if (NT_QK) __builtin_nontemporal_store(outs[m][bj], (u32x4*)(rowp + bj * HALF)); else *(u32x4*)(rowp + bj * HALF) = outs[m][bj]; } }
            }
        }
    }
};

#define EPI_FENCE asm volatile("" ::: "memory")
__device__ __forceinline__ float rstd_of(float ssq_row) { return __builtin_amdgcn_rsqf(ssq_row * (1.0f / 1024.0f) + 1e-6f); }
__device__ __forceinline__ float sumsq8(f32x4 r0, f32x4 r1) { return (r0[0] * r0[0] + r0[1] * r0[1]) + (r0[2] * r0[2] + r0[3] * r0[3]) + (r1[0] * r1[0] + r1[1] * r1[1]) + (r1[2] * r1[2] + r1[3] * r1[3]); }

template <bool BASEF32> struct EpiResid {
    EPI_FLAGS
    const float* basef; const bf16_t* baseb; bf16_t* out; float* ssq; float mul;
    __device__ __forceinline__ void load_group(int g, int row0, int col0, f32x4 (&pf)[2][2][2], u32x4 (&pb)[2][2]) const {
#pragma unroll
        for (int r = 0; r < 2; ++r)
#pragma unroll
            for (int bj = 0; bj < 2; ++bj) { const size_t o = (size_t)(row0 + (g >> 1) * HALF + ((g & 1) * 2 + r) * 16) * 1024 + col0 + bj * HALF;
                if (BASEF32) { const f32x4* bp = (const f32x4*)(basef + o); pf[r][bj][0] = __builtin_nontemporal_load(bp); pf[r][bj][1] = __builtin_nontemporal_load(bp + 1); } else pb[r][bj] = *(const u32x4*)(baseb + o); }
    }
    __device__ __forceinline__ void operator()(EPI_ARGS) const {
        const int row0 = u.pm * BM + wr * 64 + fr, col0 = u.pn * BM + wc * 32 + 8 * fq;
        f32x4 pf[2][2][2]; u32x4 pb[2][2], outs[2][2]; float sums[2];
        load_group(0, row0, col0, pf, pb);
#pragma unroll
        for (int g = 0; g < 4; ++g) { const int ai = g >> 1;
            EPI_FENCE;
#pragma unroll
            for (int r = 0; r < 2; ++r) { const int m = (g & 1) * 2 + r; float ss = 0.f;
#pragma unroll
                for (int bj = 0; bj < 2; ++bj) { f32x4 b0, b1;
                    if (BASEF32) { b0 = pf[r][bj][0]; b1 = pf[r][bj][1]; }
                    else { const u32x4 w = pb[r][bj]; b0 = (f32x4){bflo(w.x), bfhi(w.x), bflo(w.y), bfhi(w.y)}; b1 = (f32x4){bflo(w.z), bfhi(w.z), bflo(w.w), bfhi(w.w)}; }
                    const f32x4 r0 = b0 + acc[ai][bj][m][0] * mul, r1 = b1 + acc[ai][bj][m][1] * mul; outs[r][bj] = pack8(r0, r1); ss += sumsq8(r0, r1); }
                sums[r] = ss; }
            if (g < 3) load_group(g + 1, row0, col0, pf, pb);
            EPI_FENCE;
#pragma unroll
            for (int r = 0; r < 2; ++r) { const int row = row0 + ai * HALF + ((g & 1) * 2 + r) * 16; const size_t off = (size_t)row * 1024 + col0;
#pragma unroll
                for (int bj = 0; bj < 2; ++bj) *(u32x4*)(out + off + bj * HALF) = outs[r][bj];
                float ss = sums[r]; ss += __shfl_xor(ss, 16); ss += __shfl_xor(ss, 32); if (fq == 0) atomicAdd(ssq + row, ss); }
        }
    }
};

struct EpiSwiGLU {
    EPI_FLAGS
    bf16_t* ACT; const float* ssq;
    __device__ __forceinline__ void operator()(EPI_ARGS) const {
        const int row0 = u.pm * BM + wr * 64 + fr, col0 = u.pn * HALF + wc * 32 + 8 * fq;
        float sq[2][4];
#pragma unroll
        for (int ai = 0; ai < 2; ++ai)
#pragma unroll
            for (int m = 0; m < 4; ++m) sq[ai][m] = ssq[row0 + ai * HALF + m * 16];
        EPI_FENCE;
#pragma unroll
        for (int ai = 0; ai < 2; ++ai)
#pragma unroll
            for (int m = 0; m < 4; ++m) { f32x4 r[2]; const float rs = rstd_of(sq[ai][m]);
#pragma unroll
                for (int n = 0; n < 2; ++n) { const f32x4 g = acc[ai][0][m][n] * rs, up = acc[ai][1][m][n] * rs;
#pragma unroll
                    for (int e = 0; e < 4; ++e) r[n][e] = g[e] * fast_sigmoid(g[e]) * up[e]; }
                if (NT_ACT) __builtin_nontemporal_store(pack8(r[0], r[1]), (u32x4*)(ACT + (size_t)(row0 + ai * HALF + m * 16) * 2816 + col0)); else *(u32x4*)(ACT + (size_t)(row0 + ai * HALF + m * 16) * 2816 + col0) = pack8(r[0], r[1]); }
    }
};

struct EpiPle {
    EPI_FLAGS
    const bf16_t* base; const bf16_t* PP; const float* ssq_in; bf16_t* outb; float* ssq_out; float mul;
    __device__ __forceinline__ void load_group(int g, int row0, int col0, u32x4 (&hb)[2][2], u32x4 (&pb)[2][2]) const {
#pragma unroll
        for (int r = 0; r < 2; ++r)
#pragma unroll
            for (int bj = 0; bj < 2; ++bj) { const size_t o = (size_t)(row0 + (g >> 1) * HALF + ((g & 1) * 2 + r) * 16) * 1024 + col0 + bj * HALF; hb[r][bj] = *(const u32x4*)(base + o); pb[r][bj] = *(const u32x4*)(PP + o); }
    }
    __device__ __forceinline__ void operator()(EPI_ARGS) const {
        const int row0 = u.pm * BM + wr * 64 + fr, col0 = u.pn * BM + wc * 32 + 8 * fq;
        float sq[2][4]; u32x4 hb[2][2], pb[2][2], outs[2][2]; float sums[2];
#pragma unroll
        for (int ai = 0; ai < 2; ++ai)
#pragma unroll
            for (int m = 0; m < 4; ++m) sq[ai][m] = ssq_in[row0 + ai * HALF + m * 16];
        load_group(0, row0, col0, hb, pb);
#pragma unroll
        for (int g = 0; g < 4; ++g) { const int ai = g >> 1;
            EPI_FENCE;
#pragma unroll
            for (int r = 0; r < 2; ++r) { const int m = (g & 1) * 2 + r; const float rs = rstd_of(sq[ai][m]); float ss = 0.f;
#pragma unroll
                for (int bj = 0; bj < 2; ++bj) { const u32x4 hw = hb[r][bj], pp = pb[r][bj];
                    const f32x4 h0 = {bflo(hw.x), bfhi(hw.x), bflo(hw.y), bfhi(hw.y)}, h1 = {bflo(hw.z), bfhi(hw.z), bflo(hw.w), bfhi(hw.w)};
                    const f32x4 a0 = acc[ai][bj][m][0] * rs, a1 = acc[ai][bj][m][1] * rs;
                    f32x4 p0 = {bflo(pp.x), bfhi(pp.x), bflo(pp.y), bfhi(pp.y)}, p1 = {bflo(pp.z), bfhi(pp.z), bflo(pp.w), bfhi(pp.w)}, g0, g1;
#pragma unroll
                    for (int e = 0; e < 4; ++e) { g0[e] = fast_sigmoid(a0[e]); g1[e] = fast_sigmoid(a1[e]); }
                    const f32x4 r0 = h0 + g0 * p0 * mul, r1 = h1 + g1 * p1 * mul;
                    outs[r][bj] = pack8(r0, r1); ss += sumsq8(r0, r1); }
                sums[r] = ss; }
            if (g < 3) load_group(g + 1, row0, col0, hb, pb);
            EPI_FENCE;
#pragma unroll
            for (int r = 0; r < 2; ++r) { const int row = row0 + ai * HALF + ((g & 1) * 2 + r) * 16; const size_t off = (size_t)row * 1024 + col0;
#pragma unroll
                for (int bj = 0; bj < 2; ++bj) *(u32x4*)(outb + off + bj * HALF) = outs[r][bj];
                float ss = sums[r]; ss += __shfl_xor(ss, 16); ss += __shfl_xor(ss, 32); if (fq == 0) atomicAdd(ssq_out + row, ss); }
        }
    }
};

template <class Epi, class Sched, bool ALIGN_EPI = false, bool SP2 = false>
__device__ __forceinline__ void gemm_phase(PG8_LAS unsigned char* lds, const Gemm g, const Sched& S, const Epi& E) {
    int tid_ = threadIdx.x; asm volatile("" : "+v"(tid_));
    const int tid = tid_, wid = __builtin_amdgcn_readfirstlane(tid >> 6), lane = tid & 63, wr = wid >> 2, wc = wid & 3, fr = lane & 15, fq = lane >> 4;
    const int K = g.K, nt = K / BK;
    unsigned voffA[2], voffB[2];
#pragma unroll
    for (int i = 0; i < 2; ++i) { int R, C; stage_rc(tid * 16 + i * 8192, R, C); const int Rb = Epi::PERM ? ((R & ~31) + perm32(R & 31)) : R;
        voffA[i] = (unsigned)(R * K + C) * 2u; voffB[i] = (unsigned)(Rb * K + C) * 2u; }
    const size_t kstep = (size_t)(BK * 2);
    const size_t hstep = (size_t)HALF * K * 2;
    const size_t tstep = 2 * hstep;
    const unsigned ldsw = (unsigned)wid * 1024u;
    const int aoff = lds_byte(wr * 64 + fr, fq * 8), boff = lds_byte(wc * 32 + fr, fq * 8);
#define PG8_SA(b, h) (((b) * 2 + (h)) * HTB)
#define PG8_SB(b, h) ((4 + (b) * 2 + (h)) * HTB)
#define PG8_STAGE(bufoff, gbase, voff) do { _Pragma("unroll") for (int _i = 0; _i < 2; ++_i) \
        __builtin_amdgcn_global_load_lds((const unsigned*)((const char*)(gbase) + (voff)[_i]), (PG8_LAS unsigned*)(lds + (bufoff) + ldsw + _i * 8192), 16, 0, 0); } while (0)
#define PG8_LDA(dst, b, h) do { _Pragma("unroll") for (int m = 0; m < 4; ++m) _Pragma("unroll") for (int k = 0; k < 2; ++k) dst[m][k] = *(const PG8_LAS bf16x8*)(lds + PG8_SA(b, h) + aoff + m * 2048 + k * 1024); } while (0)
#define PG8_LDB(dst, b, h) do { _Pragma("unroll") for (int n = 0; n < 2; ++n) _Pragma("unroll") for (int k = 0; k < 2; ++k) dst[n][k] = *(const PG8_LAS bf16x8*)(lds + PG8_SB(b, h) + boff + n * 2048 + k * 1024); } while (0)
#define PG8_MMA(ai, bj, At, Bt) do { __builtin_amdgcn_s_setprio(1); _Pragma("unroll") for (int m = 0; m < 4; ++m) _Pragma("unroll") for (int n = 0; n < 2; ++n) _Pragma("unroll") for (int k = 0; k < 2; ++k) \
        acc[ai][bj][m][n] = __builtin_amdgcn_mfma_f32_16x16x32_bf16(Bt[n][k], At[m][k], acc[ai][bj][m][n], 0, 0, 0); __builtin_amdgcn_s_setprio(0); } while (0)
#define PG8_WAIT_V(n) asm volatile("s_waitcnt vmcnt(" #n ")" ::: "memory")
#define PG8_WAIT_L(n) asm volatile("s_waitcnt lgkmcnt(" #n ")" ::: "memory")
#define PG8_BAR __builtin_amdgcn_s_barrier()
#define PG8_SCHED __builtin_amdgcn_sched_barrier(0)
    Unit cur, nxt; int ui = 0;
    if (!S.next(0, cur)) return;
    f32x4 acc[2][2][4][2];
#pragma unroll
    for (int a = 0; a < 2; ++a)
#pragma unroll
        for (int b = 0; b < 2; ++b)
#pragma unroll
            for (int m = 0; m < 4; ++m)
#pragma unroll
                for (int n = 0; n < 2; ++n) acc[a][b][m][n] = (f32x4){0.f, 0.f, 0.f, 0.f};
    bf16x8 At[4][2], B0[2][2], B1[2][2];
    const char* cA = (const char*)g.A + (size_t)cur.pm * tstep; const char* cB = (const char*)g.Bt + (size_t)cur.pn * tstep;
    S.a_ready(cur);
    if constexpr (SP2) {
        PG8_STAGE(PG8_SB(0, 0), cB, voffB); PG8_STAGE(PG8_SB(0, 1), cB + hstep, voffB); PG8_STAGE(PG8_SA(0, 0), cA, voffA); PG8_STAGE(PG8_SA(0, 1), cA + hstep, voffA);
        if (wr == 1) PG8_BAR;
        PG8_WAIT_V(2); PG8_BAR;
        PG8_STAGE(PG8_SB(1, 0), cB + kstep, voffB); PG8_STAGE(PG8_SA(1, 0), cA + kstep, voffA); PG8_STAGE(PG8_SB(1, 1), cB + hstep + kstep, voffB);
        PG8_WAIT_V(6); PG8_BAR;
    } else {
        PG8_STAGE(PG8_SB(0, 0), cB, voffB); PG8_STAGE(PG8_SA(0, 0), cA, voffA); PG8_STAGE(PG8_SB(0, 1), cB + hstep, voffB); PG8_STAGE(PG8_SA(0, 1), cA + hstep, voffA);
        if (wr == 1) PG8_BAR;
        PG8_WAIT_V(4); PG8_BAR;
        PG8_STAGE(PG8_SB(1, 0), cB + kstep, voffB); PG8_STAGE(PG8_SA(1, 0), cA + kstep, voffA); PG8_STAGE(PG8_SB(1, 1), cB + hstep + kstep, voffB);
        PG8_WAIT_V(6); PG8_BAR;
    }
    for (;;) {
        const bool has_next = S.next(ui + 1, nxt);
        const char* nA = has_next ? (const char*)g.A + (size_t)nxt.pm * tstep : cA; const char* nB = has_next ? (const char*)g.Bt + (size_t)nxt.pn * tstep : cB;
        for (int t = 0; t < nt; t += 2) {
            const bool last = (t == nt - 2);
            const char* a1 = cA + (size_t)(t + 1) * kstep;
            const char* a2 = last ? nA : cA + (size_t)(t + 2) * kstep; const char* b2 = last ? nB : cB + (size_t)(t + 2) * kstep;
            const char* a3 = a2 + kstep; const char* b3 = b2 + kstep;
            if (last && has_next) S.a_ready(nxt);
            if constexpr (SP2) {
            PG8_LDB(B0, 0, 0); PG8_LDB(B1, 0, 1); PG8_SCHED; PG8_LDA(At, 0, 0); PG8_STAGE(PG8_SA(1, 1), a1 + hstep, voffA);
            PG8_WAIT_V(8); PG8_WAIT_L(0); PG8_BAR; PG8_MMA(0, 0, At, B0); PG8_MMA(0, 1, At, B1); PG8_BAR; PG8_SCHED;
            PG8_LDA(At, 0, 1); PG8_STAGE(PG8_SB(0, 0), b2, voffB); PG8_STAGE(PG8_SB(0, 1), b2 + hstep, voffB); PG8_STAGE(PG8_SA(0, 0), a2, voffA);
            PG8_WAIT_V(8); PG8_WAIT_L(0); PG8_BAR; PG8_MMA(1, 0, At, B0); PG8_MMA(1, 1, At, B1); PG8_BAR; PG8_SCHED;
            PG8_LDB(B0, 1, 0); PG8_LDB(B1, 1, 1); PG8_SCHED; PG8_LDA(At, 1, 0); PG8_STAGE(PG8_SA(0, 1), a2 + hstep, voffA);
            PG8_WAIT_V(8); PG8_WAIT_L(0); PG8_BAR; PG8_MMA(0, 0, At, B0); PG8_MMA(0, 1, At, B1); PG8_BAR; PG8_SCHED;
            PG8_LDA(At, 1, 1); PG8_STAGE(PG8_SB(1, 0), b3, voffB); PG8_STAGE(PG8_SB(1, 1), b3 + hstep, voffB); PG8_STAGE(PG8_SA(1, 0), a3, voffA);
            PG8_WAIT_V(8); PG8_WAIT_L(0); PG8_BAR; PG8_MMA(1, 0, At, B0); PG8_MMA(1, 1, At, B1); PG8_BAR; PG8_SCHED;
            } else {
            PG8_LDB(B0, 0, 0); PG8_SCHED; PG8_LDA(At, 0, 0); PG8_STAGE(PG8_SA(1, 1), a1 + hstep, voffA);
            PG8_WAIT_L(8); PG8_BAR; PG8_WAIT_L(0); PG8_MMA(0, 0, At, B0); PG8_BAR; PG8_SCHED;
            PG8_LDB(B1, 0, 1); PG8_STAGE(PG8_SB(0, 0), b2, voffB);
            PG8_BAR; PG8_WAIT_L(0); PG8_MMA(0, 1, At, B1); PG8_BAR;
            PG8_LDA(At, 0, 1); PG8_STAGE(PG8_SA(0, 0), a2, voffA);
            PG8_BAR; PG8_WAIT_L(0); PG8_MMA(1, 0, At, B0); PG8_BAR; PG8_SCHED;
            PG8_STAGE(PG8_SB(0, 1), b2 + hstep, voffB);
            PG8_WAIT_V(6); PG8_BAR; PG8_MMA(1, 1, At, B1); PG8_BAR;
            PG8_LDB(B0, 1, 0); PG8_SCHED; PG8_LDA(At, 1, 0); PG8_STAGE(PG8_SA(0, 1), a2 + hstep, voffA);
            PG8_WAIT_L(8); PG8_BAR; PG8_WAIT_L(0); PG8_MMA(0, 0, At, B0); PG8_BAR; PG8_SCHED;
            PG8_LDB(B1, 1, 1); PG8_STAGE(PG8_SB(1, 0), b3, voffB);
            PG8_BAR; PG8_WAIT_L(0); PG8_MMA(0, 1, At, B1); PG8_BAR;
            PG8_LDA(At, 1, 1); PG8_STAGE(PG8_SA(1, 0), a3, voffA);
            PG8_BAR; PG8_WAIT_L(0); PG8_MMA(1, 0, At, B0); PG8_BAR; PG8_SCHED;
            PG8_STAGE(PG8_SB(1, 1), b3 + hstep, voffB);
            PG8_WAIT_V(6); PG8_BAR; PG8_MMA(1, 1, At, B1); PG8_BAR;
            }
        }
        if constexpr (ALIGN_EPI) { if (wr == 0) PG8_BAR; }
        if constexpr (!Epi::AFTER_DRAIN) { E(acc, cur, wr, wc, fr, fq); S.done(cur); }
        if (!has_next) break;
#pragma unroll
        for (int a = 0; a < 2; ++a)
#pragma unroll
            for (int b = 0; b < 2; ++b)
#pragma unroll
                for (int m = 0; m < 4; ++m)
#pragma unroll
                    for (int n = 0; n < 2; ++n) acc[a][b][m][n] = (f32x4){0.f, 0.f, 0.f, 0.f};
        cur = nxt; cA = nA; cB = nB; ++ui;
        if constexpr (ALIGN_EPI) { if (wr == 1) PG8_BAR; }
    }
    PG8_WAIT_V(0);
    if constexpr (!ALIGN_EPI) { if (wr == 0) PG8_BAR; }
    PG8_BAR;
    if constexpr (Epi::AFTER_DRAIN) { E.fused(acc, cur, wr, wc, fr, fq, lds, wid, lane); S.done(cur); }
#undef PG8_SA
#undef PG8_SB
#undef PG8_STAGE
#undef PG8_LDA
#undef PG8_LDB
#undef PG8_MMA
#undef PG8_WAIT_V
#undef PG8_WAIT_L
#undef PG8_BAR
#undef PG8_SCHED
}
}

using pg8::bf16_t; using pg8::bf16x8; using pg8::f32x4; using pg8::u32x4; using pg8::u32x2; using pg8::cvtpk;
typedef float f32x16 __attribute__((ext_vector_type(16)));
#define LAS __attribute__((address_space(3)))
#define DI __device__ __forceinline__
#define MFMA32(a, b, c) __builtin_amdgcn_mfma_f32_32x32x16_bf16((a), (b), (c), 0, 0, 0)
constexpr float LOG2E = 1.4426950408889634f;
constexpr int M = 16384, S = 8192, D = 1024, DFF = 2816, NWAVES = 8, NTHREADS = 512;
constexpr float EPS = 1e-6f;
constexpr size_t MiB = 1u << 20;
constexpr size_t WS_KSTAT = 0, WS_TOT = 4096, WS_BAR = 16384, WS_SSQ = 65536, WS_ZERO_BYTES = 65536;
constexpr size_t WS_ROPEC = 1 * MiB, WS_ROPES = 3 * MiB;
constexpr size_t WS_F = 5 * MiB;
constexpr size_t WS_WIN0 = 6 * MiB, WS_WOUT0 = 12 * MiB, WS_WIN1 = 14 * MiB, WS_WOUT1 = 17 * MiB, WS_WGU = 19 * MiB, WS_WDN = 41 * MiB, WS_WPP = 52 * MiB, WS_WPG = 53 * MiB;
constexpr size_t WGU_STRIDE = (size_t)2 * DFF * D, WDN_STRIDE = (size_t)D * DFF, WPP_STRIDE = (size_t)D * 256, WPG_STRIDE = (size_t)D * D;
constexpr size_t WS_PBF = 58 * MiB, WS_HN = 74 * MiB, WS_O = 106 * MiB, WS_QK = 138 * MiB, WS_VT = 202 * MiB, WS_ACT = 138 * MiB, WS_VT1 = 178 * MiB, WS_HB2 = 186 * MiB, WS_ACT1 = 106 * MiB, WS_PP1 = 218 * MiB, WS_END = 250 * MiB;
constexpr int RING_BYTES = 131072, LDS_BYTES = 135168;

struct Params {
    const float *x, *p; const int* pos;
    const float *norm_mix, *norm_ffn, *norm_ple, *norm_final, *ev_w_in, *ev_b_f, *ev_w_out, *od_w_in, *od_sinks, *od_w_out, *ffn_w_gate, *ffn_w_up, *ffn_w_down, *ple_w_proj, *ple_w_gate;
    float* out; unsigned char* ws; int ph_lo, ph_hi;
};

DI float wave_sum(float v) {
#pragma unroll
    for (int o = 1; o < 64; o <<= 1) v += __shfl_xor(v, o);
    return v;
}

#define XB_TMO      128
#define XB_XCNT(j)  (256  + 64 * (j))
#define XB_XSUB(j)  (1280 + 64 * (j))
#define XB_XGEN(j)  (2304 + 64 * (j))
#define XB_TOP      3328
#define XB_TOPGEN   3392
#define XCD_BAR_WORDS 3456
#define XB_SPIN_CAP (1u << 24)

__device__ __forceinline__ unsigned xb_ld(unsigned* p)              { return __hip_atomic_load(p, __ATOMIC_RELAXED, __HIP_MEMORY_SCOPE_AGENT); }
__device__ __forceinline__ unsigned xb_add(unsigned* p, unsigned v) { return __hip_atomic_fetch_add(p, v, __ATOMIC_RELAXED, __HIP_MEMORY_SCOPE_AGENT); }
__device__ __forceinline__ unsigned xb_xcc_id() { return (unsigned)__builtin_amdgcn_s_getreg((3 << 11) | 20) & 0xFu; }
#define XB_SPIN(cond, bar) do { unsigned _sp = 0; while (cond) { __builtin_amdgcn_s_sleep(1); \
    if ((++_sp & 255u) == 0u) { if (xb_ld(&(bar)[XB_TMO])) break; if (_sp > XB_SPIN_CAP) { atomicAdd(&(bar)[XB_TMO], 1u); break; } } } } while (0)

struct XcdBarrier {
    unsigned* bar; unsigned x;
    volatile LAS unsigned* st;
};

__device__ __forceinline__ XcdBarrier xcd_barrier_post(unsigned* bar, volatile LAS unsigned* st) {
    XcdBarrier b; b.bar = bar; b.x = xb_xcc_id(); b.st = st;
    if (threadIdx.x == 0) (void)xb_add(&bar[XB_XCNT(b.x)], 1u);
    return b;
}
__device__ __forceinline__ void xcd_barrier_complete(unsigned* bar, unsigned x, unsigned& nloc, unsigned& nx) {
    const unsigned G = gridDim.x * gridDim.y * gridDim.z;
    unsigned sum, cnt, mine, sp = 0u;
    for (;;) {
        sum = 0u; cnt = 0u; mine = 0u;
#pragma unroll
        for (unsigned j = 0; j < 16; ++j) { const unsigned c = xb_ld(&bar[XB_XCNT(j)]); sum += c; cnt += (c > 0u) ? 1u : 0u; mine = (j == x) ? c : mine; }
        if (sum == G) break;
        __builtin_amdgcn_s_sleep(1);
        if ((++sp & 255u) == 0u) { if (xb_ld(&bar[XB_TMO])) break; if (sp > XB_SPIN_CAP) { atomicAdd(&bar[XB_TMO], 1u); break; } }
    }
    nloc = mine > 0u ? mine : 1u; nx = cnt > 0u ? cnt : 1u;
}

__device__ __forceinline__ void xcd_barrier(const XcdBarrier& b) {
    asm volatile("s_waitcnt vmcnt(0)" ::: "memory");
    __syncthreads();
    if (threadIdx.x == 0) {
        unsigned* bar = b.bar;
        __builtin_amdgcn_s_waitcnt(0);
        unsigned nloc = b.st[0], nx = b.st[1];
        if (nloc == 0u) { xcd_barrier_complete(bar, b.x, nloc, nx); b.st[0] = nloc; b.st[1] = nx; }
        const unsigned old = xb_add(&bar[XB_XSUB(b.x)], 1u);
        const unsigned gen = old / nloc;
        if (old + 1u == (gen + 1u) * nloc) {
            __builtin_amdgcn_fence(__ATOMIC_RELEASE, "agent");
            asm volatile("s_waitcnt vmcnt(0)" ::: "memory");
            const unsigned og = xb_add(&bar[XB_TOP], 1u);
            const unsigned tg = og / nx;
            if (og + 1u == (tg + 1u) * nx) xb_add(&bar[XB_TOPGEN], 1u);
            else XB_SPIN(xb_ld(&bar[XB_TOPGEN]) == tg, bar);
            __builtin_amdgcn_fence(__ATOMIC_ACQUIRE, "agent");
            xb_add(&bar[XB_XGEN(b.x)], 1u);
            asm volatile("s_waitcnt vmcnt(0)" ::: "memory");
        } else {
            XB_SPIN(xb_ld(&bar[XB_XGEN(b.x)]) == gen, bar);
            __builtin_amdgcn_fence(__ATOMIC_ACQUIRE, "agent");
            asm volatile("s_waitcnt vmcnt(0)" ::: "memory");
        }
    }
    __syncthreads();
}

DI int dest_row(int mode, int n, int row_off) {
    if (mode == 1) return (n >> 7) * 256 + (n & 127) + row_off;
    if (mode == 2 && n < 1280) { const int j = n & 63, jj = j & 31, pos = 8 * (jj >> 2) + (jj & 3) + ((j >> 5) << 2); return (n & ~63) + pos; }
    return n + row_off;
}
struct TJob { const float* W; bf16_t* WT; const float* gk; int ldn, K, ncols, mode, row_off, item; };
DI void transpose_issue(const TJob& j, float (&t)[32], int lane) {
    const int nblk = j.ncols / 32, kb = j.item / nblk, nb = j.item % nblk, k0 = 64 * kb, n0 = 32 * nb;
    const float* Wp = j.W + (size_t)(k0 + (lane >> 5)) * j.ldn + n0 + (lane & 31);
#pragma unroll
    for (int i = 0; i < 32; ++i) t[i] = __builtin_nontemporal_load(Wp + (size_t)(2 * i) * j.ldn);
}
DI void transpose_finish(const TJob& j, const float (&t)[32], LAS float* scr, int lane) {
    const int nblk = j.ncols / 32, kb = j.item / nblk, nb = j.item % nblk, k0 = 64 * kb, n0 = 32 * nb;
    const int c = lane & 7;
    f32x4 g0 = {1.f, 1.f, 1.f, 1.f}, g1 = g0;
    if (j.gk) { g0 = *(const f32x4*)(j.gk + k0 + 8 * c); g1 = *(const f32x4*)(j.gk + k0 + 8 * c + 4); }
#pragma unroll
    for (int i = 0; i < 32; ++i) scr[(2 * i + (lane >> 5)) * 33 + (lane & 31)] = t[i];
    asm volatile("s_waitcnt lgkmcnt(0)" ::: "memory");
#pragma unroll
    for (int q = 0; q < 4; ++q) { const int n = (lane >> 3) + 8 * q; const LAS float* s = scr + (8 * c) * 33 + n;
        u32x4 o; o.x = cvtpk(s[0 * 33] * g0[0], s[1 * 33] * g0[1]); o.y = cvtpk(s[2 * 33] * g0[2], s[3 * 33] * g0[3]); o.z = cvtpk(s[4 * 33] * g1[0], s[5 * 33] * g1[1]); o.w = cvtpk(s[6 * 33] * g1[2], s[7 * 33] * g1[3]);
        *(u32x4*)(j.WT + (size_t)dest_row(j.mode, n0 + n, j.row_off) * j.K + k0 + 8 * c) = o; }
    asm volatile("s_waitcnt lgkmcnt(0)" ::: "memory");
}

DI void rope_entry(int pos, int j, float& c, float& s) {
    const float inv = powf(10000.0f, -(float)j / 32.0f);
    const float angf = (float)pos * inv;
    const double a = (double)angf, kq = rint(a * 0.63661977236758134308);
    double r = fma(-kq, 1.57079632679489655800e+00, a); r = fma(-kq, 6.12323399573676603587e-17, r);
    const int q = ((int)kq) & 3; const double r2 = r * r;
    const double sp = r * (1.0 + r2 * (-1.0 / 6 + r2 * (1.0 / 120 + r2 * (-1.0 / 5040 + r2 * (1.0 / 362880 + r2 * (-1.0 / 39916800 + r2 * (1.0 / 6227020800.0)))))));
    const double cp = 1.0 + r2 * (-0.5 + r2 * (1.0 / 24 + r2 * (-1.0 / 720 + r2 * (1.0 / 40320 + r2 * (-1.0 / 3628800 + r2 * (1.0 / 479001600 + r2 * (-1.0 / 87178291200.0)))))));
    const double cc = (q == 0) ? cp : (q == 1) ? -sp : (q == 2) ? -cp : sp, ss = (q == 0) ? sp : (q == 1) ? cp : (q == 2) ? -sp : -cp;
    c = (float)cc; s = (float)ss;
}

template <bool GATES, bool OUTF32>
DI void norm_phase(const float* src, const float* __restrict__ g, void* dst, LAS unsigned char* lds, const float* __restrict__ w_in0, const float* __restrict__ b_f, float* F, float* tot, int tid, int lane, int wave) {
    LAS float* Wg = (LAS float*)lds; LAS float* lfb = (LAS float*)(lds + 32768);
    if (GATES) { for (int idx = tid; idx < 8192; idx += NTHREADS) Wg[(idx & 7) * 1024 + (idx >> 3)] = w_in0[(size_t)(idx >> 3) * 3080 + 3072 + (idx & 7)]; __syncthreads(); }
    f32x4 gv[4];
#pragma unroll
    for (int j = 0; j < 4; ++j) gv[j] = *(const f32x4*)(g + 4 * lane + 256 * j);
    for (int chunk = blockIdx.x; chunk < M / 64; chunk += gridDim.x) {
        constexpr int RB = OUTF32 ? 2 : 4;
#pragma unroll 1
        for (int rb = 0; rb < 8; rb += RB) {
        f32x4 v[RB][4];
#pragma unroll
        for (int rr = 0; rr < RB; ++rr) { const f32x4* xr = (const f32x4*)(src + (size_t)(chunk * 64 + wave * 8 + rb + rr) * D) + lane;
#pragma unroll
            for (int j = 0; j < 4; ++j) v[rr][j] = GATES ? __builtin_nontemporal_load(xr + 64 * j) : xr[64 * j]; }
#pragma unroll
        for (int rr = 0; rr < RB; ++rr) {
            const int row = chunk * 64 + wave * 8 + rb + rr;
            float ss = 0.f;
#pragma unroll
            for (int j = 0; j < 4; ++j) ss += (v[rr][j][0] * v[rr][j][0] + v[rr][j][1] * v[rr][j][1]) + (v[rr][j][2] * v[rr][j][2] + v[rr][j][3] * v[rr][j][3]);
            const float rstd = 1.0f / sqrtf(wave_sum(ss) * (1.0f / D) + EPS);
#pragma unroll
            for (int j = 0; j < 4; ++j) v[rr][j] = v[rr][j] * rstd * gv[j];
            if (OUTF32) { f32x4* o = (f32x4*)((float*)dst + (size_t)row * D) + lane;
#pragma unroll
                for (int j = 0; j < 4; ++j) o[64 * j] = v[rr][j];
            } else { u32x2* o = (u32x2*)((bf16_t*)dst + (size_t)row * D) + lane;
#pragma unroll
                for (int j = 0; j < 4; ++j) { u32x2 w; w.x = cvtpk(v[rr][j][0], v[rr][j][1]); w.y = cvtpk(v[rr][j][2], v[rr][j][3]); o[64 * j] = w; } }
            if (GATES) {
                float ga[8];
#pragma unroll
                for (int g8 = 0; g8 < 8; ++g8) { float a = 0.f;
#pragma unroll
                    for (int j = 0; j < 4; ++j) { const f32x4 w = *(const LAS f32x4*)(Wg + g8 * 1024 + 256 * j + 4 * lane); a += (w[0] * v[rr][j][0] + w[1] * v[rr][j][1]) + (w[2] * v[rr][j][2] + w[3] * v[rr][j][3]); }
                    ga[g8] = a; }
                const bool b0 = lane & 1, b1 = lane & 2, b2 = lane & 4;
                float k4[4], k2[2], k1;
#pragma unroll
                for (int e = 0; e < 4; ++e) { const float keep = b0 ? ga[4 + e] : ga[e], send = b0 ? ga[e] : ga[4 + e]; k4[e] = keep + __shfl_xor(send, 1); }
#pragma unroll
                for (int e = 0; e < 2; ++e) { const float keep = b1 ? k4[2 + e] : k4[e], send = b1 ? k4[e] : k4[2 + e]; k2[e] = keep + __shfl_xor(send, 2); }
                { const float keep = b2 ? k2[1] : k2[0], send = b2 ? k2[0] : k2[1]; k1 = keep + __shfl_xor(send, 4); }
                k1 += __shfl_xor(k1, 8); k1 += __shfl_xor(k1, 16); k1 += __shfl_xor(k1, 32);
                if (lane < 8) { const int gate = 4 * (lane & 1) + (lane & 2) + ((lane >> 2) & 1); const float x0 = k1 + b_f[gate];
                    lfb[(wave * 8 + rb + rr) * 8 + gate] = fminf(x0, 0.f) - __builtin_amdgcn_logf(1.0f + __builtin_amdgcn_exp2f(-fabsf(x0) * LOG2E)) * 0.6931471805599453f; }
            }
        }
        }
        if (GATES) {
            __syncthreads();
            if (tid < 8) { const int b = chunk >> 7, blk = chunk & 127; float run = 0.f; float* Fp = F + (size_t)(b * 8 + tid) * S + blk * 64;
                for (int r = 0; r < 64; ++r) { run += lfb[r * 8 + tid]; Fp[r] = run; }
                tot[(b * 8 + tid) * 128 + blk] = run; }
            __syncthreads();
        }
    }
}

#ifndef ATT_MINBLK
#define ATT_MINBLK 0
#endif
constexpr int ATT_NS = 13, ATT_KPITCH = 144, ATT_VPITCH = 80, ATT_VOFF = 32 * ATT_KPITCH, ATT_SLOT = ATT_VOFF + 64 * ATT_VPITCH, ATT_FLAGS = ATT_NS * ATT_SLOT;
template <int MODE  >
DI int attn_wg(const bf16_t* __restrict__ QK, const bf16_t* __restrict__ VT, bf16_t* __restrict__ O, const float* __restrict__ F, const unsigned* __restrict__ kstat, const float* __restrict__ sinks,
               int b, int h, int qg, int res_lo, bool first, bool more, bf16x8 (&qfN)[4], float& FqN, LAS unsigned char* lds, int tid, int lane, int wave) {
    constexpr int PITCH = (MODE == 2) ? 1280 : 2048;
    const int n = lane & 31, hh = lane >> 5, qt = qg * 8 + wave, q0 = qt * 32;
    const int qcol = (MODE == 1) ? 1024 + h * 64 : h * 64;
    const int kcol = (MODE == 0) ? 512 + h * 64 : (MODE == 1) ? 1536 + h * 64 : 1024 + (h >> 2) * 64;
    const int vhead = (MODE == 0) ? b * 16 + h : (MODE == 1) ? b * 16 + 8 + h : b * 4 + (h >> 2);
    const int ocol = (MODE == 1) ? 512 + h * 64 : h * 64;
    const size_t rowb = (size_t)b * S;
    const int ksw = (n & 0x13) | ((n & 4) << 1) | ((n & 8) >> 1);
    const bool isK = tid < 256; const int tv = tid - 256;
    const bf16_t* gsrc = isK ? QK + (rowb + (tid >> 3)) * PITCH + kcol + 8 * (tid & 7) : VT + ((size_t)vhead * 64 + (tv >> 2)) * S + 8 * (tv & 3);
    const size_t gstep = isK ? (size_t)32 * PITCH : (size_t)32;
    const int loff = isK ? (tid >> 3) * ATT_KPITCH + (tid & 7) * 16 : ATT_VOFF + (tv >> 2) * ATT_VPITCH + (tv & 3) * 16;
    volatile LAS int* flags = (volatile LAS int*)(lds + ATT_FLAGS);
    __syncthreads();
    if (tid < 8) flags[tid] = 0x7fffffff;
    { bf16x8 t[8];
#pragma unroll
      for (int j = 0; j < 8; ++j) { const int blk = qg * 8 + j; if (blk < res_lo || blk > res_lo + 12) t[j] = *(const bf16x8*)(gsrc + (size_t)blk * gstep); }
#pragma unroll
      for (int j = 0; j < 8; ++j) { const int blk = qg * 8 + j; if (blk < res_lo || blk > res_lo + 12) *(LAS bf16x8*)(lds + (blk % ATT_NS) * ATT_SLOT + loff) = t[j]; } }
    bf16x8 qf[4];
    const float* Fp = (MODE == 0) ? F + (size_t)(b * 8 + h) * S : F;
    { const bf16_t* Qp = QK + (rowb + q0 + n) * PITCH + qcol + 8 * hh;
      if (first) {
#pragma unroll
          for (int c = 0; c < 4; ++c) qfN[c] = *(const bf16x8*)(Qp + 16 * c);
          if (MODE == 0) FqN = Fp[q0 + n]; }
#pragma unroll
      for (int c = 0; c < 4; ++c) qf[c] = qfN[c];
    }
    float m_run = -1e30f, l_run = 0.f, carry = 0.f, cfac = 1.0f, Fq = 0.f, qkb = 0.f, sink2 = 0.f;
    if (MODE == 0) Fq = FqN;
    if (more) { const bf16_t* Qp = QK + (rowb + q0 - 256 + n) * PITCH + qcol + 8 * hh;
#pragma unroll
        for (int c = 0; c < 4; ++c) qfN[c] = *(const bf16x8*)(Qp + 16 * c);
        if (MODE == 0) FqN = Fp[q0 - 256 + n]; }
    if (MODE == 0) {
        float qs = 0.f;
#pragma unroll
        for (int c = 0; c < 4; ++c)
#pragma unroll
            for (int j = 0; j < 8; ++j) { const float v = __builtin_bit_cast(float, ((unsigned)(unsigned short)qf[c][j]) << 16); qs += v * v; }
        qs += __shfl_xor(qs, 32);
        const float kmax2 = __builtin_bit_cast(float, kstat[(b * 8 + h) * 2]) + __builtin_bit_cast(float, kstat[(b * 8 + h) * 2 + 1]);
        qkb = sqrtf(qs * kmax2) * 1.02f + 0.01f;
    }
    if (MODE == 2) { sink2 = sinks[h] * LOG2E; m_run = sink2; }
    f32x16 o0, o1;
#pragma unroll
    for (int r = 0; r < 16; ++r) { o0[r] = 0.f; o1[r] = 0.f; }
    const int kb_lo = (MODE == 2) ? (qt >= 4 ? qt - 4 : 0) : 0;
    constexpr int RATE = (MODE == 2) ? 2 : 1;
    const int nb_lo = (MODE == 2) ? (qg * 8 >= 8 ? qg * 8 - 8 : 0) : 0;
    bool done = false, posted = false;
    int lo_w = qg * 8;
    bf16x8 tn_a[RATE], tn_b[RATE]; f32x4 fkN[4]; float FrN = 0.f;
#define ATT_FLOAD(kb_) do { if (MODE == 0) { const int k0_ = (kb_) * 32; fkN[0] = *(const f32x4*)(Fp + k0_ + 8 * hh); fkN[1] = *(const f32x4*)(Fp + k0_ + 8 * hh + 4); fkN[2] = *(const f32x4*)(Fp + k0_ + 16 + 8 * hh); \
        fkN[3] = *(const f32x4*)(Fp + k0_ + 16 + 8 * hh + 4); FrN = Fp[k0_ > 0 ? k0_ - 1 : 0]; } } while (0)
#pragma unroll
    for (int r = 0; r < RATE; ++r) { const int lb_ = qg * 8 - 1 - r; tn_a[r] = *(const bf16x8*)(gsrc + (size_t)(lb_ >= nb_lo ? lb_ : nb_lo) * gstep); }
    ATT_FLOAD(qt);
    __syncthreads();
#define ATT_STEP(I, TO, TN) { \
        const int nb = qg * 8 - 1 - RATE * (I); \
_Pragma("unroll") \
        for (int r = 0; r < RATE; ++r) { const int lb_ = nb - RATE - r; TN[r] = *(const bf16x8*)(gsrc + (size_t)(lb_ >= nb_lo ? lb_ : nb_lo) * gstep); } \
        const int kb = qt - (I); \
        if (!done && kb < kb_lo) done = true; \
        if (!done) { \
            const LAS unsigned char* sl = lds + (kb % ATT_NS) * ATT_SLOT; \
            bf16x8 kf[4]; f32x4 fk[4]; \
_Pragma("unroll") \
            for (int c = 0; c < 4; ++c) { kf[c] = *(const LAS bf16x8*)(sl + ksw * ATT_KPITCH + c * 32 + hh * 16); fk[c] = fkN[c]; } \
            const LAS unsigned char* vp = sl + ATT_VOFF + n * ATT_VPITCH + hh * 16; \
            const bf16x8 v00 = *(const LAS bf16x8*)(vp), v01 = *(const LAS bf16x8*)(vp + 32), v10 = *(const LAS bf16x8*)(vp + 32 * ATT_VPITCH), v11 = *(const LAS bf16x8*)(vp + 32 * ATT_VPITCH + 32); \
            const float Fr = FrN; \
            ATT_FLOAD(kb > kb_lo ? kb - 1 : kb_lo); \
            f32x16 s; \
_Pragma("unroll") \
            for (int r = 0; r < 16; ++r) s[r] = 0.f; \
_Pragma("unroll") \
            for (int c = 0; c < 4; ++c) s = MFMA32(kf[c], qf[c], s); \
            float p[16]; \
            if (MODE == 0 || MODE == 2) { \
                if (MODE == 0) { \
_Pragma("unroll") \
                    for (int r = 0; r < 16; ++r) p[r] = s[r] + (Fq - fk[r >> 2][r & 3]); \
                } else { \
_Pragma("unroll") \
                    for (int r = 0; r < 16; ++r) p[r] = s[r]; \
                } \
                if (kb == qt) { \
_Pragma("unroll") \
                    for (int r = 0; r < 16; ++r) { const int kl = 16 * (r >> 3) + 8 * hh + (r & 7); if (kl > n) p[r] = -1e30f; } \
                } \
                if (MODE == 2 && kb == qt - 4) { \
_Pragma("unroll") \
                    for (int r = 0; r < 16; ++r) { const int kl = 16 * (r >> 3) + 8 * hh + (r & 7); if (kl <= n) p[r] = -1e30f; } \
                } \
                float mx = p[0]; \
_Pragma("unroll") \
                for (int r = 1; r < 16; ++r) mx = fmaxf(mx, p[r]); \
                mx = fmaxf(mx, __shfl_xor(mx, 32)); \
                const float mnew = fmaxf(m_run, mx), alpha = __builtin_amdgcn_exp2f(m_run - mnew); \
                float ps = 0.f; \
_Pragma("unroll") \
                for (int r = 0; r < 16; ++r) { p[r] = __builtin_amdgcn_exp2f(p[r] - mnew); ps += p[r]; } \
                l_run = l_run * alpha + ps; m_run = mnew; \
                if (!__all(alpha == 1.0f)) { _Pragma("unroll") for (int r = 0; r < 16; ++r) { o0[r] *= alpha; o1[r] *= alpha; } } \
            } else { \
                float om[16], ex[16], T[2]; \
_Pragma("unroll") \
                for (int r = 0; r < 16; ++r) { om[r] = __builtin_amdgcn_rcpf(1.0f + __builtin_amdgcn_exp2f(s[r])); p[r] = 1.0f - om[r]; } \
                if (kb == qt) { \
_Pragma("unroll") \
                    for (int r = 0; r < 16; ++r) { const int kl = 16 * (r >> 3) + 8 * hh + (r & 7); if (kl >= n) { om[r] = 1.0f; p[r] = 0.f; } } \
                } \
_Pragma("unroll") \
                for (int c = 0; c < 2; ++c) { float run = 1.0f; \
_Pragma("unroll") \
                    for (int j = 7; j >= 0; --j) { ex[8 * c + j] = run; run *= om[8 * c + j]; } \
                    T[c] = run; } \
                const float P0 = __shfl_xor(T[0], 32), P1 = __shfl_xor(T[1], 32); \
                const float off0 = cfac * (hh == 0 ? (P0 * T[1] * P1) : (P1 * T[1])), off1 = cfac * (hh == 0 ? P1 : 1.0f); \
_Pragma("unroll") \
                for (int r = 0; r < 16; ++r) p[r] = p[r] * ex[r] * (r < 8 ? off0 : off1); \
                const float tot = (T[0] * T[1]) * (P0 * P1); \
                cfac *= tot; carry += __builtin_amdgcn_logf(tot); \
            } \
            bf16x8 pf0, pf1; \
            { u32x4 w0, w1; w0.x = cvtpk(p[0], p[1]); w0.y = cvtpk(p[2], p[3]); w0.z = cvtpk(p[4], p[5]); w0.w = cvtpk(p[6], p[7]); \
              w1.x = cvtpk(p[8], p[9]); w1.y = cvtpk(p[10], p[11]); w1.z = cvtpk(p[12], p[13]); w1.w = cvtpk(p[14], p[15]); \
              pf0 = __builtin_bit_cast(bf16x8, w0); pf1 = __builtin_bit_cast(bf16x8, w1); } \
            o0 = MFMA32(v00, pf0, o0); o0 = MFMA32(v01, pf1, o0); o1 = MFMA32(v10, pf0, o1); o1 = MFMA32(v11, pf1, o1); \
            if (MODE == 0 && (I) >= ATT_MINBLK) { if (__all((qkb + (Fq - Fr) - m_run) < -152.0f)) done = true; } \
            if (MODE == 1 && (I) >= ATT_MINBLK) { if (__all(carry < -152.0f)) done = true; } \
            if (kb == kb_lo) done = true; \
        } \
        if (done && !posted) { posted = true; if (lane == 0) flags[wave] = (I); } \
_Pragma("unroll") \
        for (int r = 0; r < RATE; ++r) { if (nb - r >= nb_lo) { *(LAS bf16x8*)(lds + ((nb - r) % ATT_NS) * ATT_SLOT + loff) = TO[r]; lo_w = nb - r; }  } \
        __syncthreads(); \
        const int fl = flags[lane & 7]; \
        if (__all(fl <= (I))) break; \
    }
    for (int i2 = 0; ; i2 += 2) {
        ATT_STEP(i2, tn_a, tn_b)
        ATT_STEP(i2 + 1, tn_b, tn_a)
    }
#undef ATT_STEP
    float inv = 1.0f;
    if (MODE == 0 || MODE == 2) { float l = l_run + __shfl_xor(l_run, 32); if (MODE == 2) l += __builtin_amdgcn_exp2f(sink2 - m_run); inv = 1.0f / l; }
    bf16_t* Op = O + (rowb + q0 + n) * D + ocol + 4 * hh;
#pragma unroll
    for (int i = 0; i < 4; ++i) {
        u32x2 w; w.x = cvtpk(o0[4 * i] * inv, o0[4 * i + 1] * inv); w.y = cvtpk(o0[4 * i + 2] * inv, o0[4 * i + 3] * inv); *(u32x2*)(Op + 8 * i) = w;
        u32x2 y; y.x = cvtpk(o1[4 * i] * inv, o1[4 * i + 1] * inv); y.y = cvtpk(o1[4 * i + 2] * inv, o1[4 * i + 3] * inv); *(u32x2*)(Op + 32 + 8 * i) = y;
    }
    return lo_w;
}

#undef ATT_FLOAD
#define REP_P0 0
#define REP_GIN0 0
#define REP_ATT0 0
#define REP_GU 0
#define REP_SWA 0
#define REP_SYNC 0
#define ALIGN1 true
#define ALIGNM true
#define REP_T 0
#define REP_NG 0
#define REP_PR 0
#define REP_GOUT0 0
#define REP_DOWN0 0
#define REP_PG0 0
__global__ void __launch_bounds__(NTHREADS, 2) mk_fwd(Params P) {
    extern __shared__ __attribute__((aligned(16))) unsigned char lds_raw[];
    LAS unsigned char* lds = (LAS unsigned char*)lds_raw;
    cg::grid_group grid = cg::this_grid();
    const int G = gridDim.x, NGW = G * NWAVES, NGT = G * NTHREADS;
    if (threadIdx.x < 32) ((LAS unsigned*)(lds + RING_BYTES))[threadIdx.x] = 0u;
    __syncthreads();
    const XcdBarrier xbar = xcd_barrier_post((unsigned*)(P.ws + WS_BAR), (volatile LAS unsigned*)(lds + RING_BYTES));
    if (P.ph_hi < 0) grid.sync();
#define IDS int tid = threadIdx.x; asm volatile("" : "+v"(tid)); const int lane = tid & 63, wave = __builtin_amdgcn_readfirstlane(tid >> 6), gw = blockIdx.x * NWAVES + wave, gt = blockIdx.x * NTHREADS + tid; (void)gw; (void)gt; (void)lane;
    unsigned char* ws = P.ws;
    unsigned* kstat = (unsigned*)(ws + WS_KSTAT); float* tot = (float*)(ws + WS_TOT); float* ropeC = (float*)(ws + WS_ROPEC); float* ropeS = (float*)(ws + WS_ROPES); float* Fc = (float*)(ws + WS_F);
    bf16_t* Win0 = (bf16_t*)(ws + WS_WIN0); bf16_t* Wout0 = (bf16_t*)(ws + WS_WOUT0); bf16_t* Win1 = (bf16_t*)(ws + WS_WIN1); bf16_t* Wout1 = (bf16_t*)(ws + WS_WOUT1);
    bf16_t* Wgu = (bf16_t*)(ws + WS_WGU); bf16_t* Wdn = (bf16_t*)(ws + WS_WDN); bf16_t* Wpp = (bf16_t*)(ws + WS_WPP); bf16_t* Wpg = (bf16_t*)(ws + WS_WPG);
    bf16_t* pbf = (bf16_t*)(ws + WS_PBF); bf16_t* hn = (bf16_t*)(ws + WS_HN); bf16_t* Ob = (bf16_t*)(ws + WS_O); bf16_t* PP = Ob; bf16_t* QK = (bf16_t*)(ws + WS_QK); bf16_t* VT = (bf16_t*)(ws + WS_VT); bf16_t* ACT = (bf16_t*)(ws + WS_ACT);
    bf16_t* hb2 = (bf16_t*)(ws + WS_HB2); bf16_t* VT1 = (bf16_t*)(ws + WS_VT1); float* ssq = (float*)(ws + WS_SSQ); bf16_t* ACT1 = (bf16_t*)(ws + WS_ACT1); bf16_t* PP1 = (bf16_t*)(ws + WS_PP1);
    float* h = P.out;
    const int lo = P.ph_lo, hi = P.ph_hi;
#define IN(k) (lo <= (k) && (k) < hi)
#define SEAM(k) do { if (IN(k) && IN((k) + 1)) xcd_barrier(xbar); } while (0)
#define GEMM(EpiT, E, A_, B_, N_, K_) do { int k_ = (K_); asm volatile("" : "+s"(k_)); pg8::Gemm g_{A_, B_, M, N_, k_}; pg8::StaticOrder S_; S_.init(M, N_, G, (int)blockIdx.x); pg8::gemm_phase<EpiT, pg8::StaticOrder, ALIGNM, true>(lds, g_, S_, E); } while (0)
#define GEMM1(EpiT, E, A_, B_, N_, K_) do { int k_ = (K_); asm volatile("" : "+s"(k_)); pg8::Gemm g_{A_, B_, M, N_, k_}; pg8::StaticOrder S_; S_.init(M, N_, G, (int)blockIdx.x); pg8::gemm_phase<EpiT, pg8::StaticOrder, ALIGN1, true>(lds, g_, S_, E); } while (0)

#define GEMM_SUB(EpiT, E, A_, B_, N_, K_, c0_) do { const int c0v_ = (c0_); if ((int)blockIdx.x >= c0v_) { int k_ = (K_); asm volatile("" : "+s"(k_)); pg8::Gemm g_{A_, B_, M, N_, k_}; pg8::StaticOrder S_; S_.init(M, N_, G - c0v_, (int)blockIdx.x - c0v_); \
        pg8::gemm_phase<EpiT, pg8::StaticOrder, true, true>(lds, g_, S_, E); } } while (0)
    if (IN(0)) for (int rep_ = 0; rep_ <= REP_P0; ++rep_) { IDS
        if (rep_ > 0) xcd_barrier(xbar);
        if (blockIdx.x == 0 && tid < 32) kstat[tid] = 0u;
        for (int i = gt; i < 6 * M; i += NGT) ssq[i] = 0.f;
        LAS float* scr = (LAS float*)(lds + wave * 16384);
        constexpr int I_IN0 = 16 * 96, I_SQ = 16 * 32, I_IN1 = 16 * 48, I_FF = 16 * 88, I_DN = 44 * 32, I_PP = 4 * 32;
        constexpr int NITEMS = I_IN0 + I_SQ + I_IN1 + I_SQ + 4 * I_FF + 2 * I_DN + 2 * I_PP + 2 * I_SQ;
#define T_DECODE(it_, J) do { int r = (it_); \
            if (r < I_IN0) { J = TJob{P.ev_w_in, Win0, nullptr, 3080, D, 3072, 0, 0, r}; break; } r -= I_IN0; \
            if (r < I_SQ) { J = TJob{P.ev_w_out, Wout0, nullptr, D, D, D, 0, 0, r}; break; } r -= I_SQ; \
            if (r < I_IN1) { J = TJob{P.od_w_in, Win1, P.norm_mix + D, 1536, D, 1536, 2, 0, r}; break; } r -= I_IN1; \
            if (r < I_SQ) { J = TJob{P.od_w_out, Wout1, nullptr, D, D, D, 0, 0, r}; break; } r -= I_SQ; \
            if (r < 4 * I_FF) { const int which = r / I_FF, l = which >> 1, up = which & 1; J = TJob{(up ? P.ffn_w_up : P.ffn_w_gate) + (size_t)l * D * DFF, Wgu + l * WGU_STRIDE, P.norm_ffn + l * D, DFF, D, DFF, 1, up * 128, r % I_FF}; break; } r -= 4 * I_FF; \
            if (r < 2 * I_DN) { const int l = r / I_DN; J = TJob{P.ffn_w_down + (size_t)l * DFF * D, Wdn + l * WDN_STRIDE, nullptr, D, DFF, D, 0, 0, r % I_DN}; break; } r -= 2 * I_DN; \
            if (r < 2 * I_PP) { const int l = r / I_PP; J = TJob{P.ple_w_proj + (size_t)l * 256 * D, Wpp + l * WPP_STRIDE, nullptr, D, 256, D, 0, 0, r % I_PP}; break; } r -= 2 * I_PP; \
            { const int l = r / I_SQ; J = TJob{P.ple_w_gate + (size_t)l * D * D, Wpg + l * WPG_STRIDE, P.norm_ple + l * D, D, D, D, 0, 0, r % I_SQ}; } } while (0)
        for (int rt_ = 0; rt_ <= REP_T; ++rt_)
        {
            float tA[32], tB[32]; TJob jc, jn; int it = gw; bool have = it < NITEMS;
            if (have) { T_DECODE(it, jc); transpose_issue(jc, tA, lane); }
            while (have) {
                const int itn = it + NGW; const bool haven = itn < NITEMS;
                if (haven) { T_DECODE(itn, jn); transpose_issue(jn, tB, lane); }
                transpose_finish(jc, tA, scr, lane);
#pragma unroll
                for (int i = 0; i < 32; ++i) tA[i] = tB[i];
                jc = jn; it = itn; have = haven;
            }
        }
#undef T_DECODE
        for (int rp_ = 0; rp_ <= REP_PR; ++rp_)
        for (int i0 = gt; i0 < 2 * M * 256 / 8; i0 += 4 * NGT) { f32x4 a[4], c[4];
#pragma unroll
            for (int k = 0; k < 4; ++k) { const int i = i0 + k * NGT; if (i < 2 * M * 256 / 8) { a[k] = __builtin_nontemporal_load((const f32x4*)P.p + 2 * i); c[k] = __builtin_nontemporal_load((const f32x4*)P.p + 2 * i + 1); } }
#pragma unroll
            for (int k = 0; k < 4; ++k) { const int i = i0 + k * NGT; if (i < 2 * M * 256 / 8) ((u32x4*)pbf)[i] = pg8::pack8(a[k], c[k]); } }
        for (int i = gt; i < M * 32; i += NGT) { float c, s; rope_entry(P.pos[i >> 5], i & 31, c, s); ropeC[i] = c; ropeS[i] = s; }
        __syncthreads();
        for (int rn_ = 0; rn_ <= REP_NG; ++rn_) norm_phase<true, false>(P.x, P.norm_mix, hn, lds, P.ev_w_in, P.ev_b_f, Fc, tot, tid, lane, wave);
    }
    SEAM(0);
    if (IN(1)) { IDS
        LAS float* offs = (LAS float*)lds;
        for (int item = blockIdx.x; item < 256; item += G) {
            const int bh = item >> 4, part = item & 15;
            if (tid < 128) offs[tid] = tot[bh * 128 + tid];
            __syncthreads();
            if (wave == 0) { const float a = offs[2 * lane], b2 = offs[2 * lane + 1], s2 = a + b2; float inc = s2;
#pragma unroll
                for (int o = 1; o < 64; o <<= 1) { const float t = __shfl_up(inc, o); if (lane >= o) inc += t; }
                const float exc = inc - s2; offs[128 + 2 * lane] = exc; offs[128 + 2 * lane + 1] = exc + a; }
            __syncthreads();
            { const int sidx = part * 512 + tid; float* fp = Fc + (size_t)bh * S + sidx; *fp = (*fp + offs[128 + (sidx >> 6)]) * LOG2E; }
            __syncthreads();
        }
        pg8::EpiL0In E{QK, VT, kstat};
        for (int rep_ = 0; rep_ <= REP_GIN0; ++rep_) GEMM(pg8::EpiL0In, E, hn, Win0, 3072, D);
    }
    SEAM(1);
    if (IN(2)) for (int rep_ = 0; rep_ <= REP_ATT0; ++rep_) { IDS
        if (rep_ > 0) xcd_barrier(xbar);
        for (int ch = blockIdx.x; ch < 2 * 8 * 16; ch += G) {
            const int cc = ch >> 4, b = (ch >> 3) & 1, hd = ch & 7; bf16x8 qfN[4]; float FqN = 0.f; int res = 1 << 28;
            for (int q = 1; q >= 0; --q) res = attn_wg<0>(QK, VT, Ob, Fc, kstat, nullptr, b, hd, 2 * cc + q, res, q == 1, q > 0, qfN, FqN, lds, tid, lane, wave);
            res = 1 << 28;
            for (int q = 1; q >= 0; --q) res = attn_wg<1>(QK, VT, Ob, nullptr, nullptr, nullptr, b, hd, 2 * cc + q, res, q == 1, q > 0, qfN, FqN, lds, tid, lane, wave);
        }
        __syncthreads();
    }
    SEAM(2);
    if (IN(3)) { { pg8::EpiResid<true> E{P.x, nullptr, hn, Fc, 1.0f}; for (int rep_ = 0; rep_ < REP_GOUT0; ++rep_) GEMM1(pg8::EpiResid<true>, E, Ob, Wout0, D, D); }
                 pg8::EpiResid<true> E{P.x, nullptr, hn, ssq, 1.0f}; GEMM1(pg8::EpiResid<true>, E, Ob, Wout0, D, D); }
    SEAM(3);
    if (IN(4)) { { pg8::EpiSwiGLU E{ACT, ssq}; for (int rep_ = 0; rep_ <= REP_GU; ++rep_) GEMM(pg8::EpiSwiGLU, E, hn, Wgu, 2 * DFF, D); }
                 { pg8::EpiStore E{PP, D}; GEMM_SUB(pg8::EpiStore, E, pbf, Wpp, D, 256, (64 * 22) % G); } }
    SEAM(4);
    if (IN(5)) { { pg8::EpiResid<false> E{nullptr, hn, hn, Fc, 0.0f}; for (int rep_ = 0; rep_ < REP_DOWN0; ++rep_) GEMM1(pg8::EpiResid<false>, E, ACT, Wdn, D, DFF); }
                 pg8::EpiResid<false> E{nullptr, hn, hn, ssq + M, 1.0f}; GEMM1(pg8::EpiResid<false>, E, ACT, Wdn, D, DFF); }
    SEAM(5);
    if (IN(6)) { { pg8::EpiPle E{hn, PP, ssq + M, hb2, Fc, 0.0f}; for (int rep_ = 0; rep_ < REP_PG0; ++rep_) GEMM1(pg8::EpiPle, E, hn, Wpg, D, D); }
                 pg8::EpiPle E{hn, PP, ssq + M, hb2, ssq + 2 * M, 1.0f}; GEMM1(pg8::EpiPle, E, hn, Wpg, D, D); }
    SEAM(6);
    if (IN(7)) { { pg8::EpiL1In E{QK, VT1, ropeC, ropeS, ssq + 2 * M}; GEMM(pg8::EpiL1In, E, hb2, Win1, 1536, D); }
                 { pg8::EpiStore E{PP1, D}; GEMM_SUB(pg8::EpiStore, E, pbf + (size_t)M * 256, Wpp + WPP_STRIDE, D, 256, (64 * 6) % G); } }
    SEAM(7);
    if (IN(8)) for (int rep_ = 0; rep_ <= REP_SWA; ++rep_) { IDS
        if (rep_ > 0) xcd_barrier(xbar);
        for (int ch = blockIdx.x; ch < 2 * 16 * 8; ch += G) { const int c = ch >> 5, b = (ch >> 4) & 1, hd = ch & 15; int res = 1 << 28; bf16x8 qfN[4]; float FqN = 0.f;
            for (int q = 3; q >= 0; --q) res = attn_wg<2>(QK, VT1, Ob, nullptr, nullptr, P.od_sinks, b, hd, 4 * c + q, res, q == 3, q > 0, qfN, FqN, lds, tid, lane, wave); }
        __syncthreads();
    }
    SEAM(8);
    if (IN(9)) { pg8::EpiResid<false> E{nullptr, hb2, hn, ssq + 3 * M, 1.0f}; GEMM1(pg8::EpiResid<false>, E, Ob, Wout1, D, D); }
    SEAM(9);
    if (IN(10)) { pg8::EpiSwiGLU E{ACT1, ssq + 3 * M}; GEMM(pg8::EpiSwiGLU, E, hn, Wgu + WGU_STRIDE, 2 * DFF, D); }
    SEAM(10);
    if (IN(11)) { pg8::EpiResid<false> E{nullptr, hn, hn, ssq + 4 * M, 1.0f}; GEMM1(pg8::EpiResid<false>, E, ACT1, Wdn + WDN_STRIDE, D, DFF); }
    SEAM(11);
    if (IN(12)) { pg8::EpiPle E{hn, PP1, ssq + 4 * M, hb2, ssq + 5 * M, 1.0f}; GEMM1(pg8::EpiPle, E, hn, Wpg + WPG_STRIDE, D, D); }
    SEAM(12);
    for (int rep_ = 0; rep_ < REP_SYNC; ++rep_) xcd_barrier(xbar);
    if (IN(13)) { IDS
        f32x4 g4[4];
#pragma unroll
        for (int q = 0; q < 4; ++q) g4[q] = *(const f32x4*)(P.norm_final + 8 * lane + 512 * (q >> 1) + 4 * (q & 1));
        for (int r0 = gw * 8; r0 < M; r0 += NGW * 8) {
            u32x4 w[8][2];
#pragma unroll
            for (int rr = 0; rr < 8; ++rr) { const u32x4* hp = (const u32x4*)(hb2 + (size_t)(r0 + rr) * D) + lane; w[rr][0] = __builtin_nontemporal_load(hp); w[rr][1] = __builtin_nontemporal_load(hp + 64); }
#pragma unroll
            for (int rr = 0; rr < 8; ++rr) { const float rs = pg8::row_rstd(ssq + 5 * M, r0 + rr); f32x4* op = (f32x4*)(h + (size_t)(r0 + rr) * D) + 2 * lane;
#pragma unroll
                for (int q = 0; q < 2; ++q) { const u32x4 x = w[rr][q];
                    const f32x4 a = {pg8::bflo(x.x), pg8::bfhi(x.x), pg8::bflo(x.y), pg8::bfhi(x.y)}, c = {pg8::bflo(x.z), pg8::bfhi(x.z), pg8::bflo(x.w), pg8::bfhi(x.w)};
                    op[128 * q] = a * rs * g4[2 * q]; op[128 * q + 1] = c * rs * g4[2 * q + 1]; } }
        }
    }
#undef IN
#undef SEAM
#undef GEMM
}

#ifndef MK_PER_PHASE
#define MK_PER_PHASE 0
#endif
constexpr int N_PHASES = 14;
extern "C" void kernel_launch(void* const* d_in, const int* in_sizes, int n_in, void* d_out, int out_size, void* d_ws, size_t ws_size, hipStream_t stream) {
    static int grid_blocks = 0;
    if (grid_blocks == 0) {
        if (n_in != 18 || out_size != M * D || ws_size < WS_END) { fprintf(stderr, "kernel_launch: unexpected shapes (n_in %d, out %d, ws %zu)\n", n_in, out_size, ws_size); grid_blocks = -1; return; }
        int dev = 0, cus = 0, per_cu = 0;
        hipGetDevice(&dev); hipDeviceGetAttribute(&cus, hipDeviceAttributeMultiprocessorCount, dev);
        if (hipFuncSetAttribute((const void*)mk_fwd, hipFuncAttributeMaxDynamicSharedMemorySize, LDS_BYTES) != hipSuccess) { fprintf(stderr, "kernel_launch: hipFuncSetAttribute failed\n"); grid_blocks = -1; return; }
        if (hipOccupancyMaxActiveBlocksPerMultiprocessor(&per_cu, (const void*)mk_fwd, NTHREADS, LDS_BYTES) != hipSuccess || per_cu < 1) { fprintf(stderr, "kernel_launch: occupancy query gave %d\n", per_cu); per_cu = 1; (void)hipGetLastError(); }
        grid_blocks = cus * 1;
    }
    if (grid_blocks < 0) return;
#define REP_LAUNCH 0
    for (int pass_ = 0; pass_ <= REP_LAUNCH; ++pass_) {
    if (hipMemsetAsync((char*)d_ws, 0, WS_ZERO_BYTES, stream) != hipSuccess) { fprintf(stderr, "kernel_launch: hipMemsetAsync failed\n"); return; }
    Params p{};
    p.x = (const float*)d_in[0]; p.p = (const float*)d_in[1]; p.pos = (const int*)d_in[2];
    p.norm_mix = (const float*)d_in[3]; p.norm_ffn = (const float*)d_in[4]; p.norm_ple = (const float*)d_in[5]; p.norm_final = (const float*)d_in[6];
    p.ev_w_in = (const float*)d_in[7]; p.ev_b_f = (const float*)d_in[8]; p.ev_w_out = (const float*)d_in[9]; p.od_w_in = (const float*)d_in[10]; p.od_sinks = (const float*)d_in[11]; p.od_w_out = (const float*)d_in[12];
    p.ffn_w_gate = (const float*)d_in[13]; p.ffn_w_up = (const float*)d_in[14]; p.ffn_w_down = (const float*)d_in[15]; p.ple_w_proj = (const float*)d_in[16]; p.ple_w_gate = (const float*)d_in[17];
    p.out = (float*)d_out; p.ws = (unsigned char*)d_ws;
#if MK_PER_PHASE
    for (int ph = 0; ph < N_PHASES; ++ph) {
        p.ph_lo = ph; p.ph_hi = ph + 1;
        void* args[] = {&p};
        hipError_t e = hipLaunchCooperativeKernel((const void*)mk_fwd, dim3(grid_blocks), dim3(NTHREADS), args, LDS_BYTES, stream);
        if (e != hipSuccess) { fprintf(stderr, "cooperative launch (phase %d) failed: %s (grid %d)\n", ph, hipGetErrorString(e), grid_blocks); break; }
    }
#else
    p.ph_lo = 0; p.ph_hi = N_PHASES;
    void* args[] = {&p};
    hipError_t e = hipLaunchCooperativeKernel((const void*)mk_fwd, dim3(grid_blocks), dim3(NTHREADS), args, LDS_BYTES, stream);
    if (e != hipSuccess) fprintf(stderr, "cooperative launch failed: %s (grid %d)\n", hipGetErrorString(e), grid_blocks);
#endif
    }
}
```

```cpp
#include <hip/hip_runtime.h>
#include <hip/hip_cooperative_groups.h>
#include <cstdio>
#include <cstdint>
#include <cmath>
namespace cg = cooperative_groups;
namespace pg8 {
#define PG8_LAS __attribute__((address_space(3)))
typedef unsigned short bf16_t;
typedef short bf16x8 __attribute__((ext_vector_type(8)));
typedef float f32x4 __attribute__((ext_vector_type(4)));
typedef unsigned u32x4 __attribute__((ext_vector_type(4)));
constexpr int BM = 256, BK = 64, HALF = 128, HTB = HALF * BK * 2  , STAGE_BYTES = 8 * HTB, NXCD = 8, WGM = 8;

__host__ __device__ __forceinline__ int lds_byte(int r, int c) { const int st = (r >> 4) * 2 + (c >> 5), rr = r & 15, cc = c & 31, ob = rr * 64 + cc * 2; return st * 1024 + (ob ^ (((ob >> 9) & 1) << 5)); }
__host__ __device__ __forceinline__ void stage_rc(int b, int& R, int& C) { const int st = b / 1024, sb = b % 1024, swz = sb ^ (((sb >> 9) & 1) << 5); R = (st >> 1) * 16 + swz / 64; C = (st & 1) * 32 + (swz % 64) / 2; }
__host__ __device__ __forceinline__ int perm32(int rho) { const int n = rho >> 4, i = rho & 15; return 8 * (i >> 2) + 4 * n + (i & 3); }

struct Unit { int pm, pn; };
struct Gemm { const bf16_t* A; const bf16_t* Bt; int M, N, K; };

struct StaticOrder {
    int nM, nN, nwg, G, c;
    __host__ __device__ void init(int M, int N, int G_, int c_) { nM = M / BM; nN = N / BM; nwg = nM * nN; G = G_; c = c_; }
    __host__ __device__ bool next(int i, Unit& u) const {
        const long L = (long)i * G + c; if (L >= nwg) return false;
        int wgid = (int)L; { const int q = nwg / NXCD, r = nwg % NXCD, xcd = wgid % NXCD, off = wgid / NXCD; wgid = (xcd < r ? xcd * (q + 1) : r * (q + 1) + (xcd - r) * q) + off; }
        const int nig = WGM * nN, gid = wgid / nig, fm = gid * WGM, gsz = (nM - fm) < WGM ? (nM - fm) : WGM;
        u.pm = fm + ((wgid % nig) % gsz); u.pn = (wgid % nig) / gsz; return true;
    }
    __device__ __forceinline__ void a_ready(const Unit&) const {}
    __device__ __forceinline__ void done(const Unit&) const {}
};

typedef float f32x2 __attribute__((ext_vector_type(2)));
typedef __bf16 bf16x2_t __attribute__((ext_vector_type(2)));
typedef unsigned u32x2 __attribute__((ext_vector_type(2)));
__device__ __forceinline__ unsigned cvtpk(float lo, float hi) { f32x2 v = {lo, hi}; bf16x2_t b = __builtin_convertvector(v, bf16x2_t); return __builtin_bit_cast(unsigned, b); }
__device__ __forceinline__ u32x4 pack8(f32x4 a, f32x4 b) { u32x4 w; w.x = cvtpk(a[0], a[1]); w.y = cvtpk(a[2], a[3]); w.z = cvtpk(b[0], b[1]); w.w = cvtpk(b[2], b[3]); return w; }
__device__ __forceinline__ float bflo(unsigned w) { return __builtin_bit_cast(float, w << 16); }
__device__ __forceinline__ float bfhi(unsigned w) { return __builtin_bit_cast(float, w & 0xffff0000u); }
__device__ __forceinline__ float fast_sigmoid(float x) { return __builtin_amdgcn_rcpf(1.0f + __builtin_amdgcn_exp2f(-x * 1.4426950408889634f)); }
__device__ __forceinline__ float row_rstd(const float* ssq, int row) { return __builtin_amdgcn_rsqf(ssq[row] * (1.0f / 1024.0f) + 1e-6f); }
__device__ __forceinline__ void st16_wt(void* p, u32x4 v) { asm volatile("global_store_dwordx4 %0, %1, off sc1\n\ts_nop 1" :: "v"(p), "v"(v) : "memory"); }
#ifndef WT_RESID
#define WT_RESID 0
#endif
#ifndef WT_WIDE
#define WT_WIDE 0
#endif
#ifndef WT_QK
#define WT_QK 0
#endif
#ifndef NT_QK
#define NT_QK 0
#endif
#ifndef NT_ACT
#define NT_ACT 0
#endif
#define EPI_ARGS const f32x4 (&acc)[2][2][4][2], const Unit& u, int wr, int wc, int fr, int fq
#define EPI_FLAGS static constexpr bool PERM = true, AFTER_DRAIN = false;
__device__ __forceinline__ void vt_store8(bf16_t* p, f32x4 a, f32x4 b) {
    const unsigned w0 = cvtpk(a[0], a[1]), w1 = cvtpk(a[2], a[3]), w2 = cvtpk(b[0], b[1]), w3 = cvtpk(b[2], b[3]);
    p[0 * 8192] = (bf16_t)(w0 & 0xffffu); p[1 * 8192] = (bf16_t)(w0 >> 16); p[2 * 8192] = (bf16_t)(w1 & 0xffffu); p[3 * 8192] = (bf16_t)(w1 >> 16);
    p[4 * 8192] = (bf16_t)(w2 & 0xffffu); p[5 * 8192] = (bf16_t)(w2 >> 16); p[6 * 8192] = (bf16_t)(w3 & 0xffffu); p[7 * 8192] = (bf16_t)(w3 >> 16);
}

struct EpiStore {
    EPI_FLAGS
    bf16_t* O; int ldc;
    __device__ __forceinline__ void operator()(EPI_ARGS) const {
        const int row0 = u.pm * BM + wr * 64 + fr, col0 = u.pn * BM + wc * 32 + 8 * fq;
#pragma unroll
        for (int ai = 0; ai < 2; ++ai)
#pragma unroll
            for (int m = 0; m < 4; ++m) { bf16_t* rowp = O + (size_t)(row0 + ai * HALF + m * 16) * ldc + col0;
#pragma unroll
                for (int bj = 0; bj < 2; ++bj) { if (WT_WIDE) st16_wt(rowp + bj * HALF, pack8(acc[ai][bj][m][0], acc[ai][bj][m][1])); else *(u32x4*)(rowp + bj * HALF) = pack8(acc[ai][bj][m][0], acc[ai][bj][m][1]); } }
    }
};

struct EpiL0In {
    EPI_FLAGS
    bf16_t* QK; bf16_t* VT; unsigned* kstat;
    __device__ __forceinline__ void operator()(EPI_ARGS) const {
        const int sec = u.pn >> 1, half = u.pn & 1, row0 = u.pm * BM + wr * 64 + fr, b = u.pm >> 5;
        if (sec == 2 || sec == 5) {
#pragma unroll
            for (int ai = 0; ai < 2; ++ai)
#pragma unroll
                for (int m = 0; m < 4; ++m) { const int s = (row0 + ai * HALF + m * 16) & 8191;
#pragma unroll
                    for (int bj = 0; bj < 2; ++bj) { const int colt = half * 256 + bj * 128 + wc * 32 + 8 * fq, head = (colt >> 6) + (sec == 5 ? 8 : 0), d0 = colt & 63;
                        vt_store8(VT + ((size_t)(b * 16 + head) * 64 + d0) * 8192 + s, acc[ai][bj][m][0], acc[ai][bj][m][1]); } }
        } else {
            const float sc = (sec == 0 || sec == 3) ? 0.125f * 1.4426950408889634f : 1.0f;
            const int cbase = (sec == 0 ? 0 : sec == 1 ? 512 : sec == 3 ? 1024 : 1536) + half * 256 + wc * 32 + 8 * fq;
#pragma unroll
            for (int ai = 0; ai < 2; ++ai)
#pragma unroll
                for (int m = 0; m < 4; ++m) { bf16_t* rowp = QK + (size_t)(row0 + ai * HALF + m * 16) * 2048 + cbase;
#pragma unroll
                    for (int bj = 0; bj < 2; ++bj) { if (NT_QK) __builtin_nontemporal_store(pack8(acc[ai][bj][m][0] * sc, acc[ai][bj][m][1] * sc), (u32x4*)(rowp + bj * HALF)); else *(u32x4*)(rowp + bj * HALF) = pack8(acc[ai][bj][m][0] * sc, acc[ai][bj][m][1] * sc); } }
            if (sec == 1) {
#pragma unroll
                for (int bj = 0; bj < 2; ++bj) { float best = 0.f;
#pragma unroll
                    for (int ai = 0; ai < 2; ++ai)
#pragma unroll
                        for (int m = 0; m < 4; ++m) { const f32x4 a = acc[ai][bj][m][0], c = acc[ai][bj][m][1];
                            float ss = (a[0] * a[0] + a[1] * a[1]) + (a[2] * a[2] + a[3] * a[3]) + (c[0] * c[0] + c[1] * c[1]) + (c[2] * c[2] + c[3] * c[3]);
                            ss += __shfl_xor(ss, 16); ss += __shfl_xor(ss, 32); best = fmaxf(best, ss); }
                    best = fmaxf(best, __shfl_xor(best, 1)); best = fmaxf(best, __shfl_xor(best, 2)); best = fmaxf(best, __shfl_xor(best, 4)); best = fmaxf(best, __shfl_xor(best, 8));
                    if (fr == 0 && fq == 0) atomicMax(kstat + ((b * 8 + half * 4 + bj * 2 + (wc >> 1)) * 2 + (wc & 1)), __builtin_bit_cast(unsigned, best)); }
            }
        }
    }
};

struct EpiL1In {
    EPI_FLAGS
    bf16_t* QKV; bf16_t* VT; const float* ropeC; const float* ropeS; const float* ssq;
    __device__ __forceinline__ void operator()(EPI_ARGS) const {
        int fr_ = fr; asm volatile("" : "+v"(fr_));
        const int row0 = u.pm * BM + wr * 64 + fr_, b = u.pm >> 5;
        float sq[2][4];
#pragma unroll
        for (int ai = 0; ai < 2; ++ai)
#pragma unroll
            for (int m = 0; m < 4; ++m) sq[ai][m] = ssq[row0 + ai * HALF + m * 16];
        if (u.pn == 5) {
            asm volatile("" ::: "memory");
#pragma unroll
            for (int ai = 0; ai < 2; ++ai)
#pragma unroll
                for (int m = 0; m < 4; ++m) { const int s = (row0 + ai * HALF + m * 16) & 8191; const float rs = __builtin_amdgcn_rsqf(sq[ai][m] * (1.0f / 1024.0f) + 1e-6f);
#pragma unroll
                    for (int bj = 0; bj < 2; ++bj) { const int colt = bj * 128 + wc * 32 + 8 * fq, head = colt >> 6, d0 = colt & 63;
                        vt_store8(VT + ((size_t)(b * 4 + head) * 64 + d0) * 8192 + s, acc[ai][bj][m][0] * rs, acc[ai][bj][m][1] * rs); } }
        } else {
            const float sc = (u.pn < 4) ? 0.125f * 1.4426950408889634f : 1.0f;
            const int col0 = u.pn * BM + wc * 32 + 8 * fq, j0 = 4 * ((wc & 1) * 4 + fq);
            f32x4 csv[4], snv[4]; u32x4 outs[4][2];
#pragma unroll
            for (int m = 0; m < 4; ++m) { const int row = row0 + m * 16; csv[m] = *(const f32x4*)(ropeC + (size_t)row * 32 + j0); snv[m] = *(const f32x4*)(ropeS + (size_t)row * 32 + j0); }
#pragma unroll
            for (int ai = 0; ai < 2; ++ai) {
                asm volatile("" ::: "memory");
#pragma unroll
                for (int m = 0; m < 4; ++m) { const float rs = __builtin_amdgcn_rsqf(sq[ai][m] * (1.0f / 1024.0f) + 1e-6f) * sc; const f32x4 cs = csv[m] * rs, sn = snv[m] * rs;
#pragma unroll
                    for (int bj = 0; bj < 2; ++bj) { const f32x4 x1 = acc[ai][bj][m][0], x2 = acc[ai][bj][m][1]; outs[m][bj] = pack8(x1 * cs - x2 * sn, x2 * cs + x1 * sn); } }
                if (ai == 0) {
#pragma unroll
                    for (int m = 0; m < 4; ++m) { const int row = row0 + HALF + m * 16; csv[m] = *(const f32x4*)(ropeC + (size_t)row * 32 + j0); snv[m] = *(const f32x4*)(ropeS + (size_t)row * 32 + j0); } }
                asm volatile("" ::: "memory");
#pragma unroll
                for (int m = 0; m < 4; ++m) { bf16_t* rowp = QKV + (size_t)(row0 + ai * HALF + m * 16) * 1280 + col0;
#pragma unroll
                    for (int bj = 0; bj < 2; ++bj) { if (NT_QK) __builtin_nontemporal_store(outs[m][bj], (u32x4*)(rowp + bj * HALF)); else *(u32x4*)(rowp + bj * HALF) = outs[m][bj]; } }
            }
        }
    }
};

#define EPI_FENCE asm volatile("" ::: "memory")
__device__ __forceinline__ float rstd_of(float ssq_row) { return __builtin_amdgcn_rsqf(ssq_row * (1.0f / 1024.0f) + 1e-6f); }
__device__ __forceinline__ float sumsq8(f32x4 r0, f32x4 r1) { return (r0[0] * r0[0] + r0[1] * r0[1]) + (r0[2] * r0[2] + r0[3] * r0[3]) + (r1[0] * r1[0] + r1[1] * r1[1]) + (r1[2] * r1[2] + r1[3] * r1[3]); }

template <bool BASEF32> struct EpiResid {
    EPI_FLAGS
    const float* basef; const bf16_t* baseb; bf16_t* out; float* ssq; float mul;
    __device__ __forceinline__ void load_group(int g, int row0, int col0, f32x4 (&pf)[2][2][2], u32x4 (&pb)[2][2]) const {
#pragma unroll
        for (int r = 0; r < 2; ++r)
#pragma unroll
            for (int bj = 0; bj < 2; ++bj) { const size_t o = (size_t)(row0 + (g >> 1) * HALF + ((g & 1) * 2 + r) * 16) * 1024 + col0 + bj * HALF;
                if (BASEF32) { const f32x4* bp = (const f32x4*)(basef + o); pf[r][bj][0] = __builtin_nontemporal_load(bp); pf[r][bj][1] = __builtin_nontemporal_load(bp + 1); } else pb[r][bj] = *(const u32x4*)(baseb + o); }
    }
    __device__ __forceinline__ void operator()(EPI_ARGS) const {
        const int row0 = u.pm * BM + wr * 64 + fr, col0 = u.pn * BM + wc * 32 + 8 * fq;
        f32x4 pf[2][2][2]; u32x4 pb[2][2], outs[2][2]; float sums[2];
        load_group(0, row0, col0, pf, pb);
#pragma unroll
        for (int g = 0; g < 4; ++g) { const int ai = g >> 1;
            EPI_FENCE;
#pragma unroll
            for (int r = 0; r < 2; ++r) { const int m = (g & 1) * 2 + r; float ss = 0.f;
#pragma unroll
                for (int bj = 0; bj < 2; ++bj) { f32x4 b0, b1;
                    if (BASEF32) { b0 = pf[r][bj][0]; b1 = pf[r][bj][1]; }
                    else { const u32x4 w = pb[r][bj]; b0 = (f32x4){bflo(w.x), bfhi(w.x), bflo(w.y), bfhi(w.y)}; b1 = (f32x4){bflo(w.z), bfhi(w.z), bflo(w.w), bfhi(w.w)}; }
                    const f32x4 r0 = b0 + acc[ai][bj][m][0] * mul, r1 = b1 + acc[ai][bj][m][1] * mul; outs[r][bj] = pack8(r0, r1); ss += sumsq8(r0, r1); }
                sums[r] = ss; }
            if (g < 3) load_group(g + 1, row0, col0, pf, pb);
            EPI_FENCE;
#pragma unroll
            for (int r = 0; r < 2; ++r) { const int row = row0 + ai * HALF + ((g & 1) * 2 + r) * 16; const size_t off = (size_t)row * 1024 + col0;
#pragma unroll
                for (int bj = 0; bj < 2; ++bj) *(u32x4*)(out + off + bj * HALF) = outs[r][bj];
                float ss = sums[r]; ss += __shfl_xor(ss, 16); ss += __shfl_xor(ss, 32); if (fq == 0) atomicAdd(ssq + row, ss); }
        }
    }
};

struct EpiSwiGLU {
    EPI_FLAGS
    bf16_t* ACT; const float* ssq;
    __device__ __forceinline__ void operator()(EPI_ARGS) const {
        const int row0 = u.pm * BM + wr * 64 + fr, col0 = u.pn * HALF + wc * 32 + 8 * fq;
        float sq[2][4];
#pragma unroll
        for (int ai = 0; ai < 2; ++ai)
#pragma unroll
            for (int m = 0; m < 4; ++m) sq[ai][m] = ssq[row0 + ai * HALF + m * 16];
        EPI_FENCE;
#pragma unroll
        for (int ai = 0; ai < 2; ++ai)
#pragma unroll
            for (int m = 0; m < 4; ++m) { f32x4 r[2]; const float rs = rstd_of(sq[ai][m]);
#pragma unroll
                for (int n = 0; n < 2; ++n) { const f32x4 g = acc[ai][0][m][n] * rs, up = acc[ai][1][m][n] * rs;
#pragma unroll
                    for (int e = 0; e < 4; ++e) r[n][e] = g[e] * fast_sigmoid(g[e]) * up[e]; }
                if (NT_ACT) __builtin_nontemporal_store(pack8(r[0], r[1]), (u32x4*)(ACT + (size_t)(row0 + ai * HALF + m * 16) * 2816 + col0)); else *(u32x4*)(ACT + (size_t)(row0 + ai * HALF + m * 16) * 2816 + col0) = pack8(r[0], r[1]); }
    }
};

struct EpiPle {
    EPI_FLAGS
    const bf16_t* base; const bf16_t* PP; const float* ssq_in; bf16_t* outb; float* ssq_out; float mul;
    __device__ __forceinline__ void load_group(int g, int row0, int col0, u32x4 (&hb)[2][2], u32x4 (&pb)[2][2]) const {
#pragma unroll
        for (int r = 0; r < 2; ++r)
#pragma unroll
            for (int bj = 0; bj < 2; ++bj) { const size_t o = (size_t)(row0 + (g >> 1) * HALF + ((g & 1) * 2 + r) * 16) * 1024 + col0 + bj * HALF; hb[r][bj] = *(const u32x4*)(base + o); pb[r][bj] = *(const u32x4*)(PP + o); }
    }
    __device__ __forceinline__ void operator()(EPI_ARGS) const {
        const int row0 = u.pm * BM + wr * 64 + fr, col0 = u.pn * BM + wc * 32 + 8 * fq;
        float sq[2][4]; u32x4 hb[2][2], pb[2][2], outs[2][2]; float sums[2];
#pragma unroll
        for (int ai = 0; ai < 2; ++ai)
#pragma unroll
            for (int m = 0; m < 4; ++m) sq[ai][m] = ssq_in[row0 + ai * HALF + m * 16];
        load_group(0, row0, col0, hb, pb);
#pragma unroll
        for (int g = 0; g < 4; ++g) { const int ai = g >> 1;
            EPI_FENCE;
#pragma unroll
            for (int r = 0; r < 2; ++r) { const int m = (g & 1) * 2 + r; const float rs = rstd_of(sq[ai][m]); float ss = 0.f;
#pragma unroll
                for (int bj = 0; bj < 2; ++bj) { const u32x4 hw = hb[r][bj], pp = pb[r][bj];
                    const f32x4 h0 = {bflo(hw.x), bfhi(hw.x), bflo(hw.y), bfhi(hw.y)}, h1 = {bflo(hw.z), bfhi(hw.z), bflo(hw.w), bfhi(hw.w)};
                    const f32x4 a0 = acc[ai][bj][m][0] * rs, a1 = acc[ai][bj][m][1] * rs;
                    f32x4 p0 = {bflo(pp.x), bfhi(pp.x), bflo(pp.y), bfhi(pp.y)}, p1 = {bflo(pp.z), bfhi(pp.z), bflo(pp.w), bfhi(pp.w)}, g0, g1;
#pragma unroll
                    for (int e = 0; e < 4; ++e) { g0[e] = fast_sigmoid(a0[e]); g1[e] = fast_sigmoid(a1[e]); }
                    const f32x4 r0 = h0 + g0 * p0 * mul, r1 = h1 + g1 * p1 * mul;
                    outs[r][bj] = pack8(r0, r1); ss += sumsq8(r0, r1); }
                sums[r] = ss; }
            if (g < 3) load_group(g + 1, row0, col0, hb, pb);
            EPI_FENCE;
#pragma unroll
            for (int r = 0; r < 2; ++r) { const int row = row0 + ai * HALF + ((g & 1) * 2 + r) * 16; const size_t off = (size_t)row * 1024 + col0;
#pragma unroll
                for (int bj = 0; bj < 2; ++bj) *(u32x4*)(outb + off + bj * HALF) = outs[r][bj];
                float ss = sums[r]; ss += __shfl_xor(ss, 16); ss += __shfl_xor(ss, 32); if (fq == 0) atomicAdd(ssq_out + row, ss); }
        }
    }
};

template <class Epi, class Sched, bool ALIGN_EPI = false, bool SP2 = false>
__device__ __forceinline__ void gemm_phase(PG8_LAS unsigned char* lds, const Gemm g, const Sched& S, const Epi& E) {
    int tid_ = threadIdx.x; asm volatile("" : "+v"(tid_));
    const int tid = tid_, wid = __builtin_amdgcn_readfirstlane(tid >> 6), lane = tid & 63, wr = wid >> 2, wc = wid & 3, fr = lane & 15, fq = lane >> 4;
    const int K = g.K, nt = K / BK;
    unsigned voffA[2], voffB[2];
#pragma unroll
    for (int i = 0; i < 2; ++i) { int R, C; stage_rc(tid * 16 + i * 8192, R, C); const int Rb = Epi::PERM ? ((R & ~31) + perm32(R & 31)) : R;
        voffA[i] = (unsigned)(R * K + C) * 2u; voffB[i] = (unsigned)(Rb * K + C) * 2u; }
    const size_t kstep = (size_t)(BK * 2);
    const size_t hstep = (size_t)HALF * K * 2;
    const size_t tstep = 2 * hstep;
    const unsigned ldsw = (unsigned)wid * 1024u;
    const int aoff = lds_byte(wr * 64 + fr, fq * 8), boff = lds_byte(wc * 32 + fr, fq * 8);
#define PG8_SA(b, h) (((b) * 2 + (h)) * HTB)
#define PG8_SB(b, h) ((4 + (b) * 2 + (h)) * HTB)
#define PG8_STAGE(bufoff, gbase, voff) do { _Pragma("unroll") for (int _i = 0; _i < 2; ++_i) \
        __builtin_amdgcn_global_load_lds((const unsigned*)((const char*)(gbase) + (voff)[_i]), (PG8_LAS unsigned*)(lds + (bufoff) + ldsw + _i * 8192), 16, 0, 0); } while (0)
#define PG8_LDA(dst, b, h) do { _Pragma("unroll") for (int m = 0; m < 4; ++m) _Pragma("unroll") for (int k = 0; k < 2; ++k) dst[m][k] = *(const PG8_LAS bf16x8*)(lds + PG8_SA(b, h) + aoff + m * 2048 + k * 1024); } while (0)
#define PG8_LDB(dst, b, h) do { _Pragma("unroll") for (int n = 0; n < 2; ++n) _Pragma("unroll") for (int k = 0; k < 2; ++k) dst[n][k] = *(const PG8_LAS bf16x8*)(lds + PG8_SB(b, h) + boff + n * 2048 + k * 1024); } while (0)
#define PG8_MMA(ai, bj, At, Bt) do { __builtin_amdgcn_s_setprio(1); _Pragma("unroll") for (int m = 0; m < 4; ++m) _Pragma("unroll") for (int n = 0; n < 2; ++n) _Pragma("unroll") for (int k = 0; k < 2; ++k) \
        acc[ai][bj][m][n] = __builtin_amdgcn_mfma_f32_16x16x32_bf16(Bt[n][k], At[m][k], acc[ai][bj][m][n], 0, 0, 0); __builtin_amdgcn_s_setprio(0); } while (0)
#define PG8_WAIT_V(n) asm volatile("s_waitcnt vmcnt(" #n ")" ::: "memory")
#define PG8_WAIT_L(n) asm volatile("s_waitcnt lgkmcnt(" #n ")" ::: "memory")
#define PG8_BAR __builtin_amdgcn_s_barrier()
#define PG8_SCHED __builtin_amdgcn_sched_barrier(0)
    Unit cur, nxt; int ui = 0;
    if (!S.next(0, cur)) return;
    f32x4 acc[2][2][4][2];
#pragma unroll
    for (int a = 0; a < 2; ++a)
#pragma unroll
        for (int b = 0; b < 2; ++b)
#pragma unroll
            for (int m = 0; m < 4; ++m)
#pragma unroll
                for (int n = 0; n < 2; ++n) acc[a][b][m][n] = (f32x4){0.f, 0.f, 0.f, 0.f};
    bf16x8 At[4][2], B0[2][2], B1[2][2];
    const char* cA = (const char*)g.A + (size_t)cur.pm * tstep; const char* cB = (const char*)g.Bt + (size_t)cur.pn * tstep;
    S.a_ready(cur);
    if constexpr (SP2) {
        PG8_STAGE(PG8_SB(0, 0), cB, voffB); PG8_STAGE(PG8_SB(0, 1), cB + hstep, voffB); PG8_STAGE(PG8_SA(0, 0), cA, voffA); PG8_STAGE(PG8_SA(0, 1), cA + hstep, voffA);
        if (wr == 1) PG8_BAR;
        PG8_WAIT_V(2); PG8_BAR;
        PG8_STAGE(PG8_SB(1, 0), cB + kstep, voffB); PG8_STAGE(PG8_SA(1, 0), cA + kstep, voffA); PG8_STAGE(PG8_SB(1, 1), cB + hstep + kstep, voffB);
        PG8_WAIT_V(6); PG8_BAR;
    } else {
        PG8_STAGE(PG8_SB(0, 0), cB, voffB); PG8_STAGE(PG8_SA(0, 0), cA, voffA); PG8_STAGE(PG8_SB(0, 1), cB + hstep, voffB); PG8_STAGE(PG8_SA(0, 1), cA + hstep, voffA);
        if (wr == 1) PG8_BAR;
        PG8_WAIT_V(4); PG8_BAR;
        PG8_STAGE(PG8_SB(1, 0), cB + kstep, voffB); PG8_STAGE(PG8_SA(1, 0), cA + kstep, voffA); PG8_STAGE(PG8_SB(1, 1), cB + hstep + kstep, voffB);
        PG8_WAIT_V(6); PG8_BAR;
    }
    for (;;) {
        const bool has_next = S.next(ui + 1, nxt);
        const char* nA = has_next ? (const char*)g.A + (size_t)nxt.pm * tstep : cA; const char* nB = has_next ? (const char*)g.Bt + (size_t)nxt.pn * tstep : cB;
        for (int t = 0; t < nt; t += 2) {
            const bool last = (t == nt - 2);
            const char* a1 = cA + (size_t)(t + 1) * kstep;
            const char* a2 = last ? nA : cA + (size_t)(t + 2) * kstep; const char* b2 = last ? nB : cB + (size_t)(t + 2) * kstep;
            const char* a3 = a2 + kstep; const char* b3 = b2 + kstep;
            if (last && has_next) S.a_ready(nxt);
            if constexpr (SP2) {
            PG8_LDB(B0, 0, 0); PG8_LDB(B1, 0, 1); PG8_SCHED; PG8_LDA(At, 0, 0); PG8_STAGE(PG8_SA(1, 1), a1 + hstep, voffA);
            PG8_WAIT_V(8); PG8_WAIT_L(0); PG8_BAR; PG8_MMA(0, 0, At, B0); PG8_MMA(0, 1, At, B1); PG8_BAR; PG8_SCHED;
            PG8_LDA(At, 0, 1); PG8_STAGE(PG8_SB(0, 0), b2, voffB); PG8_STAGE(PG8_SB(0, 1), b2 + hstep, voffB); PG8_STAGE(PG8_SA(0, 0), a2, voffA);
            PG8_WAIT_V(8); PG8_WAIT_L(0); PG8_BAR; PG8_MMA(1, 0, At, B0); PG8_MMA(1, 1, At, B1); PG8_BAR; PG8_SCHED;
            PG8_LDB(B0, 1, 0); PG8_LDB(B1, 1, 1); PG8_SCHED; PG8_LDA(At, 1, 0); PG8_STAGE(PG8_SA(0, 1), a2 + hstep, voffA);
            PG8_WAIT_V(8); PG8_WAIT_L(0); PG8_BAR; PG8_MMA(0, 0, At, B0); PG8_MMA(0, 1, At, B1); PG8_BAR; PG8_SCHED;
            PG8_LDA(At, 1, 1); PG8_STAGE(PG8_SB(1, 0), b3, voffB); PG8_STAGE(PG8_SB(1, 1), b3 + hstep, voffB); PG8_STAGE(PG8_SA(1, 0), a3, voffA);
            PG8_WAIT_V(8); PG8_WAIT_L(0); PG8_BAR; PG8_MMA(1, 0, At, B0); PG8_MMA(1, 1, At, B1); PG8_BAR; PG8_SCHED;
            } else {
            PG8_LDB(B0, 0, 0); PG8_SCHED; PG8_LDA(At, 0, 0); PG8_STAGE(PG8_SA(1, 1), a1 + hstep, voffA);
            PG8_WAIT_L(8); PG8_BAR; PG8_WAIT_L(0); PG8_MMA(0, 0, At, B0); PG8_BAR; PG8_SCHED;
            PG8_LDB(B1, 0, 1); PG8_STAGE(PG8_SB(0, 0), b2, voffB);
            PG8_BAR; PG8_WAIT_L(0); PG8_MMA(0, 1, At, B1); PG8_BAR;
            PG8_LDA(At, 0, 1); PG8_STAGE(PG8_SA(0, 0), a2, voffA);
            PG8_BAR; PG8_WAIT_L(0); PG8_MMA(1, 0, At, B0); PG8_BAR; PG8_SCHED;
            PG8_STAGE(PG8_SB(0, 1), b2 + hstep, voffB);
            PG8_WAIT_V(6); PG8_BAR; PG8_MMA(1, 1, At, B1); PG8_BAR;
            PG8_LDB(B0, 1, 0); PG8_SCHED; PG8_LDA(At, 1, 0); PG8_STAGE(PG8_SA(0, 1), a2 + hstep, voffA);
            PG8_WAIT_L(8); PG8_BAR; PG8_WAIT_L(0); PG8_MMA(0, 0, At, B0); PG8_BAR; PG8_SCHED;
            PG8_LDB(B1, 1, 1); PG8_STAGE(PG8_SB(1, 0), b3, voffB);
            PG8_BAR; PG8_WAIT_L(0); PG8_MMA(0, 1, At, B1); PG8_BAR;
            PG8_LDA(At, 1, 1); PG8_STAGE(PG8_SA(1, 0), a3, voffA);
            PG8_BAR; PG8_WAIT_L(0); PG8_MMA(1, 0, At, B0); PG8_BAR; PG8_SCHED;
            PG8_STAGE(PG8_SB(1, 1), b3 + hstep, voffB);
            PG8_WAIT_V(6); PG8_BAR; PG8_MMA(1, 1, At, B1); PG8_BAR;
            }
        }
        if constexpr (ALIGN_EPI) { if (wr == 0) PG8_BAR; }
        if constexpr (!Epi::AFTER_DRAIN) { E(acc, cur, wr, wc, fr, fq); S.done(cur); }
        if (!has_next) break;
#pragma unroll
        for (int a = 0; a < 2; ++a)
#pragma unroll
            for (int b = 0; b < 2; ++b)
#pragma unroll
                for (int m = 0; m < 4; ++m)
#pragma unroll
                    for (int n = 0; n < 2; ++n) acc[a][b][m][n] = (f32x4){0.f, 0.f, 0.f, 0.f};
        cur = nxt; cA = nA; cB = nB; ++ui;
        if constexpr (ALIGN_EPI) { if (wr == 1) PG8_BAR; }
    }
    PG8_WAIT_V(0);
    if constexpr (!ALIGN_EPI) { if (wr == 0) PG8_BAR; }
    PG8_BAR;
    if constexpr (Epi::AFTER_DRAIN) { E.fused(acc, cur, wr, wc, fr, fq, lds, wid, lane); S.done(cur); }
#undef PG8_SA
#undef PG8_SB
#undef PG8_STAGE
#undef PG8_LDA
#undef PG8_LDB
#undef PG8_MMA
#undef PG8_WAIT_V
#undef PG8_WAIT_L
#undef PG8_BAR
#undef PG8_SCHED
}
}

using pg8::bf16_t; using pg8::bf16x8; using pg8::f32x4; using pg8::u32x4; using pg8::u32x2; using pg8::cvtpk;
typedef float f32x16 __attribute__((ext_vector_type(16)));
#define LAS __attribute__((address_space(3)))
#define DI __device__ __forceinline__
#define MFMA32(a, b, c) __builtin_amdgcn_mfma_f32_32x32x16_bf16((a), (b), (c), 0, 0, 0)
constexpr float LOG2E = 1.4426950408889634f;
constexpr int M = 16384, S = 8192, D = 1024, DFF = 2816, NWAVES = 8, NTHREADS = 512;
constexpr float EPS = 1e-6f;
constexpr size_t MiB = 1u << 20;
constexpr size_t WS_KSTAT = 0, WS_TOT = 4096, WS_BAR = 16384, WS_SSQ = 65536, WS_ZERO_BYTES = 65536;
constexpr size_t WS_ROPEC = 1 * MiB, WS_ROPES = 3 * MiB;
constexpr size_t WS_F = 5 * MiB;
constexpr size_t WS_WIN0 = 6 * MiB, WS_WOUT0 = 12 * MiB, WS_WIN1 = 14 * MiB, WS_WOUT1 = 17 * MiB, WS_WGU = 19 * MiB, WS_WDN = 41 * MiB, WS_WPP = 52 * MiB, WS_WPG = 53 * MiB;
constexpr size_t WGU_STRIDE = (size_t)2 * DFF * D, WDN_STRIDE = (size_t)D * DFF, WPP_STRIDE = (size_t)D * 256, WPG_STRIDE = (size_t)D * D;
constexpr size_t WS_PBF = 58 * MiB, WS_HN = 74 * MiB, WS_O = 106 * MiB, WS_QK = 138 * MiB, WS_VT = 202 * MiB, WS_ACT = 138 * MiB, WS_VT1 = 178 * MiB, WS_HB2 = 186 * MiB, WS_ACT1 = 106 * MiB, WS_PP1 = 218 * MiB, WS_END = 250 * MiB;
constexpr int RING_BYTES = 131072, LDS_BYTES = 135168;

struct Params {
    const float *x, *p; const int* pos;
    const float *norm_mix, *norm_ffn, *norm_ple, *norm_final, *ev_w_in, *ev_b_f, *ev_w_out, *od_w_in, *od_sinks, *od_w_out, *ffn_w_gate, *ffn_w_up, *ffn_w_down, *ple_w_proj, *ple_w_gate;
    float* out; unsigned char* ws; int ph_lo, ph_hi;
};

DI float wave_sum(float v) {
#pragma unroll
    for (int o = 1; o < 64; o <<= 1) v += __shfl_xor(v, o);
    return v;
}

#define XB_TMO      128
#define XB_XCNT(j)  (256  + 64 * (j))
#define XB_XSUB(j)  (1280 + 64 * (j))
#define XB_XGEN(j)  (2304 + 64 * (j))
#define XB_TOP      3328
#define XB_TOPGEN   3392
#define XCD_BAR_WORDS 3456
#define XB_SPIN_CAP (1u << 24)

__device__ __forceinline__ unsigned xb_ld(unsigned* p)              { return __hip_atomic_load(p, __ATOMIC_RELAXED, __HIP_MEMORY_SCOPE_AGENT); }
__device__ __forceinline__ unsigned xb_add(unsigned* p, unsigned v) { return __hip_atomic_fetch_add(p, v, __ATOMIC_RELAXED, __HIP_MEMORY_SCOPE_AGENT); }
__device__ __forceinline__ unsigned xb_xcc_id() { return (unsigned)__builtin_amdgcn_s_getreg((3 << 11) | 20) & 0xFu; }
#define XB_SPIN(cond, bar) do { unsigned _sp = 0; while (cond) { __builtin_amdgcn_s_sleep(1); \
    if ((++_sp & 255u) == 0u) { if (xb_ld(&(bar)[XB_TMO])) break; if (_sp > XB_SPIN_CAP) { atomicAdd(&(bar)[XB_TMO], 1u); break; } } } } while (0)

struct XcdBarrier {
    unsigned* bar; unsigned x;
    volatile LAS unsigned* st;
};

__device__ __forceinline__ XcdBarrier xcd_barrier_post(unsigned* bar, volatile LAS unsigned* st) {
    XcdBarrier b; b.bar = bar; b.x = xb_xcc_id(); b.st = st;
    if (threadIdx.x == 0) (void)xb_add(&bar[XB_XCNT(b.x)], 1u);
    return b;
}
__device__ __forceinline__ void xcd_barrier_complete(unsigned* bar, unsigned x, unsigned& nloc, unsigned& nx) {
    const unsigned G = gridDim.x * gridDim.y * gridDim.z;
    unsigned sum, cnt, mine, sp = 0u;
    for (;;) {
        sum = 0u; cnt = 0u; mine = 0u;
#pragma unroll
        for (unsigned j = 0; j < 16; ++j) { const unsigned c = xb_ld(&bar[XB_XCNT(j)]); sum += c; cnt += (c > 0u) ? 1u : 0u; mine = (j == x) ? c : mine; }
        if (sum == G) break;
        __builtin_amdgcn_s_sleep(1);
        if ((++sp & 255u) == 0u) { if (xb_ld(&bar[XB_TMO])) break; if (sp > XB_SPIN_CAP) { atomicAdd(&bar[XB_TMO], 1u); break; } }
    }
    nloc = mine > 0u ? mine : 1u; nx = cnt > 0u ? cnt : 1u;
}

__device__ __forceinline__ void xcd_barrier(const XcdBarrier& b) {
    asm volatile("s_waitcnt vmcnt(0)" ::: "memory");
    __syncthreads();
    if (threadIdx.x == 0) {
        unsigned* bar = b.bar;
        __builtin_amdgcn_s_waitcnt(0);
        unsigned nloc = b.st[0], nx = b.st[1];
        if (nloc == 0u) { xcd_barrier_complete(bar, b.x, nloc, nx); b.st[0] = nloc; b.st[1] = nx; }
        const unsigned old = xb_add(&bar[XB_XSUB(b.x)], 1u);
        const unsigned gen = old / nloc;
        if (old + 1u == (gen + 1u) * nloc) {
            __builtin_amdgcn_fence(__ATOMIC_RELEASE, "agent");
            asm volatile("s_waitcnt vmcnt(0)" ::: "memory");
            const unsigned og = xb_add(&bar[XB_TOP], 1u);
            const unsigned tg = og / nx;
            if (og + 1u == (tg + 1u) * nx) xb_add(&bar[XB_TOPGEN], 1u);
            else XB_SPIN(xb_ld(&bar[XB_TOPGEN]) == tg, bar);
            __builtin_amdgcn_fence(__ATOMIC_ACQUIRE, "agent");
            xb_add(&bar[XB_XGEN(b.x)], 1u);
            asm volatile("s_waitcnt vmcnt(0)" ::: "memory");
        } else {
            XB_SPIN(xb_ld(&bar[XB_XGEN(b.x)]) == gen, bar);
            __builtin_amdgcn_fence(__ATOMIC_ACQUIRE, "agent");
            asm volatile("s_waitcnt vmcnt(0)" ::: "memory");
        }
    }
    __syncthreads();
}

DI int dest_row(int mode, int n, int row_off) {
    if (mode == 1) return (n >> 7) * 256 + (n & 127) + row_off;
    if (mode == 2 && n < 1280) { const int j = n & 63, jj = j & 31, pos = 8 * (jj >> 2) + (jj & 3) + ((j >> 5) << 2); return (n & ~63) + pos; }
    return n + row_off;
}
struct TJob { const float* W; bf16_t* WT; const float* gk; int ldn, K, ncols, mode, row_off, item; };
DI void transpose_issue(const TJob& j, float (&t)[32], int lane) {
    const int nblk = j.ncols / 32, kb = j.item / nblk, nb = j.item % nblk, k0 = 64 * kb, n0 = 32 * nb;
    const float* Wp = j.W + (size_t)(k0 + (lane >> 5)) * j.ldn + n0 + (lane & 31);
#pragma unroll
    for (int i = 0; i < 32; ++i) t[i] = __builtin_nontemporal_load(Wp + (size_t)(2 * i) * j.ldn);
}
DI void transpose_finish(const TJob& j, const float (&t)[32], LAS float* scr, int lane) {
    const int nblk = j.ncols / 32, kb = j.item / nblk, nb = j.item % nblk, k0 = 64 * kb, n0 = 32 * nb;
    const int c = lane & 7;
    f32x4 g0 = {1.f, 1.f, 1.f, 1.f}, g1 = g0;
    if (j.gk) { g0 = *(const f32x4*)(j.gk + k0 + 8 * c); g1 = *(const f32x4*)(j.gk + k0 + 8 * c + 4); }
#pragma unroll
    for (int i = 0; i < 32; ++i) scr[(2 * i + (lane >> 5)) * 33 + (lane & 31)] = t[i];
    asm volatile("s_waitcnt lgkmcnt(0)" ::: "memory");
#pragma unroll
    for (int q = 0; q < 4; ++q) { const int n = (lane >> 3) + 8 * q; const LAS float* s = scr + (8 * c) * 33 + n;
        u32x4 o; o.x = cvtpk(s[0 * 33] * g0[0], s[1 * 33] * g0[1]); o.y = cvtpk(s[2 * 33] * g0[2], s[3 * 33] * g0[3]); o.z = cvtpk(s[4 * 33] * g1[0], s[5 * 33] * g1[1]); o.w = cvtpk(s[6 * 33] * g1[2], s[7 * 33] * g1[3]);
        *(u32x4*)(j.WT + (size_t)dest_row(j.mode, n0 + n, j.row_off) * j.K + k0 + 8 * c) = o; }
    asm volatile("s_waitcnt lgkmcnt(0)" ::: "memory");
}

DI void rope_entry(int pos, int j, float& c, float& s) {
    const float inv = powf(10000.0f, -(float)j / 32.0f);
    const float angf = (float)pos * inv;
    const double a = (double)angf, kq = rint(a * 0.63661977236758134308);
    double r = fma(-kq, 1.57079632679489655800e+00, a); r = fma(-kq, 6.12323399573676603587e-17, r);
    const int q = ((int)kq) & 3; const double r2 = r * r;
    const double sp = r * (1.0 + r2 * (-1.0 / 6 + r2 * (1.0 / 120 + r2 * (-1.0 / 5040 + r2 * (1.0 / 362880 + r2 * (-1.0 / 39916800 + r2 * (1.0 / 6227020800.0)))))));
    const double cp = 1.0 + r2 * (-0.5 + r2 * (1.0 / 24 + r2 * (-1.0 / 720 + r2 * (1.0 / 40320 + r2 * (-1.0 / 3628800 + r2 * (1.0 / 479001600 + r2 * (-1.0 / 87178291200.0)))))));
    const double cc = (q == 0) ? cp : (q == 1) ? -sp : (q == 2) ? -cp : sp, ss = (q == 0) ? sp : (q == 1) ? cp : (q == 2) ? -sp : -cp;
    c = (float)cc; s = (float)ss;
}

template <bool GATES, bool OUTF32>
DI void norm_phase(const float* src, const float* __restrict__ g, void* dst, LAS unsigned char* lds, const float* __restrict__ w_in0, const float* __restrict__ b_f, float* F, float* tot, int tid, int lane, int wave) {
    LAS float* Wg = (LAS float*)lds; LAS float* lfb = (LAS float*)(lds + 32768);
    if (GATES) { for (int idx = tid; idx < 8192; idx += NTHREADS) Wg[(idx & 7) * 1024 + (idx >> 3)] = w_in0[(size_t)(idx >> 3) * 3080 + 3072 + (idx & 7)]; __syncthreads(); }
    f32x4 gv[4];
#pragma unroll
    for (int j = 0; j < 4; ++j) gv[j] = *(const f32x4*)(g + 4 * lane + 256 * j);
    for (int chunk = (gridDim.x == 256) ? (((int)blockIdx.x & 7) * 32 + ((int)blockIdx.x >> 3)) : (int)blockIdx.x; chunk < M / 64; chunk += gridDim.x) {
        constexpr int RB = OUTF32 ? 2 : 4;
#pragma unroll 1
        for (int rb = 0; rb < 8; rb += RB) {
        f32x4 v[RB][4];
#pragma unroll
        for (int rr = 0; rr < RB; ++rr) { const f32x4* xr = (const f32x4*)(src + (size_t)(chunk * 64 + wave * 8 + rb + rr) * D) + lane;
#pragma unroll
            for (int j = 0; j < 4; ++j) v[rr][j] = GATES ? __builtin_nontemporal_load(xr + 64 * j) : xr[64 * j]; }
#pragma unroll
        for (int rr = 0; rr < RB; ++rr) {
            const int row = chunk * 64 + wave * 8 + rb + rr;
            float ss = 0.f;
#pragma unroll
            for (int j = 0; j < 4; ++j) ss += (v[rr][j][0] * v[rr][j][0] + v[rr][j][1] * v[rr][j][1]) + (v[rr][j][2] * v[rr][j][2] + v[rr][j][3] * v[rr][j][3]);
            const float rstd = 1.0f / sqrtf(wave_sum(ss) * (1.0f / D) + EPS);
#pragma unroll
            for (int j = 0; j < 4; ++j) v[rr][j] = v[rr][j] * rstd * gv[j];
            if (OUTF32) { f32x4* o = (f32x4*)((float*)dst + (size_t)row * D) + lane;
#pragma unroll
                for (int j = 0; j < 4; ++j) o[64 * j] = v[rr][j];
            } else { u32x2* o = (u32x2*)((bf16_t*)dst + (size_t)row * D) + lane;
#pragma unroll
                for (int j = 0; j < 4; ++j) { u32x2 w; w.x = cvtpk(v[rr][j][0], v[rr][j][1]); w.y = cvtpk(v[rr][j][2], v[rr][j][3]); o[64 * j] = w; } }
            if (GATES) {
                float ga[8];
#pragma unroll
                for (int g8 = 0; g8 < 8; ++g8) { float a = 0.f;
#pragma unroll
                    for (int j = 0; j < 4; ++j) { const f32x4 w = *(const LAS f32x4*)(Wg + g8 * 1024 + 256 * j + 4 * lane); a += (w[0] * v[rr][j][0] + w[1] * v[rr][j][1]) + (w[2] * v[rr][j][2] + w[3] * v[rr][j][3]); }
                    ga[g8] = a; }
                const bool b0 = lane & 1, b1 = lane & 2, b2 = lane & 4;
                float k4[4], k2[2], k1;
#pragma unroll
                for (int e = 0; e < 4; ++e) { const float keep = b0 ? ga[4 + e] : ga[e], send = b0 ? ga[e] : ga[4 + e]; k4[e] = keep + __shfl_xor(send, 1); }
#pragma unroll
                for (int e = 0; e < 2; ++e) { const float keep = b1 ? k4[2 + e] : k4[e], send = b1 ? k4[e] : k4[2 + e]; k2[e] = keep + __shfl_xor(send, 2); }
                { const float keep = b2 ? k2[1] : k2[0], send = b2 ? k2[0] : k2[1]; k1 = keep + __shfl_xor(send, 4); }
                k1 += __shfl_xor(k1, 8); k1 += __shfl_xor(k1, 16); k1 += __shfl_xor(k1, 32);
                if (lane < 8) { const int gate = 4 * (lane & 1) + (lane & 2) + ((lane >> 2) & 1); const float x0 = k1 + b_f[gate];
                    lfb[(wave * 8 + rb + rr) * 8 + gate] = fminf(x0, 0.f) - __builtin_amdgcn_logf(1.0f + __builtin_amdgcn_exp2f(-fabsf(x0) * LOG2E)) * 0.6931471805599453f; }
            }
        }
        }
        if (GATES) {
            __syncthreads();
            if (tid < 8) { const int b = chunk >> 7, blk = chunk & 127; float run = 0.f; float* Fp = F + (size_t)(b * 8 + tid) * S + blk * 64;
                for (int r = 0; r < 64; ++r) { run += lfb[r * 8 + tid]; Fp[r] = run; }
                tot[(b * 8 + tid) * 128 + blk] = run; }
            __syncthreads();
        }
    }
}

#ifndef ATT_MINBLK
#define ATT_MINBLK 0
#endif
constexpr int ATT_NS = 13, ATT_KPITCH = 144, ATT_VPITCH = 80, ATT_VOFF = 32 * ATT_KPITCH, ATT_SLOT = ATT_VOFF + 64 * ATT_VPITCH, ATT_FLAGS = ATT_NS * ATT_SLOT;
template <int MODE  >
DI int attn_wg(const bf16_t* __restrict__ QK, const bf16_t* __restrict__ VT, bf16_t* __restrict__ O, const float* __restrict__ F, const unsigned* __restrict__ kstat, const float* __restrict__ sinks,
               int b, int h, int qg, int res_lo, bool first, bool more, bf16x8 (&qfN)[4], float& FqN, LAS unsigned char* lds, int tid, int lane, int wave) {
    constexpr int PITCH = (MODE == 2) ? 1280 : 2048;
    const int n = lane & 31, hh = lane >> 5, qt = qg * 8 + wave, q0 = qt * 32;
    const int qcol = (MODE == 1) ? 1024 + h * 64 : h * 64;
    const int kcol = (MODE == 0) ? 512 + h * 64 : (MODE == 1) ? 1536 + h * 64 : 1024 + (h >> 2) * 64;
    const int vhead = (MODE == 0) ? b * 16 + h : (MODE == 1) ? b * 16 + 8 + h : b * 4 + (h >> 2);
    const int ocol = (MODE == 1) ? 512 + h * 64 : h * 64;
    const size_t rowb = (size_t)b * S;
    const int ksw = (n & 0x13) | ((n & 4) << 1) | ((n & 8) >> 1);
    const bool isK = tid < 256; const int tv = tid - 256;
    const bf16_t* gsrc = isK ? QK + (rowb + (tid >> 3)) * PITCH + kcol + 8 * (tid & 7) : VT + ((size_t)vhead * 64 + (tv >> 2)) * S + 8 * (tv & 3);
    const size_t gstep = isK ? (size_t)32 * PITCH : (size_t)32;
    const int loff = isK ? (tid >> 3) * ATT_KPITCH + (tid & 7) * 16 : ATT_VOFF + (tv >> 2) * ATT_VPITCH + (tv & 3) * 16;
    volatile LAS int* flags = (volatile LAS int*)(lds + ATT_FLAGS);
    __syncthreads();
    if (tid < 8) flags[tid] = 0x7fffffff;
    { bf16x8 t[8];
#pragma unroll
      for (int j = 0; j < 8; ++j) { const int blk = qg * 8 + j; if (blk < res_lo || blk > res_lo + 12) t[j] = *(const bf16x8*)(gsrc + (size_t)blk * gstep); }
#pragma unroll
      for (int j = 0; j < 8; ++j) { const int blk = qg * 8 + j; if (blk < res_lo || blk > res_lo + 12) *(LAS bf16x8*)(lds + (blk % ATT_NS) * ATT_SLOT + loff) = t[j]; } }
    bf16x8 qf[4];
    const float* Fp = (MODE == 0) ? F + (size_t)(b * 8 + h) * S : F;
    { const bf16_t* Qp = QK + (rowb + q0 + n) * PITCH + qcol + 8 * hh;
      if (first) {
#pragma unroll
          for (int c = 0; c < 4; ++c) qfN[c] = *(const bf16x8*)(Qp + 16 * c);
          if (MODE == 0) FqN = Fp[q0 + n]; }
#pragma unroll
      for (int c = 0; c < 4; ++c) qf[c] = qfN[c];
    }
    float m_run = -1e30f, l_run = 0.f, carry = 0.f, cfac = 1.0f, Fq = 0.f, qkb = 0.f, sink2 = 0.f;
    if (MODE == 0) Fq = FqN;
    if (more) { const bf16_t* Qp = QK + (rowb + q0 - 256 + n) * PITCH + qcol + 8 * hh;
#pragma unroll
        for (int c = 0; c < 4; ++c) qfN[c] = *(const bf16x8*)(Qp + 16 * c);
        if (MODE == 0) FqN = Fp[q0 - 256 + n]; }
    if (MODE == 0) {
        float qs = 0.f;
#pragma unroll
        for (int c = 0; c < 4; ++c)
#pragma unroll
            for (int j = 0; j < 8; ++j) { const float v = __builtin_bit_cast(float, ((unsigned)(unsigned short)qf[c][j]) << 16); qs += v * v; }
        qs += __shfl_xor(qs, 32);
        const float kmax2 = __builtin_bit_cast(float, kstat[(b * 8 + h) * 2]) + __builtin_bit_cast(float, kstat[(b * 8 + h) * 2 + 1]);
        qkb = sqrtf(qs * kmax2) * 1.02f + 0.01f;
    }
    if (MODE == 2) { sink2 = sinks[h] * LOG2E; m_run = sink2; }
    f32x16 o0, o1;
#pragma unroll
    for (int r = 0; r < 16; ++r) { o0[r] = 0.f; o1[r] = 0.f; }
    const int kb_lo = (MODE == 2) ? (qt >= 4 ? qt - 4 : 0) : 0;
    constexpr int RATE = (MODE == 2) ? 2 : 1;
    const int nb_lo = (MODE == 2) ? (qg * 8 >= 8 ? qg * 8 - 8 : 0) : 0;
    bool done = false, posted = false;
    int lo_w = qg * 8;
    bf16x8 tn_a[RATE], tn_b[RATE]; f32x4 fkN[4]; float FrN = 0.f;
#define ATT_FLOAD(kb_) do { if (MODE == 0) { const int k0_ = (kb_) * 32; fkN[0] = *(const f32x4*)(Fp + k0_ + 8 * hh); fkN[1] = *(const f32x4*)(Fp + k0_ + 8 * hh + 4); fkN[2] = *(const f32x4*)(Fp + k0_ + 16 + 8 * hh); \
        fkN[3] = *(const f32x4*)(Fp + k0_ + 16 + 8 * hh + 4); FrN = Fp[k0_ > 0 ? k0_ - 1 : 0]; } } while (0)
#pragma unroll
    for (int r = 0; r < RATE; ++r) { const int lb_ = qg * 8 - 1 - r; tn_a[r] = *(const bf16x8*)(gsrc + (size_t)(lb_ >= nb_lo ? lb_ : nb_lo) * gstep); }
    ATT_FLOAD(qt);
    __syncthreads();
#define ATT_STEP(I, TO, TN) { \
        const int nb = qg * 8 - 1 - RATE * (I); \
_Pragma("unroll") \
        for (int r = 0; r < RATE; ++r) { const int lb_ = nb - RATE - r; TN[r] = *(const bf16x8*)(gsrc + (size_t)(lb_ >= nb_lo ? lb_ : nb_lo) * gstep); } \
        const int kb = qt - (I); \
        if (!done && kb < kb_lo) done = true; \
        if (!done) { \
            const LAS unsigned char* sl = lds + (kb % ATT_NS) * ATT_SLOT; \
            bf16x8 kf[4]; f32x4 fk[4]; \
_Pragma("unroll") \
            for (int c = 0; c < 4; ++c) { kf[c] = *(const LAS bf16x8*)(sl + ksw * ATT_KPITCH + c * 32 + hh * 16); fk[c] = fkN[c]; } \
            const LAS unsigned char* vp = sl + ATT_VOFF + n * ATT_VPITCH + hh * 16; \
            const bf16x8 v00 = *(const LAS bf16x8*)(vp), v01 = *(const LAS bf16x8*)(vp + 32), v10 = *(const LAS bf16x8*)(vp + 32 * ATT_VPITCH), v11 = *(const LAS bf16x8*)(vp + 32 * ATT_VPITCH + 32); \
            const float Fr = FrN; \
            ATT_FLOAD(kb > kb_lo ? kb - 1 : kb_lo); \
            f32x16 s; \
_Pragma("unroll") \
            for (int r = 0; r < 16; ++r) s[r] = 0.f; \
_Pragma("unroll") \
            for (int c = 0; c < 4; ++c) s = MFMA32(kf[c], qf[c], s); \
            float p[16]; \
            if (MODE == 0 || MODE == 2) { \
                if (MODE == 0) { \
_Pragma("unroll") \
                    for (int r = 0; r < 16; ++r) p[r] = s[r] + (Fq - fk[r >> 2][r & 3]); \
                } else { \
_Pragma("unroll") \
                    for (int r = 0; r < 16; ++r) p[r] = s[r]; \
                } \
                if (kb == qt) { \
_Pragma("unroll") \
                    for (int r = 0; r < 16; ++r) { const int kl = 16 * (r >> 3) + 8 * hh + (r & 7); if (kl > n) p[r] = -1e30f; } \
                } \
                if (MODE == 2 && kb == qt - 4) { \
_Pragma("unroll") \
                    for (int r = 0; r < 16; ++r) { const int kl = 16 * (r >> 3) + 8 * hh + (r & 7); if (kl <= n) p[r] = -1e30f; } \
                } \
                float mx = p[0]; \
_Pragma("unroll") \
                for (int r = 1; r < 16; ++r) mx = fmaxf(mx, p[r]); \
                mx = fmaxf(mx, __shfl_xor(mx, 32)); \
                const float mnew = fmaxf(m_run, mx), alpha = __builtin_amdgcn_exp2f(m_run - mnew); \
                float ps = 0.f; \
_Pragma("unroll") \
                for (int r = 0; r < 16; ++r) { p[r] = __builtin_amdgcn_exp2f(p[r] - mnew); ps += p[r]; } \
                l_run = l_run * alpha + ps; m_run = mnew; \
                if (!__all(alpha == 1.0f)) { _Pragma("unroll") for (int r = 0; r < 16; ++r) { o0[r] *= alpha; o1[r] *= alpha; } } \
            } else { \
                float om[16], ex[16], T[2]; \
_Pragma("unroll") \
                for (int r = 0; r < 16; ++r) { om[r] = __builtin_amdgcn_rcpf(1.0f + __builtin_amdgcn_exp2f(s[r])); p[r] = 1.0f - om[r]; } \
                if (kb == qt) { \
_Pragma("unroll") \
                    for (int r = 0; r < 16; ++r) { const int kl = 16 * (r >> 3) + 8 * hh + (r & 7); if (kl >= n) { om[r] = 1.0f; p[r] = 0.f; } } \
                } \
_Pragma("unroll") \
                for (int c = 0; c < 2; ++c) { float run = 1.0f; \
_Pragma("unroll") \
                    for (int j = 7; j >= 0; --j) { ex[8 * c + j] = run; run *= om[8 * c + j]; } \
                    T[c] = run; } \
                const float P0 = __shfl_xor(T[0], 32), P1 = __shfl_xor(T[1], 32); \
                const float off0 = cfac * (hh == 0 ? (P0 * T[1] * P1) : (P1 * T[1])), off1 = cfac * (hh == 0 ? P1 : 1.0f); \
_Pragma("unroll") \
                for (int r = 0; r < 16; ++r) p[r] = p[r] * ex[r] * (r < 8 ? off0 : off1); \
                const float tot = (T[0] * T[1]) * (P0 * P1); \
                cfac *= tot; carry += __builtin_amdgcn_logf(tot); \
            } \
            bf16x8 pf0, pf1; \
            { u32x4 w0, w1; w0.x = cvtpk(p[0], p[1]); w0.y = cvtpk(p[2], p[3]); w0.z = cvtpk(p[4], p[5]); w0.w = cvtpk(p[6], p[7]); \
              w1.x = cvtpk(p[8], p[9]); w1.y = cvtpk(p[10], p[11]); w1.z = cvtpk(p[12], p[13]); w1.w = cvtpk(p[14], p[15]); \
              pf0 = __builtin_bit_cast(bf16x8, w0); pf1 = __builtin_bit_cast(bf16x8, w1); } \
            o0 = MFMA32(v00, pf0, o0); o0 = MFMA32(v01, pf1, o0); o1 = MFMA32(v10, pf0, o1); o1 = MFMA32(v11, pf1, o1); \
            if (MODE == 0 && (I) >= ATT_MINBLK) { if (__all((qkb + (Fq - Fr) - m_run) < -152.0f)) done = true; } \
            if (MODE == 1 && (I) >= ATT_MINBLK) { if (__all(carry < -152.0f)) done = true; } \
            if (kb == kb_lo) done = true; \
        } \
        if (done && !posted) { posted = true; if (lane == 0) flags[wave] = (I); } \
_Pragma("unroll") \
        for (int r = 0; r < RATE; ++r) { if (nb - r >= nb_lo) { *(LAS bf16x8*)(lds + ((nb - r) % ATT_NS) * ATT_SLOT + loff) = TO[r]; lo_w = nb - r; }  } \
        __syncthreads(); \
        const int fl = flags[lane & 7]; \
        if (__all(fl <= (I))) break; \
    }
    for (int i2 = 0; ; i2 += 2) {
        ATT_STEP(i2, tn_a, tn_b)
        ATT_STEP(i2 + 1, tn_b, tn_a)
    }
#undef ATT_STEP
    float inv = 1.0f;
    if (MODE == 0 || MODE == 2) { float l = l_run + __shfl_xor(l_run, 32); if (MODE == 2) l += __builtin_amdgcn_exp2f(sink2 - m_run); inv = 1.0f / l; }
    bf16_t* Op = O + (rowb + q0 + n) * D + ocol + 4 * hh;
#pragma unroll
    for (int i = 0; i < 4; ++i) {
        u32x2 w; w.x = cvtpk(o0[4 * i] * inv, o0[4 * i + 1] * inv); w.y = cvtpk(o0[4 * i + 2] * inv, o0[4 * i + 3] * inv); *(u32x2*)(Op + 8 * i) = w;
        u32x2 y; y.x = cvtpk(o1[4 * i] * inv, o1[4 * i + 1] * inv); y.y = cvtpk(o1[4 * i + 2] * inv, o1[4 * i + 3] * inv); *(u32x2*)(Op + 32 + 8 * i) = y;
    }
    return lo_w;
}

#undef ATT_FLOAD
#define REP_P0 0
#define REP_GIN0 0
#define REP_ATT0 0
#define REP_GU 0
#define REP_SWA 0
#define REP_SYNC 0
#define ALIGN1 true
#define ALIGNM true
#define REP_T 0
#define REP_NG 0
#define REP_PR 0
#define REP_GOUT0 0
#define REP_DOWN0 0
#define REP_PG0 0
__global__ void __launch_bounds__(NTHREADS, 2) mk_fwd(Params P) {
    extern __shared__ __attribute__((aligned(16))) unsigned char lds_raw[];
    LAS unsigned char* lds = (LAS unsigned char*)lds_raw;
    cg::grid_group grid = cg::this_grid();
    const int G = gridDim.x, NGW = G * NWAVES, NGT = G * NTHREADS;
    if (threadIdx.x < 32) ((LAS unsigned*)(lds + RING_BYTES))[threadIdx.x] = 0u;
    __syncthreads();
    const XcdBarrier xbar = xcd_barrier_post((unsigned*)(P.ws + WS_BAR), (volatile LAS unsigned*)(lds + RING_BYTES));
    if (P.ph_hi < 0) grid.sync();
#define IDS int tid = threadIdx.x; asm volatile("" : "+v"(tid)); const int lane = tid & 63, wave = __builtin_amdgcn_readfirstlane(tid >> 6), gw = blockIdx.x * NWAVES + wave, gt = blockIdx.x * NTHREADS + tid; (void)gw; (void)gt; (void)lane;
    unsigned char* ws = P.ws;
    unsigned* kstat = (unsigned*)(ws + WS_KSTAT); float* tot = (float*)(ws + WS_TOT); float* ropeC = (float*)(ws + WS_ROPEC); float* ropeS = (float*)(ws + WS_ROPES); float* Fc = (float*)(ws + WS_F);
    bf16_t* Win0 = (bf16_t*)(ws + WS_WIN0); bf16_t* Wout0 = (bf16_t*)(ws + WS_WOUT0); bf16_t* Win1 = (bf16_t*)(ws + WS_WIN1); bf16_t* Wout1 = (bf16_t*)(ws + WS_WOUT1);
    bf16_t* Wgu = (bf16_t*)(ws + WS_WGU); bf16_t* Wdn = (bf16_t*)(ws + WS_WDN); bf16_t* Wpp = (bf16_t*)(ws + WS_WPP); bf16_t* Wpg = (bf16_t*)(ws + WS_WPG);
    bf16_t* pbf = (bf16_t*)(ws + WS_PBF); bf16_t* hn = (bf16_t*)(ws + WS_HN); bf16_t* Ob = (bf16_t*)(ws + WS_O); bf16_t* PP = Ob; bf16_t* QK = (bf16_t*)(ws + WS_QK); bf16_t* VT = (bf16_t*)(ws + WS_VT); bf16_t* ACT = (bf16_t*)(ws + WS_ACT);
    bf16_t* hb2 = (bf16_t*)(ws + WS_HB2); bf16_t* VT1 = (bf16_t*)(ws + WS_VT1); float* ssq = (float*)(ws + WS_SSQ); bf16_t* ACT1 = (bf16_t*)(ws + WS_ACT1); bf16_t* PP1 = (bf16_t*)(ws + WS_PP1);
    float* h = P.out;
    const int lo = P.ph_lo, hi = P.ph_hi;
#define IN(k) (lo <= (k) && (k) < hi)
#define SEAM(k) do { if (IN(k) && IN((k) + 1)) xcd_barrier(xbar); } while (0)
#define GEMM(EpiT, E, A_, B_, N_, K_) do { int k_ = (K_); asm volatile("" : "+s"(k_)); pg8::Gemm g_{A_, B_, M, N_, k_}; pg8::StaticOrder S_; S_.init(M, N_, G, (int)blockIdx.x); pg8::gemm_phase<EpiT, pg8::StaticOrder, ALIGNM, true>(lds, g_, S_, E); } while (0)
#define GEMM1(EpiT, E, A_, B_, N_, K_) do { int k_ = (K_); asm volatile("" : "+s"(k_)); pg8::Gemm g_{A_, B_, M, N_, k_}; pg8::StaticOrder S_; S_.init(M, N_, G, (int)blockIdx.x); pg8::gemm_phase<EpiT, pg8::StaticOrder, ALIGN1, true>(lds, g_, S_, E); } while (0)

#define GEMM_SUB(EpiT, E, A_, B_, N_, K_, c0_) do { const int c0v_ = (c0_); if ((int)blockIdx.x >= c0v_) { int k_ = (K_); asm volatile("" : "+s"(k_)); pg8::Gemm g_{A_, B_, M, N_, k_}; pg8::StaticOrder S_; S_.init(M, N_, G - c0v_, (int)blockIdx.x - c0v_); \
        pg8::gemm_phase<EpiT, pg8::StaticOrder, true, true>(lds, g_, S_, E); } } while (0)
    if (IN(0)) for (int rep_ = 0; rep_ <= REP_P0; ++rep_) { IDS
        if (rep_ > 0) xcd_barrier(xbar);
        if (blockIdx.x == 0 && tid < 32) kstat[tid] = 0u;
        for (int i = gt; i < 6 * M; i += NGT) ssq[i] = 0.f;
        LAS float* scr = (LAS float*)(lds + wave * 16384);
        constexpr int I_IN0 = 16 * 96, I_SQ = 16 * 32, I_IN1 = 16 * 48, I_FF = 16 * 88, I_DN = 44 * 32, I_PP = 4 * 32;
        constexpr int NITEMS = I_IN0 + I_SQ + I_IN1 + I_SQ + 4 * I_FF + 2 * I_DN + 2 * I_PP + 2 * I_SQ;
#define T_DECODE(it_, J) do { int r = (it_); \
            if (r < I_IN0) { J = TJob{P.ev_w_in, Win0, nullptr, 3080, D, 3072, 0, 0, r}; break; } r -= I_IN0; \
            if (r < I_SQ) { J = TJob{P.ev_w_out, Wout0, nullptr, D, D, D, 0, 0, r}; break; } r -= I_SQ; \
            if (r < I_IN1) { J = TJob{P.od_w_in, Win1, P.norm_mix + D, 1536, D, 1536, 2, 0, r}; break; } r -= I_IN1; \
            if (r < I_SQ) { J = TJob{P.od_w_out, Wout1, nullptr, D, D, D, 0, 0, r}; break; } r -= I_SQ; \
            if (r < 4 * I_FF) { const int which = r / I_FF, l = which >> 1, up = which & 1; J = TJob{(up ? P.ffn_w_up : P.ffn_w_gate) + (size_t)l * D * DFF, Wgu + l * WGU_STRIDE, P.norm_ffn + l * D, DFF, D, DFF, 1, up * 128, r % I_FF}; break; } r -= 4 * I_FF; \
            if (r < 2 * I_DN) { const int l = r / I_DN; J = TJob{P.ffn_w_down + (size_t)l * DFF * D, Wdn + l * WDN_STRIDE, nullptr, D, DFF, D, 0, 0, r % I_DN}; break; } r -= 2 * I_DN; \
            if (r < 2 * I_PP) { const int l = r / I_PP; J = TJob{P.ple_w_proj + (size_t)l * 256 * D, Wpp + l * WPP_STRIDE, nullptr, D, 256, D, 0, 0, r % I_PP}; break; } r -= 2 * I_PP; \
            { const int l = r / I_SQ; J = TJob{P.ple_w_gate + (size_t)l * D * D, Wpg + l * WPG_STRIDE, P.norm_ple + l * D, D, D, D, 0, 0, r % I_SQ}; } } while (0)
        for (int rt_ = 0; rt_ <= REP_T; ++rt_)
        {
            float tA[32], tB[32]; TJob jc, jn; int it = gw; bool have = it < NITEMS;
            if (have) { T_DECODE(it, jc); transpose_issue(jc, tA, lane); }
            while (have) {
                const int itn = it + NGW; const bool haven = itn < NITEMS;
                if (haven) { T_DECODE(itn, jn); transpose_issue(jn, tB, lane); }
                transpose_finish(jc, tA, scr, lane);
#pragma unroll
                for (int i = 0; i < 32; ++i) tA[i] = tB[i];
                jc = jn; it = itn; have = haven;
            }
        }
#undef T_DECODE
        for (int rp_ = 0; rp_ <= REP_PR; ++rp_)
        for (int i0 = gt; i0 < 2 * M * 256 / 8; i0 += 4 * NGT) { f32x4 a[4], c[4];
#pragma unroll
            for (int k = 0; k < 4; ++k) { const int i = i0 + k * NGT; if (i < 2 * M * 256 / 8) { a[k] = __builtin_nontemporal_load((const f32x4*)P.p + 2 * i); c[k] = __builtin_nontemporal_load((const f32x4*)P.p + 2 * i + 1); } }
#pragma unroll
            for (int k = 0; k < 4; ++k) { const int i = i0 + k * NGT; if (i < 2 * M * 256 / 8) ((u32x4*)pbf)[i] = pg8::pack8(a[k], c[k]); } }
        for (int i = gt; i < M * 32; i += NGT) { float c, s; rope_entry(P.pos[i >> 5], i & 31, c, s); ropeC[i] = c; ropeS[i] = s; }
        __syncthreads();
        for (int rn_ = 0; rn_ <= REP_NG; ++rn_) norm_phase<true, false>(P.x, P.norm_mix, hn, lds, P.ev_w_in, P.ev_b_f, Fc, tot, tid, lane, wave);
    }
    SEAM(0);
    if (IN(1)) { IDS
        LAS float* offs = (LAS float*)lds;
        for (int item = blockIdx.x; item < 256; item += G) {
            const int bh = item >> 4, part = item & 15;
            if (tid < 128) offs[tid] = tot[bh * 128 + tid];
            __syncthreads();
            if (wave == 0) { const float a = offs[2 * lane], b2 = offs[2 * lane + 1], s2 = a + b2; float inc = s2;
#pragma unroll
                for (int o = 1; o < 64; o <<= 1) { const float t = __shfl_up(inc, o); if (lane >= o) inc += t; }
                const float exc = inc - s2; offs[128 + 2 * lane] = exc; offs[128 + 2 * lane + 1] = exc + a; }
            __syncthreads();
            { const int sidx = part * 512 + tid; float* fp = Fc + (size_t)bh * S + sidx; *fp = (*fp + offs[128 + (sidx >> 6)]) * LOG2E; }
            __syncthreads();
        }
        pg8::EpiL0In E{QK, VT, kstat};
        for (int rep_ = 0; rep_ <= REP_GIN0; ++rep_) GEMM(pg8::EpiL0In, E, hn, Win0, 3072, D);
    }
    SEAM(1);
    if (IN(2)) for (int rep_ = 0; rep_ <= REP_ATT0; ++rep_) { IDS
        if (rep_ > 0) xcd_barrier(xbar);
        for (int ch = blockIdx.x; ch < 2 * 8 * 16; ch += G) {
            const int cc = ch >> 4, b = (ch >> 3) & 1, hd = ch & 7; bf16x8 qfN[4]; float FqN = 0.f; int res = 1 << 28;
            for (int q = 1; q >= 0; --q) res = attn_wg<0>(QK, VT, Ob, Fc, kstat, nullptr, b, hd, 2 * cc + q, res, q == 1, q > 0, qfN, FqN, lds, tid, lane, wave);
            res = 1 << 28;
            for (int q = 1; q >= 0; --q) res = attn_wg<1>(QK, VT, Ob, nullptr, nullptr, nullptr, b, hd, 2 * cc + q, res, q == 1, q > 0, qfN, FqN, lds, tid, lane, wave);
        }
        __syncthreads();
    }
    SEAM(2);
    if (IN(3)) { { pg8::EpiResid<true> E{P.x, nullptr, hn, Fc, 1.0f}; for (int rep_ = 0; rep_ < REP_GOUT0; ++rep_) GEMM1(pg8::EpiResid<true>, E, Ob, Wout0, D, D); }
                 pg8::EpiResid<true> E{P.x, nullptr, hn, ssq, 1.0f}; GEMM1(pg8::EpiResid<true>, E, Ob, Wout0, D, D); }
    SEAM(3);
    if (IN(4)) { { pg8::EpiSwiGLU E{ACT, ssq}; for (int rep_ = 0; rep_ <= REP_GU; ++rep_) GEMM(pg8::EpiSwiGLU, E, hn, Wgu, 2 * DFF, D); }
                 { pg8::EpiStore E{PP, D}; GEMM_SUB(pg8::EpiStore, E, pbf, Wpp, D, 256, (64 * 22) % G); } }
    SEAM(4);
    if (IN(5)) { { pg8::EpiResid<false> E{nullptr, hn, hn, Fc, 0.0f}; for (int rep_ = 0; rep_ < REP_DOWN0; ++rep_) GEMM1(pg8::EpiResid<false>, E, ACT, Wdn, D, DFF); }
                 pg8::EpiResid<false> E{nullptr, hn, hn, ssq + M, 1.0f}; GEMM1(pg8::EpiResid<false>, E, ACT, Wdn, D, DFF); }
    SEAM(5);
    if (IN(6)) { { pg8::EpiPle E{hn, PP, ssq + M, hb2, Fc, 0.0f}; for (int rep_ = 0; rep_ < REP_PG0; ++rep_) GEMM1(pg8::EpiPle, E, hn, Wpg, D, D); }
                 pg8::EpiPle E{hn, PP, ssq + M, hb2, ssq + 2 * M, 1.0f}; GEMM1(pg8::EpiPle, E, hn, Wpg, D, D); }
    SEAM(6);
    if (IN(7)) { { pg8::EpiL1In E{QK, VT1, ropeC, ropeS, ssq + 2 * M}; GEMM(pg8::EpiL1In, E, hb2, Win1, 1536, D); }
                 { pg8::EpiStore E{PP1, D}; GEMM_SUB(pg8::EpiStore, E, pbf + (size_t)M * 256, Wpp + WPP_STRIDE, D, 256, (64 * 6) % G); } }
    SEAM(7);
    if (IN(8)) for (int rep_ = 0; rep_ <= REP_SWA; ++rep_) { IDS
        if (rep_ > 0) xcd_barrier(xbar);
        for (int ch = blockIdx.x; ch < 2 * 16 * 8; ch += G) { const int c = ch >> 5, b = (ch >> 4) & 1, hd = ch & 15; int res = 1 << 28; bf16x8 qfN[4]; float FqN = 0.f;
            for (int q = 3; q >= 0; --q) res = attn_wg<2>(QK, VT1, Ob, nullptr, nullptr, P.od_sinks, b, hd, 4 * c + q, res, q == 3, q > 0, qfN, FqN, lds, tid, lane, wave); }
        __syncthreads();
    }
    SEAM(8);
    if (IN(9)) { pg8::EpiResid<false> E{nullptr, hb2, hn, ssq + 3 * M, 1.0f}; GEMM1(pg8::EpiResid<false>, E, Ob, Wout1, D, D); }
    SEAM(9);
    if (IN(10)) { pg8::EpiSwiGLU E{ACT1, ssq + 3 * M}; GEMM(pg8::EpiSwiGLU, E, hn, Wgu + WGU_STRIDE, 2 * DFF, D); }
    SEAM(10);
    if (IN(11)) { pg8::EpiResid<false> E{nullptr, hn, hn, ssq + 4 * M, 1.0f}; GEMM1(pg8::EpiResid<false>, E, ACT1, Wdn + WDN_STRIDE, D, DFF); }
    SEAM(11);
    if (IN(12)) { pg8::EpiPle E{hn, PP1, ssq + 4 * M, hb2, ssq + 5 * M, 1.0f}; GEMM1(pg8::EpiPle, E, hn, Wpg + WPG_STRIDE, D, D); }
    SEAM(12);
    for (int rep_ = 0; rep_ < REP_SYNC; ++rep_) xcd_barrier(xbar);
    if (IN(13)) { IDS
        f32x4 g4[4];
#pragma unroll
        for (int q = 0; q < 4; ++q) g4[q] = *(const f32x4*)(P.norm_final + 8 * lane + 512 * (q >> 1) + 4 * (q & 1));
        for (int r0 = gw * 8; r0 < M; r0 += NGW * 8) {
            u32x4 w[8][2];
#pragma unroll
            for (int rr = 0; rr < 8; ++rr) { const u32x4* hp = (const u32x4*)(hb2 + (size_t)(r0 + rr) * D) + lane; w[rr][0] = __builtin_nontemporal_load(hp); w[rr][1] = __builtin_nontemporal_load(hp + 64); }
#pragma unroll
            for (int rr = 0; rr < 8; ++rr) { const float rs = pg8::row_rstd(ssq + 5 * M, r0 + rr); f32x4* op = (f32x4*)(h + (size_t)(r0 + rr) * D) + 2 * lane;
#pragma unroll
                for (int q = 0; q < 2; ++q) { const u32x4 x = w[rr][q];
                    const f32x4 a = {pg8::bflo(x.x), pg8::bfhi(x.x), pg8::bflo(x.y), pg8::bfhi(x.y)}, c = {pg8::bflo(x.z), pg8::bfhi(x.z), pg8::bflo(x.w), pg8::bfhi(x.w)};
                    op[128 * q] = a * rs * g4[2 * q]; op[128 * q + 1] = c * rs * g4[2 * q + 1]; } }
        }
    }
#undef IN
#undef SEAM
#undef GEMM
}

#ifndef MK_PER_PHASE
#define MK_PER_PHASE 0
#endif
constexpr int N_PHASES = 14;
extern "C" void kernel_launch(void* const* d_in, const int* in_sizes, int n_in, void* d_out, int out_size, void* d_ws, size_t ws_size, hipStream_t stream) {
    static int grid_blocks = 0;
    if (grid_blocks == 0) {
        if (n_in != 18 || out_size != M * D || ws_size < WS_END) { fprintf(stderr, "kernel_launch: unexpected shapes (n_in %d, out %d, ws %zu)\n", n_in, out_size, ws_size); grid_blocks = -1; return; }
        int dev = 0, cus = 0, per_cu = 0;
        hipGetDevice(&dev); hipDeviceGetAttribute(&cus, hipDeviceAttributeMultiprocessorCount, dev);
        if (hipFuncSetAttribute((const void*)mk_fwd, hipFuncAttributeMaxDynamicSharedMemorySize, LDS_BYTES) != hipSuccess) { fprintf(stderr, "kernel_launch: hipFuncSetAttribute failed\n"); grid_blocks = -1; return; }
        if (hipOccupancyMaxActiveBlocksPerMultiprocessor(&per_cu, (const void*)mk_fwd, NTHREADS, LDS_BYTES) != hipSuccess || per_cu < 1) { fprintf(stderr, "kernel_launch: occupancy query gave %d\n", per_cu); per_cu = 1; (void)hipGetLastError(); }
        grid_blocks = cus * 1;
    }
    if (grid_blocks < 0) return;
#define REP_LAUNCH 0
    for (int pass_ = 0; pass_ <= REP_LAUNCH; ++pass_) {
    if (hipMemsetAsync((char*)d_ws, 0, WS_ZERO_BYTES, stream) != hipSuccess) { fprintf(stderr, "kernel_launch: hipMemsetAsync failed\n"); return; }
    Params p{};
    p.x = (const float*)d_in[0]; p.p = (const float*)d_in[1]; p.pos = (const int*)d_in[2];
    p.norm_mix = (const float*)d_in[3]; p.norm_ffn = (const float*)d_in[4]; p.norm_ple = (const float*)d_in[5]; p.norm_final = (const float*)d_in[6];
    p.ev_w_in = (const float*)d_in[7]; p.ev_b_f = (const float*)d_in[8]; p.ev_w_out = (const float*)d_in[9]; p.od_w_in = (const float*)d_in[10]; p.od_sinks = (const float*)d_in[11]; p.od_w_out = (const float*)d_in[12];
    p.ffn_w_gate = (const float*)d_in[13]; p.ffn_w_up = (const float*)d_in[14]; p.ffn_w_down = (const float*)d_in[15]; p.ple_w_proj = (const float*)d_in[16]; p.ple_w_gate = (const float*)d_in[17];
    p.out = (float*)d_out; p.ws = (unsigned char*)d_ws;
#if MK_PER_PHASE
    for (int ph = 0; ph < N_PHASES; ++ph) {
        p.ph_lo = ph; p.ph_hi = ph + 1;
        void* args[] = {&p};
        hipError_t e = hipLaunchCooperativeKernel((const void*)mk_fwd, dim3(grid_blocks), dim3(NTHREADS), args, LDS_BYTES, stream);
        if (e != hipSuccess) { fprintf(stderr, "cooperative launch (phase %d) failed: %s (grid %d)\n", ph, hipGetErrorString(e), grid_blocks); break; }
    }
#else
    p.ph_lo = 0; p.ph_hi = N_PHASES;
    void* args[] = {&p};
    hipError_t e = hipLaunchCooperativeKernel((const void*)mk_fwd, dim3(grid_blocks), dim3(NTHREADS), args, LDS_BYTES, stream);
    if (e != hipSuccess) fprintf(stderr, "cooperative launch failed: %s (grid %d)\n", hipGetErrorString(e), grid_blocks);
#endif
    }
}
```
